# Optimizing an MI355X kernel written in HIP

```python
import math
import jax, jax.numpy as jnp
from jax import lax
import numpy as np

D_MODEL = 1024
BATCH = 8
SEQ = 4096
DEPTH = 1

D_MIX = D_MODEL
ATT_WIDTH = D_MIX // 2
RET_WIDTH = D_MIX - ATT_WIDTH
ATT_HEADS = 8
ATT_KV_HEADS = 2
ATT_HEAD_DIM = ATT_WIDTH // ATT_HEADS
IDX_HEADS = 4
IDX_DIM = 64
TOPK_MAX = 256
Q_BLOCK = 128
RET_HEADS = 4
RET_HEAD_DIM = RET_WIDTH // RET_HEADS
RET_CHUNK = 128
ROPE_BASE = 10000.0
N_BUCKETS = 32
MAX_DISTANCE = 128
N_EXPERTS = 32
TOP_K = 4
D_FF = D_MODEL
SWIGLU_ALPHA = 1.702
SWIGLU_LIMIT = 7.0
MOE_BLOCK = 256
LN_EPS = 1e-5
DN_ALPHA = (2 * DEPTH) ** 0.25
DN_BETA = (8 * DEPTH) ** -0.25
IN_SPLITS = (ATT_WIDTH, ATT_KV_HEADS * ATT_HEAD_DIM, ATT_KV_HEADS * ATT_HEAD_DIM,
             IDX_HEADS * IDX_DIM, IDX_DIM, IDX_HEADS,
             RET_WIDTH, RET_WIDTH, RET_WIDTH, RET_WIDTH)
D_IN = sum(IN_SPLITS)

kernel_name = "dsa_retention_hybrid_moe_deepnorm"


def layer_norm(x, g, b):
    xf = x.astype(jnp.float32)
    mu = jnp.mean(xf, -1, keepdims=True)
    var = jnp.mean(jnp.square(xf - mu), -1, keepdims=True)
    return ((xf - mu) * lax.rsqrt(var + LN_EPS)).astype(x.dtype) * g + b


def head_norm(y):
    yf = y.astype(jnp.float32)
    mu = jnp.mean(yf, -1, keepdims=True)
    var = jnp.mean(jnp.square(yf - mu), -1, keepdims=True)
    return ((yf - mu) * lax.rsqrt(var + LN_EPS)).astype(y.dtype)


def t5_bucket(dist):
    max_exact = N_BUCKETS // 2
    n = jnp.maximum(dist, 0)
    nf = jnp.maximum(n, 1).astype(jnp.float32)
    large = max_exact + (jnp.log(nf / max_exact) / math.log(MAX_DISTANCE / max_exact)
                         * (N_BUCKETS - max_exact)).astype(jnp.int32)
    large = jnp.minimum(large, N_BUCKETS - 1)
    return jnp.where(n < max_exact, n, large)


def rotary(x):
    L, d = x.shape[1], x.shape[-1]
    inv = 1.0 / (ROPE_BASE ** (jnp.arange(0, d, 2, dtype=jnp.float32) / d))
    ang = jnp.arange(L, dtype=jnp.float32)[:, None] * inv[None, :]
    cos = jnp.cos(ang)[None, :, None, :]
    sin = jnp.sin(ang)[None, :, None, :]
    xf = x.astype(jnp.float32)
    x1, x2 = xf[..., : d // 2], xf[..., d // 2:]
    return jnp.concatenate([x1 * cos - x2 * sin, x1 * sin + x2 * cos], -1).astype(x.dtype)


def dsa_attention(q, k, v, q_idx, k_idx, w_idx, rel_bias):
    B, L = q.shape[0], q.shape[1]
    k_sel = min(TOPK_MAX, L // 4)
    nqb = L // Q_BLOCK
    rep = ATT_HEADS // ATT_KV_HEADS
    key_pos = jnp.arange(L, dtype=jnp.int32)
    b_ix = jnp.arange(B)[:, None, None]

    def blocks(a):
        return jnp.moveaxis(a.reshape(B, nqb, Q_BLOCK, *a.shape[2:]), 1, 0)

    def one_block(args):
        qb, qib, wb, tpos = args
        rel = jax.nn.relu(jnp.einsum('bthd,bsd->bths', qib, k_idx) * IDX_DIM ** -0.5)
        score = jnp.einsum('bths,bth->bts', rel, wb).astype(jnp.float32)
        causal = key_pos[None, :] <= tpos[:, None]
        score = jnp.where(causal[None], score, -jnp.inf)
        _, idx = lax.top_k(score, k_sel)
        ks = k[b_ix, idx]
        vs = v[b_ix, idx]
        qg = qb.reshape(B, Q_BLOCK, ATT_KV_HEADS, rep, ATT_HEAD_DIM)
        logits = jnp.einsum('btgrd,btkgd->btgrk', qg, ks).astype(jnp.float32) * ATT_HEAD_DIM ** -0.5
        dist = tpos[None, :, None] - idx
        bias = rel_bias[t5_bucket(dist)].reshape(B, Q_BLOCK, k_sel, ATT_KV_HEADS, rep)
        logits = logits + jnp.moveaxis(bias, 2, -1).astype(jnp.float32)
        valid = (dist >= 0)[:, :, None, None, :]
        logits = jnp.where(valid, logits, -jnp.inf)
        p = jax.nn.softmax(logits, axis=-1).astype(v.dtype)
        o = jnp.einsum('btgrk,btkgd->btgrd', p, vs)
        return o.reshape(B, Q_BLOCK, ATT_WIDTH)

    out = lax.map(one_block, (blocks(q), blocks(q_idx), blocks(w_idx),
                              key_pos.reshape(nqb, Q_BLOCK)))
    return jnp.moveaxis(out, 0, 1).reshape(B, L, ATT_WIDTH)


def retention(q, k, v):
    B, L, H, d = q.shape
    nc = L // RET_CHUNK
    log_g = jnp.log(1.0 - 2.0 ** (-5.0 - jnp.arange(H, dtype=jnp.float32)))
    i = jnp.arange(RET_CHUNK, dtype=jnp.float32)
    diff = i[:, None] - i[None, :]
    inner_decay = jnp.where(diff[None] >= 0,
                            jnp.exp(jnp.maximum(diff, 0.0)[None] * log_g[:, None, None]), 0.0)
    q_decay = jnp.exp((i[None, :] + 1.0) * log_g[:, None])[None, :, :, None]
    k_decay = jnp.exp((RET_CHUNK - 1.0 - i[None, :]) * log_g[:, None])[None, :, :, None]
    chunk_decay = jnp.exp(RET_CHUNK * log_g)[None, :, None, None]

    def to_chunks(a):
        return a.astype(jnp.float32).reshape(B, nc, RET_CHUNK, H, d).transpose(1, 0, 3, 2, 4)

    def step(state, inp):
        qi, ki, vi = inp
        attn = jnp.einsum('bhid,bhjd->bhij', qi, ki) * inner_decay[None]
        inner = jnp.einsum('bhij,bhjv->bhiv', attn, vi)
        cross = jnp.einsum('bhid,bhdv->bhiv', qi, state) * q_decay
        new_state = state * chunk_decay + jnp.einsum('bhjd,bhjv->bhdv', ki * k_decay, vi)
        return new_state, inner + cross

    state0 = jnp.zeros((B, H, d, d), jnp.float32)
    _, out = lax.scan(step, state0, (to_chunks(q), to_chunks(k), to_chunks(v)))
    return out.transpose(1, 0, 3, 2, 4).reshape(B, L, H, d).astype(q.dtype)


def hybrid_mixer(h, w_in, ret_norm_g, w_out, rel_bias):
    B, L, _ = h.shape
    proj = h @ w_in
    cuts = np.cumsum(IN_SPLITS)[:-1].tolist()
    q_a, k_a, v_a, q_i, k_i, w_i, q_r, k_r, v_r, g_r = jnp.split(proj, cuts, axis=-1)
    attn = dsa_attention(
        q_a.reshape(B, L, ATT_HEADS, ATT_HEAD_DIM),
        k_a.reshape(B, L, ATT_KV_HEADS, ATT_HEAD_DIM),
        v_a.reshape(B, L, ATT_KV_HEADS, ATT_HEAD_DIM),
        q_i.reshape(B, L, IDX_HEADS, IDX_DIM), k_i, w_i * IDX_HEADS ** -0.5, rel_bias)
    qr = rotary(q_r.reshape(B, L, RET_HEADS, RET_HEAD_DIM))
    kr = rotary(k_r.reshape(B, L, RET_HEADS, RET_HEAD_DIM)) * RET_HEAD_DIM ** -0.5
    ret = retention(qr, kr, v_r.reshape(B, L, RET_HEADS, RET_HEAD_DIM))
    ret = head_norm(ret).reshape(B, L, RET_WIDTH) * ret_norm_g
    ret = jax.nn.silu(g_r) * ret
    return jnp.concatenate([attn, ret], axis=-1) @ w_out


def clamped_swiglu(gu):
    g, u = gu[..., :D_FF], gu[..., D_FF:]
    g = jnp.minimum(g, SWIGLU_LIMIT)
    u = jnp.clip(u, -SWIGLU_LIMIT, SWIGLU_LIMIT)
    return (u + 1.0) * (g * jax.nn.sigmoid(g * SWIGLU_ALPHA))


def moe(h, w_router, b_router, w_gate_up, b_gate_up, w_down, b_down):
    B, L, D = h.shape
    N = B * L
    hf = h.reshape(N, D)
    logits = hf @ w_router + b_router
    top_val, top_idx = lax.top_k(logits, TOP_K)
    gates = jax.nn.softmax(top_val.astype(jnp.float32), axis=-1).astype(h.dtype)
    e_flat = top_idx.reshape(-1).astype(jnp.int32)
    tok_flat = jnp.arange(N * TOP_K, dtype=jnp.int32) // TOP_K
    g_flat = gates.reshape(-1)
    order = jnp.argsort(e_flat)
    e_sorted = e_flat[order]
    counts = jnp.zeros((N_EXPERTS,), jnp.int32).at[e_flat].add(1)
    starts = jnp.cumsum(counts) - counts
    padded = (counts + MOE_BLOCK - 1) // MOE_BLOCK * MOE_BLOCK
    pends = jnp.cumsum(padded)
    pstarts = pends - padded
    rank = jnp.arange(N * TOP_K, dtype=jnp.int32) - starts[e_sorted]
    dest = pstarts[e_sorted] + rank
    n_blocks = -(-(N * TOP_K) // MOE_BLOCK) + N_EXPERTS
    P = n_blocks * MOE_BLOCK
    row_tok = jnp.full((P,), N, jnp.int32).at[dest].set(tok_flat[order])
    row_gate = jnp.zeros((P,), h.dtype).at[dest].set(g_flat[order])
    block_start = jnp.arange(n_blocks, dtype=jnp.int32) * MOE_BLOCK
    block_exp = jnp.minimum(jnp.searchsorted(pends, block_start, side='right'),
                            N_EXPERTS - 1).astype(jnp.int32)

    def one_block(args):
        tok, gate, e = args
        xb = jnp.take(hf, tok, axis=0, mode='fill', fill_value=0)
        gu = xb @ w_gate_up[e] + b_gate_up[e]
        y = clamped_swiglu(gu) @ w_down[e] + b_down[e]
        return y * gate[:, None]

    ys = lax.map(one_block, (row_tok.reshape(n_blocks, MOE_BLOCK),
                             row_gate.reshape(n_blocks, MOE_BLOCK), block_exp))
    out = jnp.zeros((N, D), h.dtype).at[row_tok].add(ys.reshape(P, D), mode='drop')
    return out.reshape(B, L, D)


def setup_inputs(seed: int = 0) -> dict:
    key = jax.random.key(seed)
    ks = jax.random.split(key, 20)
    f32 = jnp.float32
    D = D_MODEL
    nrm = lambda k, s: jax.random.normal(k, s, f32)
    col_scale = np.ones((D_IN,), np.float32)
    offs = np.concatenate([[0], np.cumsum(IN_SPLITS)])
    for j in (2, 8):
        col_scale[offs[j]:offs[j + 1]] = DN_BETA
    w_in = nrm(ks[3], (DEPTH, D, D_IN)) * D ** -0.5 * jnp.asarray(col_scale)
    return {
        "x": nrm(ks[0], (BATCH, SEQ, D)),
        "c": nrm(ks[1], (BATCH, D)),
        "rel_bias": nrm(ks[2], (N_BUCKETS, ATT_HEADS)) * 0.5,
        "w_ada": nrm(ks[4], (DEPTH, D, 6 * D)) * D ** -0.5 * 0.2,
        "b_ada": nrm(ks[5], (DEPTH, 6 * D)) * 0.01,
        "w_in": w_in,
        "ret_norm_g": 1.0 + 0.05 * nrm(ks[6], (DEPTH, RET_WIDTH)),
        "w_out": nrm(ks[7], (DEPTH, D_MIX, D)) * D_MIX ** -0.5 * DN_BETA,
        "ln1_g": 1.0 + 0.05 * nrm(ks[8], (DEPTH, D)),
        "ln1_b": 0.01 * nrm(ks[9], (DEPTH, D)),
        "w_router": nrm(ks[10], (DEPTH, D, N_EXPERTS)) * D ** -0.5,
        "b_router": 0.01 * nrm(ks[11], (DEPTH, N_EXPERTS)),
        "w_gate_up": nrm(ks[12], (DEPTH, N_EXPERTS, D, 2 * D_FF)) * D ** -0.5 * DN_BETA,
        "b_gate_up": 0.01 * nrm(ks[13], (DEPTH, N_EXPERTS, 2 * D_FF)),
        "w_down": nrm(ks[14], (DEPTH, N_EXPERTS, D_FF, D)) * D_FF ** -0.5 * DN_BETA,
        "b_down": 0.01 * nrm(ks[15], (DEPTH, N_EXPERTS, D)),
        "ln2_g": 1.0 + 0.05 * nrm(ks[16], (DEPTH, D)),
        "ln2_b": 0.01 * nrm(ks[17], (DEPTH, D)),
    }


def reference(x, c, rel_bias, w_ada, b_ada, w_in, ret_norm_g, w_out, ln1_g, ln1_b,
              w_router, b_router, w_gate_up, b_gate_up, w_down, b_down, ln2_g, ln2_b):
    for l in range(DEPTH):
        mod = jax.nn.silu(c) @ w_ada[l] + b_ada[l]
        sh_a, sc_a, g_a, sh_f, sc_f, g_f = jnp.split(mod[:, None, :], 6, axis=-1)
        h = x * (1.0 + sc_a) + sh_a
        mix = hybrid_mixer(h, w_in[l], ret_norm_g[l], w_out[l], rel_bias)
        x = layer_norm(DN_ALPHA * x + (1.0 + g_a) * mix, ln1_g[l], ln1_b[l])
        h = x * (1.0 + sc_f) + sh_f
        ff = moe(h, w_router[l], b_router[l], w_gate_up[l], b_gate_up[l], w_down[l], b_down[l])
        x = layer_norm(DN_ALPHA * x + (1.0 + g_f) * ff, ln2_g[l], ln2_b[l])
    return x
```

```cpp
#include <hip/hip_runtime.h>
#include <hip/hip_bf16.h>
#include <cstdio>
#include <cstdint>
#include <cmath>

#define LAS __attribute__((address_space(3)))
#define GAS __attribute__((address_space(1)))
typedef unsigned short bf16_t;
typedef short bf16x8 __attribute__((ext_vector_type(8)));
typedef short s16x4 __attribute__((ext_vector_type(4)));
typedef float f32x2 __attribute__((ext_vector_type(2)));
typedef float f32x4 __attribute__((ext_vector_type(4)));
typedef float f32x16 __attribute__((ext_vector_type(16)));
typedef unsigned u32x2 __attribute__((ext_vector_type(2)));
typedef unsigned u32x4 __attribute__((ext_vector_type(4)));

constexpr int BATCH = 8, SEQ = 4096, DM = 1024, NTOK = BATCH * SEQ;
constexpr int NIN = 3328;
constexpr int DIN_SRC = 3140;
constexpr int NEXP = 32, DFF = 1024, TOPK = 4, MOE_BLK = 256, MAXBLK = 544, PROWS = MAXBLK * 256;
constexpr float LN_EPS = 1e-5f;
constexpr float DN_ALPHA = 1.189207115002721f;
constexpr float LOG2E = 1.4426950408889634f;
constexpr float QSCALE = 0.125f * LOG2E;

__device__ __forceinline__ unsigned f2bf(float f) { unsigned u = __builtin_bit_cast(unsigned, f); return (u + 0x7fffu + ((u >> 16) & 1u)) >> 16; }
__device__ __forceinline__ unsigned pk2(float lo, float hi) { return f2bf(lo) | (f2bf(hi) << 16); }
__device__ __forceinline__ float bf2f(unsigned short b) { return __uint_as_float(((unsigned)b) << 16); }
__device__ __forceinline__ unsigned cvt_pk_bf16(float lo, float hi) { unsigned r; asm volatile("v_cvt_pk_bf16_f32 %0, %1, %2" : "=v"(r) : "v"(lo), "v"(hi)); return r; }

namespace pg8 {
constexpr int BM = 256, BK = 64, HALF = 128, HTB = HALF * BK * 2, STAGE_BYTES = 8 * HTB, NXCD = 8, WGM = 8;
__host__ __device__ __forceinline__ int lds_byte(int r, int c) { const int st = (r >> 4) * 2 + (c >> 5), rr = r & 15, cc = c & 31, ob = rr * 64 + cc * 2; return st * 1024 + (ob ^ (((ob >> 9) & 1) << 5)); }
__host__ __device__ __forceinline__ void stage_rc(int b, int& R, int& C) { const int st = b / 1024, sb = b % 1024, swz = sb ^ (((sb >> 9) & 1) << 5); R = (st >> 1) * 16 + swz / 64; C = (st & 1) * 32 + (swz % 64) / 2; }
__host__ __device__ __forceinline__ int perm32(int rho) { const int n = rho >> 4, i = rho & 15; return 8 * (i >> 2) + 4 * n + (i & 3); }

struct Unit { int pm, pn; };
struct Gemm { const bf16_t* A; const bf16_t* Bt; int K; const int* rowidx; };

struct StaticOrder {
    int nM, nN, nwg, G, c;
    __device__ void init(int M, int N, int G_, int c_) { nM = M / BM; nN = N / BM; nwg = nM * nN; G = G_; c = c_; }
    __device__ bool next(int i, Unit& u) const {
        const long L = (long)i * G + c; if (L >= nwg) return false;
        int wgid = (int)L; { const int q = nwg / NXCD, r = nwg % NXCD, xcd = wgid % NXCD, off = wgid / NXCD; wgid = (xcd < r ? xcd * (q + 1) : r * (q + 1) + (xcd - r) * q) + off; }
        const int nig = WGM * nN, gid = wgid / nig, fm = gid * WGM, gsz = (nM - fm) < WGM ? (nM - fm) : WGM;
        u.pm = fm + ((wgid % nig) % gsz); u.pn = (wgid % nig) / gsz; return true;
    }
};
struct MoeOrder {
    const int* block_exp; int nblk, nN, G, c;
    __device__ bool next(int i, Unit& u) const {
        const long L = (long)i * G + c; if (L >= (long)nblk * nN) return false;
        const int rb = (int)(L / nN), pnl = (int)(L % nN);
        u.pm = rb; u.pn = block_exp[rb] * nN + pnl; return true;
    }
};

template <class Epi, class Sched, bool GATHER>
__device__ __forceinline__ void gemm_phase(LAS unsigned char* lds, const Gemm g, const Sched& S, const Epi& E) {
    const int tid = threadIdx.x, wid = __builtin_amdgcn_readfirstlane(tid >> 6), lane = tid & 63, wr = wid >> 2, wc = wid & 3, fr = lane & 15, fq = lane >> 4;
    const int K = g.K, nt = K / BK;
    unsigned voffA0[2], voffA1[2], voffB[2], nvA0[2], nvA1[2]; int RA[2], CA[2];
    const size_t hstep = (size_t)HALF * K * 2;
    const size_t tstep = 2 * hstep;
#pragma unroll
    for (int i = 0; i < 2; ++i) { int R, C; stage_rc(tid * 16 + i * 8192, R, C); const int Rb = Epi::PERM ? ((R & ~31) + perm32(R & 31)) : R;
        RA[i] = R; CA[i] = C;
        voffA0[i] = (unsigned)(R * K + C) * 2u; voffA1[i] = voffA0[i] + (unsigned)hstep; voffB[i] = (unsigned)(Rb * K + C) * 2u; nvA0[i] = voffA0[i]; nvA1[i] = voffA1[i]; }
    const size_t kstep = (size_t)(BK * 2);
    const unsigned ldsw = (unsigned)wid * 1024u;
    const int aoff = lds_byte(wr * 64 + fr, fq * 8), boff = lds_byte(wc * 32 + fr, fq * 8);
#define PG8_SA(b, h) (((b) * 2 + (h)) * HTB)
#define PG8_SB(b, h) ((4 + (b) * 2 + (h)) * HTB)
#define PG8_STAGE(bufoff, gbase, voff) do { _Pragma("unroll") for (int _i = 0; _i < 2; ++_i) \
        __builtin_amdgcn_global_load_lds((const unsigned*)((const char*)(gbase) + (voff)[_i]), (LAS unsigned*)(lds + (bufoff) + ldsw + _i * 8192), 16, 0, 0); } while (0)
#define PG8_LDA(dst, b, h) do { _Pragma("unroll") for (int m = 0; m < 4; ++m) _Pragma("unroll") for (int k = 0; k < 2; ++k) dst[m][k] = *(const LAS bf16x8*)(lds + PG8_SA(b, h) + aoff + m * 2048 + k * 1024); } while (0)
#define PG8_LDB(dst, b, h) do { _Pragma("unroll") for (int n = 0; n < 2; ++n) _Pragma("unroll") for (int k = 0; k < 2; ++k) dst[n][k] = *(const LAS bf16x8*)(lds + PG8_SB(b, h) + boff + n * 2048 + k * 1024); } while (0)
#define PG8_MMA(ai, bj, At, Bt) do { __builtin_amdgcn_s_setprio(1); _Pragma("unroll") for (int m = 0; m < 4; ++m) _Pragma("unroll") for (int n = 0; n < 2; ++n) _Pragma("unroll") for (int k = 0; k < 2; ++k) \
        acc[ai][bj][m][n] = __builtin_amdgcn_mfma_f32_16x16x32_bf16(Bt[n][k], At[m][k], acc[ai][bj][m][n], 0, 0, 0); __builtin_amdgcn_s_setprio(0); } while (0)
#define PG8_WAIT_V(n) asm volatile("s_waitcnt vmcnt(" #n ")" ::: "memory")
#define PG8_WAIT_L(n) asm volatile("s_waitcnt lgkmcnt(" #n ")" ::: "memory")
#define PG8_BAR __builtin_amdgcn_s_barrier()
#define PG8_SCHED __builtin_amdgcn_sched_barrier(0)
#define PG8_GLOAD(u, o0, o1) do { if constexpr (GATHER) { _Pragma("unroll") for (int _i = 0; _i < 2; ++_i) { \
        const int r0_ = g.rowidx[(u).pm * BM + RA[_i]], r1_ = g.rowidx[(u).pm * BM + HALF + RA[_i]]; \
        o0[_i] = (unsigned)(r0_ * K + CA[_i]) * 2u; o1[_i] = (unsigned)(r1_ * K + CA[_i]) * 2u; } } } while (0)
    Unit cur, nxt; int ui = 0;
    if (!S.next(0, cur)) return;
    f32x4 acc[2][2][4][2];
#pragma unroll
    for (int a = 0; a < 2; ++a)
#pragma unroll
        for (int b = 0; b < 2; ++b)
#pragma unroll
            for (int m = 0; m < 4; ++m)
#pragma unroll
                for (int n = 0; n < 2; ++n) acc[a][b][m][n] = (f32x4){0.f, 0.f, 0.f, 0.f};
    bf16x8 At[4][2], B0[2][2], B1[2][2];
    PG8_GLOAD(cur, voffA0, voffA1);
    const char* cA = (const char*)g.A + (GATHER ? (size_t)0 : (size_t)cur.pm * tstep); const char* cB = (const char*)g.Bt + (size_t)cur.pn * tstep;
    PG8_STAGE(PG8_SB(0, 0), cB, voffB); PG8_STAGE(PG8_SB(0, 1), cB + hstep, voffB); PG8_STAGE(PG8_SA(0, 0), cA, voffA0); PG8_STAGE(PG8_SA(0, 1), cA, voffA1);
    if (wr == 1) PG8_BAR;
    PG8_WAIT_V(2); PG8_BAR;
    PG8_STAGE(PG8_SB(1, 0), cB + kstep, voffB); PG8_STAGE(PG8_SA(1, 0), cA + kstep, voffA0); PG8_STAGE(PG8_SB(1, 1), cB + hstep + kstep, voffB);
    PG8_WAIT_V(6); PG8_BAR;
    for (;;) {
        const bool has_next = S.next(ui + 1, nxt);
        const char* nA = has_next ? (const char*)g.A + (GATHER ? (size_t)0 : (size_t)nxt.pm * tstep) : cA; const char* nB = has_next ? (const char*)g.Bt + (size_t)nxt.pn * tstep : cB;
        for (int t = 0; t < nt; t += 2) {
            const bool last = (t == nt - 2);
            const char* a1 = cA + (size_t)(t + 1) * kstep;
            const char* a2 = last ? nA : cA + (size_t)(t + 2) * kstep; const char* b2 = last ? nB : cB + (size_t)(t + 2) * kstep;
            const char* a3 = a2 + kstep; const char* b3 = b2 + kstep;
            if constexpr (GATHER) { if (last) { if (has_next) { PG8_GLOAD(nxt, nvA0, nvA1); } else { nvA0[0] = voffA0[0]; nvA0[1] = voffA0[1]; nvA1[0] = voffA1[0]; nvA1[1] = voffA1[1]; } } }
            unsigned x0[2], x1[2];
#pragma unroll
            for (int _i = 0; _i < 2; ++_i) { x0[_i] = (GATHER && last) ? nvA0[_i] : voffA0[_i]; x1[_i] = (GATHER && last) ? nvA1[_i] : voffA1[_i]; }
            PG8_LDB(B0, 0, 0); PG8_LDB(B1, 0, 1); PG8_SCHED; PG8_LDA(At, 0, 0); PG8_STAGE(PG8_SA(1, 1), a1, voffA1);
            PG8_WAIT_V(8); PG8_WAIT_L(0); PG8_BAR; PG8_MMA(0, 0, At, B0); PG8_MMA(0, 1, At, B1); PG8_BAR; PG8_SCHED;
            PG8_LDA(At, 0, 1); PG8_STAGE(PG8_SB(0, 0), b2, voffB); PG8_STAGE(PG8_SB(0, 1), b2 + hstep, voffB); PG8_STAGE(PG8_SA(0, 0), a2, x0);
            PG8_WAIT_V(8); PG8_WAIT_L(0); PG8_BAR; PG8_MMA(1, 0, At, B0); PG8_MMA(1, 1, At, B1); PG8_BAR; PG8_SCHED;
            PG8_LDB(B0, 1, 0); PG8_LDB(B1, 1, 1); PG8_SCHED; PG8_LDA(At, 1, 0); PG8_STAGE(PG8_SA(0, 1), a2, x1);
            PG8_WAIT_V(8); PG8_WAIT_L(0); PG8_BAR; PG8_MMA(0, 0, At, B0); PG8_MMA(0, 1, At, B1); PG8_BAR; PG8_SCHED;
            PG8_LDA(At, 1, 1); PG8_STAGE(PG8_SB(1, 0), b3, voffB); PG8_STAGE(PG8_SB(1, 1), b3 + hstep, voffB); PG8_STAGE(PG8_SA(1, 0), a3, x0);
            PG8_WAIT_V(8); PG8_WAIT_L(0); PG8_BAR; PG8_MMA(1, 0, At, B0); PG8_MMA(1, 1, At, B1); PG8_BAR; PG8_SCHED;
        }
        if (wr == 0) PG8_BAR;
        E(acc, cur, wr, wc, fr, fq);
        if (!has_next) break;
#pragma unroll
        for (int a = 0; a < 2; ++a)
#pragma unroll
            for (int b = 0; b < 2; ++b)
#pragma unroll
                for (int m = 0; m < 4; ++m)
#pragma unroll
                    for (int n = 0; n < 2; ++n) acc[a][b][m][n] = (f32x4){0.f, 0.f, 0.f, 0.f};
        cur = nxt; cA = nA; cB = nB; ++ui;
        if constexpr (GATHER) { voffA0[0] = nvA0[0]; voffA0[1] = nvA0[1]; voffA1[0] = nvA1[0]; voffA1[1] = nvA1[1]; }
        if (wr == 1) PG8_BAR;
    }
    PG8_WAIT_V(0);
    PG8_BAR;
#undef PG8_SA
#undef PG8_SB
#undef PG8_STAGE
#undef PG8_LDA
#undef PG8_LDB
#undef PG8_MMA
#undef PG8_WAIT_V
#undef PG8_WAIT_L
#undef PG8_BAR
#undef PG8_SCHED
#undef PG8_GLOAD
}
}
namespace pg8 {
struct EpiInProj {
    static constexpr bool PERM = true;
    bf16_t *QA, *KA, *VA, *QI, *KIW, *QR, *KR, *VR, *GR;
    __device__ __forceinline__ void operator()(const f32x4 (&acc)[2][2][4][2], const Unit& u, int wr, int wc, int fr, int fq) const {
        const int row0 = u.pm * BM + wr * 64 + fr;
#pragma unroll
        for (int bj = 0; bj < 2; ++bj) {
            const int hb = u.pn * 2 + bj;
            bf16_t* base; int pitch; float sc = 1.f;
            if (hb < 4) { base = QA + hb * 128; pitch = 512; sc = QSCALE; }
            else if (hb == 4) { base = KA; pitch = 128; }
            else if (hb == 5) { base = VA; pitch = 128; }
            else if (hb < 8) { base = QI + (hb - 6) * 128; pitch = 256; sc = 0.125f; }
            else if (hb == 8) { base = KIW; pitch = 128; }
            else if (hb == 9) { continue; }
            else if (hb < 14) { base = QR + (hb - 10) * 128; pitch = 512; }
            else if (hb < 18) { base = KR + (hb - 14) * 128; pitch = 512; }
            else if (hb < 22) { base = VR + (hb - 18) * 128; pitch = 512; }
            else { base = GR + (hb - 22) * 128; pitch = 512; }
            const int col0 = wc * 32 + 8 * fq;
#pragma unroll
            for (int ai = 0; ai < 2; ++ai)
#pragma unroll
                for (int m = 0; m < 4; ++m) {
                    const f32x4 v0 = acc[ai][bj][m][0] * sc, v1 = acc[ai][bj][m][1] * sc;
                    u32x4 w; w.x = cvt_pk_bf16(v0[0], v0[1]); w.y = cvt_pk_bf16(v0[2], v0[3]); w.z = cvt_pk_bf16(v1[0], v1[1]); w.w = cvt_pk_bf16(v1[2], v1[3]);
                    *(u32x4*)(base + (size_t)(row0 + ai * HALF + m * 16) * pitch + col0) = w; }
        }
    }
};
struct EpiOutProj {
    static constexpr bool PERM = false;
    const float* x; const float* mod; float* V1;
    __device__ __forceinline__ void operator()(const f32x4 (&acc)[2][2][4][2], const Unit& u, int wr, int wc, int fr, int fq) const {
        const int row0 = u.pm * BM + wr * 64 + fr, col0 = u.pn * BM + wc * 32 + 4 * fq;
        const int b = (u.pm * BM) / SEQ;
        f32x4 gv[2][2];
#pragma unroll
        for (int bj = 0; bj < 2; ++bj)
#pragma unroll
            for (int n = 0; n < 2; ++n) gv[bj][n] = *(const f32x4*)(mod + (size_t)b * 6 * DM + 2 * DM + col0 + bj * HALF + n * 16) + 1.0f;
#pragma unroll
        for (int ai = 0; ai < 2; ++ai)
#pragma unroll
            for (int m = 0; m < 4; ++m) { const size_t off = (size_t)(row0 + ai * HALF + m * 16) * DM + col0;
#pragma unroll
                for (int bj = 0; bj < 2; ++bj)
#pragma unroll
                    for (int n = 0; n < 2; ++n) { const f32x4 xv = *(const f32x4*)(x + off + bj * HALF + n * 16);
                        *(f32x4*)(V1 + off + bj * HALF + n * 16) = xv * DN_ALPHA + gv[bj][n] * acc[ai][bj][m][n]; } }
    }
};
struct EpiGateUp {
    static constexpr bool PERM = true;
    bf16_t* act; const float* bgu;
    __device__ __forceinline__ void operator()(const f32x4 (&acc)[2][2][4][2], const Unit& u, int wr, int wc, int fr, int fq) const {
        const int e = u.pn >> 3, pnl = u.pn & 7;
        const int row0 = u.pm * BM + wr * 64 + fr, j0 = wc * 32 + 8 * fq;
        f32x4 bg[2], bu[2];
#pragma unroll
        for (int n = 0; n < 2; ++n) { bg[n] = *(const f32x4*)(bgu + (size_t)e * 2048 + pnl * 128 + j0 + 4 * n); bu[n] = *(const f32x4*)(bgu + (size_t)e * 2048 + 1024 + pnl * 128 + j0 + 4 * n); }
#pragma unroll
        for (int ai = 0; ai < 2; ++ai)
#pragma unroll
            for (int m = 0; m < 4; ++m) {
                float o[8];
#pragma unroll
                for (int n = 0; n < 2; ++n) { const f32x4 gq = acc[ai][0][m][n] + bg[n], uq = acc[ai][1][m][n] + bu[n];
#pragma unroll
                    for (int i = 0; i < 4; ++i) { const float gg = fminf(gq[i], 7.0f), uu = fminf(fmaxf(uq[i], -7.0f), 7.0f);
                        const float sg = __builtin_amdgcn_rcpf(1.0f + __builtin_amdgcn_exp2f(-1.702f * LOG2E * gg));
                        o[4 * n + i] = (uu + 1.0f) * (gg * sg); } }
                u32x4 w; w.x = cvt_pk_bf16(o[0], o[1]); w.y = cvt_pk_bf16(o[2], o[3]); w.z = cvt_pk_bf16(o[4], o[5]); w.w = cvt_pk_bf16(o[6], o[7]);
                *(u32x4*)(act + (size_t)(row0 + ai * HALF + m * 16) * DFF + pnl * 128 + j0) = w; }
    }
};
struct EpiDown {
    static constexpr bool PERM = true;
    bf16_t* Y; const float* bd; const float* row_gate;
    __device__ __forceinline__ void operator()(const f32x4 (&acc)[2][2][4][2], const Unit& u, int wr, int wc, int fr, int fq) const {
        const int e = u.pn >> 2, pnl = u.pn & 3;
        const int row0 = u.pm * BM + wr * 64 + fr, col0 = pnl * BM + wc * 32 + 8 * fq;
        f32x4 bv[2][2];
#pragma unroll
        for (int bj = 0; bj < 2; ++bj)
#pragma unroll
            for (int n = 0; n < 2; ++n) bv[bj][n] = *(const f32x4*)(bd + (size_t)e * DM + col0 + bj * HALF + 4 * n);
#pragma unroll
        for (int ai = 0; ai < 2; ++ai)
#pragma unroll
            for (int m = 0; m < 4; ++m) { const int row = row0 + ai * HALF + m * 16; const float gt = row_gate[row];
#pragma unroll
                for (int bj = 0; bj < 2; ++bj) { const f32x4 v0 = (acc[ai][bj][m][0] + bv[bj][0]) * gt, v1 = (acc[ai][bj][m][1] + bv[bj][1]) * gt;
                    u32x4 w; w.x = cvt_pk_bf16(v0[0], v0[1]); w.y = cvt_pk_bf16(v0[2], v0[3]); w.z = cvt_pk_bf16(v1[0], v1[1]); w.w = cvt_pk_bf16(v1[2], v1[3]);
                    *(u32x4*)(Y + (size_t)row * DM + col0 + bj * HALF) = w; } }
    }
};
}
namespace attn_body {
constexpr int D = 64, QP = 512, KP = 128, VP = 128, OP = 1024;
constexpr int NW = 8, QBLK = 32, QB = QBLK * NW, KVBLK = 64;
__device__ __forceinline__ int crow(int r, int hi) { return (r & 3) + 8 * (r >> 2) + 4 * hi; }
#define SBAR() __builtin_amdgcn_sched_barrier(0)
constexpr int NSLOT = 3, SLOTB = 8192, MSLOT = 2048;
constexpr int LDS_K = 0, LDS_V = NSLOT * SLOTB, LDS_WS = 2 * NSLOT * SLOTB, LDS_OST = LDS_WS + NW * 64 * 4, LDS_M = LDS_OST + NW * 4096, LDS_BT = LDS_M + NSLOT * MSLOT, BT_N = 704, LDS_BYTES = LDS_BT + BT_N * 4;
__device__ __forceinline__ void glds16(const void* gsrc, unsigned lds_dst) { unsigned keep;
    asm volatile("s_mov_b32 %0, m0\n\ts_mov_b32 m0, %2\n\ts_nop 0\n\tglobal_load_lds_dwordx4 %1, off\n\ts_mov_b32 m0, %0" : "=&s"(keep) : "v"(gsrc), "s"(lds_dst) : "memory"); }
__device__ __forceinline__ void glds4(const void* gsrc, unsigned lds_dst) { unsigned keep;
    asm volatile("s_mov_b32 %0, m0\n\ts_mov_b32 m0, %2\n\ts_nop 0\n\tglobal_load_lds_dword %1, off\n\ts_mov_b32 m0, %0" : "=&s"(keep) : "v"(gsrc), "s"(lds_dst) : "memory"); }
__device__ __forceinline__ float max3f(float a, float b, float c) { float r; asm("v_max3_f32 %0, %1, %2, %3" : "=v"(r) : "v"(a), "v"(b), "v"(c)); return r; }
__device__ __forceinline__ float max2f(float a, float b) { float r; asm("v_max_f32_e32 %0, %1, %2" : "=v"(r) : "v"(a), "v"(b)); return r; }
__device__ __forceinline__ float fadd_s(float a, float b) { float r; asm("v_add_f32_e32 %0, %1, %2" : "=v"(r) : "v"(a), "v"(b)); return r; }
__device__ __forceinline__ float fsub_s(float a, float b) { float r; asm("v_sub_f32_e32 %0, %1, %2" : "=v"(r) : "v"(a), "v"(b)); return r; }
typedef __bf16 bf16x2_t __attribute__((ext_vector_type(2)));
__device__ __forceinline__ unsigned cvtpk_s(float lo, float hi) { f32x2 v = {lo, hi}; bf16x2_t b = __builtin_convertvector(v, bf16x2_t); return __builtin_bit_cast(unsigned, b); }
#define WAIT_BAR(N) asm volatile("s_waitcnt vmcnt(" #N ") lgkmcnt(0)\n\ts_barrier" ::: "memory")

__device__ __forceinline__ void qkt(f32x16& p0, f32x16& p1, const char* Kslot, const bf16x8* qr, const f32x16& negm, int r32, int hi) {
    const char* kb = Kslot + hi * 1024 + r32 * 16;
#pragma unroll
    for (int d0 = 0; d0 < 4; ++d0) {
        const bf16x8 b0 = *reinterpret_cast<const bf16x8*>(kb + d0 * 2048);
        const bf16x8 b1 = *reinterpret_cast<const bf16x8*>(kb + d0 * 2048 + 512);
        if (d0 == 0) { p0 = __builtin_amdgcn_mfma_f32_32x32x16_bf16(b0, qr[0], negm, 0, 0, 0); p1 = __builtin_amdgcn_mfma_f32_32x32x16_bf16(b1, qr[0], negm, 0, 0, 0); }
        else { p0 = __builtin_amdgcn_mfma_f32_32x32x16_bf16(b0, qr[d0], p0, 0, 0, 0); p1 = __builtin_amdgcn_mfma_f32_32x32x16_bf16(b1, qr[d0], p1, 0, 0, 0); } }
}
typedef LAS const char* lds_cptr;
typedef short v4i16_t __attribute__((ext_vector_type(4)));
__device__ __forceinline__ void kload8(bf16x8* kf, lds_cptr kp) {
    kf[0] = *(const LAS bf16x8*)(kp);        kf[1] = *(const LAS bf16x8*)(kp + 512);
    kf[2] = *(const LAS bf16x8*)(kp + 2048); kf[3] = *(const LAS bf16x8*)(kp + 2560);
    kf[4] = *(const LAS bf16x8*)(kp + 4096); kf[5] = *(const LAS bf16x8*)(kp + 4608);
    kf[6] = *(const LAS bf16x8*)(kp + 6144); kf[7] = *(const LAS bf16x8*)(kp + 6656);
}
__device__ __forceinline__ void kload2(bf16x8* kf, lds_cptr kp, int j) { kf[2 * j] = *(const LAS bf16x8*)(kp + j * 2048); kf[2 * j + 1] = *(const LAS bf16x8*)(kp + j * 2048 + 512); }
__device__ __forceinline__ s16x4 vtr(lds_cptr p) { return __builtin_bit_cast(s16x4, __builtin_amdgcn_ds_read_tr16_b64_v4i16((LAS v4i16_t*)p)); }
__device__ __forceinline__ float rowmax(const f32x16& p0, const f32x16& p1) {
    float a = max3f(p0[0], p0[1], p1[0]), b = max3f(p0[2], p0[3], p1[1]); a = max3f(a, p1[2], p1[3]);
#pragma unroll
    for (int r = 4; r < 16; r += 4) { a = max3f(a, p0[r], p0[r + 1]); b = max3f(b, p0[r + 2], p0[r + 3]); a = max3f(a, p1[r], p1[r + 1]); b = max3f(b, p1[r + 2], p1[r + 3]); }
    const float m = max2f(a, b);
    auto rr = __builtin_amdgcn_permlane32_swap(__float_as_uint(m), __float_as_uint(m), false, false);
    return max2f(__uint_as_float(rr[0]), __uint_as_float(rr[1]));
}
__device__ __forceinline__ void pv(f32x16* o, int vb, bf16x8 pa0, bf16x8 pa1, bf16x8 pa2, bf16x8 pa3) {
#pragma unroll
    for (int d0 = 0; d0 < 2; ++d0) { s16x4 lo[4], hi[4];
#pragma unroll
        for (int ks = 0; ks < 4; ++ks) {
            asm volatile("ds_read_b64_tr_b16 %0,%1 offset:%c2" : "=&v"(lo[ks]) : "v"(vb), "i"(d0 * 4096 + ks * 1024) : "memory");
            asm volatile("ds_read_b64_tr_b16 %0,%1 offset:%c2" : "=&v"(hi[ks]) : "v"(vb), "i"(d0 * 4096 + ks * 1024 + 512) : "memory"); }
        asm volatile("s_waitcnt lgkmcnt(0)" ::: "memory"); SBAR();
#define PK(k) (bf16x8){lo[k][0], lo[k][1], lo[k][2], lo[k][3], hi[k][0], hi[k][1], hi[k][2], hi[k][3]}
        o[d0] = __builtin_amdgcn_mfma_f32_32x32x16_bf16(pa0, PK(0), o[d0], 0, 0, 0);
        o[d0] = __builtin_amdgcn_mfma_f32_32x32x16_bf16(pa1, PK(1), o[d0], 0, 0, 0);
        o[d0] = __builtin_amdgcn_mfma_f32_32x32x16_bf16(pa2, PK(2), o[d0], 0, 0, 0);
        o[d0] = __builtin_amdgcn_mfma_f32_32x32x16_bf16(pa3, PK(3), o[d0], 0, 0, 0);
#undef PK
    }
}
__device__ __forceinline__ void apply_mask(f32x16& p0, f32x16& p1, unsigned w0, unsigned w1, float mh) {
#pragma unroll
    for (int r = 0; r < 16; ++r) { const int c = (r & 3) + 8 * (r >> 2);
        const unsigned m0 = (unsigned)__builtin_amdgcn_sbfe((int)w0, c, 1), m1 = (unsigned)__builtin_amdgcn_sbfe((int)w1, c, 1);
        p0[r] = __uint_as_float((__float_as_uint(p0[r] - mh) & m0) | (0xff800000u & ~m0));
        p1[r] = __uint_as_float((__float_as_uint(p1[r] - mh) & m1) | (0xff800000u & ~m1)); }
}
__device__ __forceinline__ void apply_bias(f32x16& p0, f32x16& p1, lds_cptr bp) {
#pragma unroll
    for (int r = 0; r < 16; ++r) { const int c = (r & 3) + 8 * (r >> 2);
        p0[r] += *(const LAS float*)(bp + 4 * c); p1[r] += *(const LAS float*)(bp + 4 * c + 128); }
}

#ifndef ATTN_THRL
#define ATTN_THRL 8
#endif
__device__ __forceinline__ void attn_unit(int b, int h, int qb, const bf16_t* Q, const bf16_t* __restrict__ K, const bf16_t* __restrict__ V, bf16_t* O,
                                          const unsigned* __restrict__ mask, const float* __restrict__ rel_bias, char* shm) {
    constexpr int THRL = ATTN_THRL;
    const int tid = threadIdx.x, lane = tid & 63, r32 = lane & 31, hi = lane >> 5; const int wid = __builtin_amdgcn_readfirstlane(tid >> 6);
    const long rowbase = (long)b * SEQ; const int q0 = qb * QB; const int g = h >> 2;
    const bf16_t* Qw = Q + (rowbase + q0 + wid * QBLK) * QP + h * D;
    const bf16_t* Kh = K + rowbase * KP + g * D; const bf16_t* Vh = V + rowbase * VP + g * D;
    const unsigned lds0 = (unsigned)(uintptr_t)shm;
    float* wsf = (float*)(shm + LDS_WS) + wid * 64;
    const bf16_t* ksrc = Kh + (long)lane * KP + wid * 8;
    const bf16_t* vsrc = Vh + (long)(16 * (wid & 3) + (lane >> 2)) * VP + (wid >> 2) * 32 + (lane & 3) * 8;
    const unsigned* msrc = mask + ((size_t)b * 64 * SEQ + q0 + wid * QBLK) * 2 + lane;
    const unsigned kdst = lds0 + LDS_K + wid * 1024, vdst = lds0 + LDS_V + wid * 1024, mdst = lds0 + LDS_M + wid * 256;
#define DMA_K(t, slot) glds16(ksrc + (long)(t) * KVBLK * KP, (unsigned)__builtin_amdgcn_readfirstlane(kdst + (slot)))
#define DMA_V(t, slot) glds16(vsrc + (long)(t) * KVBLK * VP, (unsigned)__builtin_amdgcn_readfirstlane(vdst + (slot)))
#define DMA_M(t, slot) glds4(msrc + (size_t)(t) * SEQ * 2, (unsigned)__builtin_amdgcn_readfirstlane(mdst + ((slot) >> 2)))
    const int vb0 = (int)(lds0 + LDS_V) + ((lane >> 4) & 1) * 32 + (lane & 3) * 8 + (4 * hi + ((lane & 15) >> 2)) * 64;
    const char* Kbase = shm + LDS_K; bf16x8 kf[8];
    const lds_cptr shm3 = (lds_cptr)shm; const lds_cptr kp0 = shm3 + LDS_K + hi * 1024 + r32 * 16; const lds_cptr vp0 = shm3 + LDS_V + ((lane >> 4) & 1) * 32 + (lane & 3) * 8 + (4 * hi + ((lane & 15) >> 2)) * 64;
    const lds_cptr mp0 = shm3 + LDS_M + wid * 256 + r32 * 8;
    const int NT = (q0 + QB) / KVBLK;
    { float* TR = (float*)(shm + LDS_BT); const float cfar = rel_bias[31 * 8 + h];
      for (int j = tid; j < BT_N; j += 512) { const int d = 447 - j; float v = 0.f;
          if (d >= 0 && d < 113) { int bk;
              if (d < 16) bk = d; else { bk = 16 + (d >= 19) + (d >= 21) + (d >= 24) + (d >= 27) + (d >= 31) + (d >= 35) + (d >= 40) + (d >= 46) + (d >= 52) + (d >= 59) + (d >= 67) + (d >= 77) + (d >= 87) + (d >= 99); }
              v = (rel_bias[bk * 8 + h] - cfar) * LOG2E; }
          TR[j] = v; } }
    DMA_K(0, 0); DMA_V(0, 0); DMA_K(1, SLOTB); DMA_M(0, 0); DMA_M(1, SLOTB);
    bf16x8 qr[4];
#pragma unroll
    for (int d0 = 0; d0 < 4; ++d0) qr[d0] = *reinterpret_cast<const bf16x8*>(&Qw[(long)r32 * QP + d0 * 16 + hi * 8]);
    float mhat = 0.f, l_reg = 0.f; f32x16 o[2]; o[0] = f32x16{}; o[1] = f32x16{}; const f32x16 zero16 = f32x16{};
    const int qrel = wid * QBLK + r32;
#define BIASP(t) (shm3 + LDS_BT + 4 * (447 - qrel + 4 * hi - 64 * (NT - 4 - (t))))
    bool resc = false;
#define START(P0, P1) do { const float rm = rowmax(P0, P1); resc = false; \
    { const float dl = __builtin_fmaxf(rm, -256.f); mhat = fadd_s(mhat, dl); \
      _Pragma("unroll") for (int r = 0; r < 16; ++r) { P0[r] = fsub_s(P0[r], dl); P1[r] = fsub_s(P1[r], dl); } \
      } \
    _Pragma("unroll") for (int r = 0; r < 16; ++r) P0[r] = __builtin_amdgcn_exp2f(P0[r]); } while (0)
#define RESC() do { if (resc) { asm volatile("s_waitcnt lgkmcnt(0)" ::: "memory"); \
      _Pragma("unroll") for (int d_ = 0; d_ < 2; ++d_) _Pragma("unroll") for (int r = 0; r < 16; ++r) o[d_][r] *= wsf[crow(r, hi)]; } } while (0)
    f32x16 pA0, pA1, pB0, pB1;
    int sl_prev = 0, sl_cur = 0, sl_next = SLOTB;
#define ROT() do { sl_prev = sl_cur; sl_cur = sl_next; sl_next = (sl_next == (NSLOT - 1) * SLOTB) ? 0 : sl_next + SLOTB; } while (0)
    DMA_K(2, 2 * SLOTB);
    WAIT_BAR(3);
    u32x2 mw = *(const LAS u32x2*)(mp0);
    qkt(pA0, pA1, Kbase, qr, zero16, r32, hi); asm volatile("s_nop 15\n\ts_nop 7" : "+v"(pA0), "+v"(pA1));
    apply_mask(pA0, pA1, mw.x >> (4 * hi), mw.y >> (4 * hi), 0.f);
    if (NT <= 7) apply_bias(pA0, pA1, BIASP(0));
    START(pA0, pA1);
    _Pragma("unroll") for (int r = 0; r < 16; ++r) pA1[r] = __builtin_amdgcn_exp2f(pA1[r]);
    WAIT_BAR(0);
    DMA_K(3, 0); DMA_V(1, SLOTB); DMA_M(2, 2 * SLOTB);
    ROT();
    kload8(kf, kp0 + sl_cur);
    WAIT_BAR(3);
    s16x4 vlo[8], vhi[8]; u32x4 pw0, pw1, pw2, pw3;
#define PKW(P, B) cvtpk_s(P[B], P[B + 1])
#define PAF(k) __builtin_bit_cast(bf16x8, pw##k)
#define VFR(i) (bf16x8){vlo[i][0], vlo[i][1], vlo[i][2], vlo[i][3], vhi[i][0], vhi[i][1], vhi[i][2], vhi[i][3]}
#define PIN(x) asm volatile("" : "+v"(x))
#define MX3(a, b, c) __builtin_fmaxf(__builtin_fmaxf((a), (b)), (c))
#define GAPA(MF, A0, A1, A2, A3, W0, W1, PW) do { MF; sacc += A0; sacc += A1; sacc += A2; sacc += A3; PIN(sacc); W0; W1; PIN(PW); SBAR(); } while (0)
#define EX(v) __builtin_amdgcn_exp2f(v)
#define GAPB(MF, X, B) do { MF; X[B] = EX(X[B]); X[B + 1] = EX(X[B + 1]); X[B + 2] = EX(X[B + 2]); X[B + 3] = EX(X[B + 3]); PIN(X); SBAR(); } while (0)
#define VRD(i) do { vlo[i] = vtr(vp_ + (((i) >> 2) * 4096 + ((i) & 3) * 1024)); vhi[i] = vtr(vp_ + (((i) >> 2) * 4096 + ((i) & 3) * 1024 + 512)); } while (0)
#define KRD(G, j) do { if (G) { kload2(kf, kp0 + sl_next, j); SBAR(); } } while (0)
#define STEP(C0, C1, P0, P1, t, GK, GV, GM, GL, GB) do { SBAR(); \
    const lds_cptr vp_ = vp0 + sl_prev; \
    const u32x2 mw_ = *(const LAS u32x2*)(mp0 + (sl_cur >> 2)); \
    VRD(0); SBAR(); float sacc = (P0[0] + P0[1]); \
    GAPA(C0 = __builtin_amdgcn_mfma_f32_32x32x16_bf16(kf[0], qr[0], zero16, 0, 0, 0), P0[2], P0[3], P0[4], P0[5],     pw0[0] = PKW(P0, 0), pw0[1] = PKW(P0, 2), pw0); \
    VRD(4); SBAR(); GAPA(C1 = __builtin_amdgcn_mfma_f32_32x32x16_bf16(kf[1], qr[0], zero16, 0, 0, 0), P0[6], P0[7], P0[8], P0[9],     pw0[2] = PKW(P0, 4), pw0[3] = PKW(P0, 6), pw0); \
    VRD(1); SBAR(); GAPA(C0 = __builtin_amdgcn_mfma_f32_32x32x16_bf16(kf[2], qr[1], C0, 0, 0, 0),   P0[10], P0[11], P0[12], P0[13], pw1[0] = PKW(P0, 8), pw1[1] = PKW(P0, 10), pw1); \
    VRD(5); SBAR(); GAPA(C1 = __builtin_amdgcn_mfma_f32_32x32x16_bf16(kf[3], qr[1], C1, 0, 0, 0),   P0[14], P0[15], P1[0], P1[1],   pw1[2] = PKW(P0, 12), pw1[3] = PKW(P0, 14), pw1); \
    VRD(2); SBAR(); GAPA(C0 = __builtin_amdgcn_mfma_f32_32x32x16_bf16(kf[4], qr[2], C0, 0, 0, 0),   P1[2], P1[3], P1[4], P1[5],     pw2[0] = PKW(P1, 0), pw2[1] = PKW(P1, 2), pw2); \
    VRD(6); SBAR(); GAPA(C1 = __builtin_amdgcn_mfma_f32_32x32x16_bf16(kf[5], qr[2], C1, 0, 0, 0),   P1[6], P1[7], P1[8], P1[9],     pw2[2] = PKW(P1, 4), pw2[3] = PKW(P1, 6), pw2); \
    VRD(3); SBAR(); GAPA(C0 = __builtin_amdgcn_mfma_f32_32x32x16_bf16(kf[6], qr[3], C0, 0, 0, 0),   P1[10], P1[11], P1[12], P1[13], pw3[0] = PKW(P1, 8), pw3[1] = PKW(P1, 10), pw3); \
    VRD(7); SBAR(); GAPA(C1 = __builtin_amdgcn_mfma_f32_32x32x16_bf16(kf[7], qr[3], C1, 0, 0, 0),   P1[14], P1[15], 0.f, 0.f,       pw3[2] = PKW(P1, 12), pw3[3] = PKW(P1, 14), pw3); \
    l_reg += sacc; \
    if (GK) { DMA_K((t) + 3, sl_cur); } if (GV) { DMA_V((t) + 1, sl_next); } if (GM) { DMA_M((t) + 2, sl_prev); } \
    apply_mask(C0, C1, mw_.x >> (4 * hi), mw_.y >> (4 * hi), mhat); \
    if (GB) { apply_bias(C0, C1, BIASP(t)); } \
    { float a = MX3(C0[0], C0[1], C1[0]), b = MX3(C0[2], C0[3], C1[1]); a = MX3(a, C1[2], C1[3]); \
      _Pragma("unroll") for (int r = 4; r < 16; r += 4) { a = MX3(a, C0[r], C0[r + 1]); b = MX3(b, C0[r + 2], C0[r + 3]); a = MX3(a, C1[r], C1[r + 1]); b = MX3(b, C1[r + 2], C1[r + 3]); } \
      float rm = __builtin_fmaxf(a, b); { auto rr = __builtin_amdgcn_permlane32_swap(__float_as_uint(rm), __float_as_uint(rm), false, false); rm = __builtin_fmaxf(__uint_as_float(rr[0]), __uint_as_float(rr[1])); } \
      resc = false; \
      if (__builtin_expect(__any(rm > (float)THRL), 0)) { const float dl = __builtin_fmaxf(rm, 0.f); mhat += dl; \
        _Pragma("unroll") for (int r = 0; r < 16; ++r) { C0[r] -= dl; C1[r] -= dl; } \
        const float f = __builtin_amdgcn_exp2f(-dl); l_reg *= f; if (hi == 0) wsf[r32] = f; resc = true; } } \
    SBAR(); \
    GAPB(o[0] = __builtin_amdgcn_mfma_f32_32x32x16_bf16(PAF(0), VFR(0), o[0], 0, 0, 0), C0, 0); \
    GAPB(o[1] = __builtin_amdgcn_mfma_f32_32x32x16_bf16(PAF(0), VFR(4), o[1], 0, 0, 0), C0, 4); \
    KRD(GL, 0); GAPB(o[0] = __builtin_amdgcn_mfma_f32_32x32x16_bf16(PAF(1), VFR(1), o[0], 0, 0, 0), C0, 8); \
    KRD(GL, 1); GAPB(o[1] = __builtin_amdgcn_mfma_f32_32x32x16_bf16(PAF(1), VFR(5), o[1], 0, 0, 0), C0, 12); \
    KRD(GL, 2); GAPB(o[0] = __builtin_amdgcn_mfma_f32_32x32x16_bf16(PAF(2), VFR(2), o[0], 0, 0, 0), C1, 0); \
    KRD(GL, 3); GAPB(o[1] = __builtin_amdgcn_mfma_f32_32x32x16_bf16(PAF(2), VFR(6), o[1], 0, 0, 0), C1, 4); \
    GAPB(o[0] = __builtin_amdgcn_mfma_f32_32x32x16_bf16(PAF(3), VFR(3), o[0], 0, 0, 0), C1, 8); \
    GAPB(o[1] = __builtin_amdgcn_mfma_f32_32x32x16_bf16(PAF(3), VFR(7), o[1], 0, 0, 0), C1, 12); \
    } while (0)
    int t = 1;
    for (; t + 7 < NT; t += 2) {
        STEP(pB0, pB1, pA0, pA1, t, true, true, true, true, false);     WAIT_BAR(3); RESC(); ROT();
        STEP(pA0, pA1, pB0, pB1, t + 1, true, true, true, true, false); WAIT_BAR(3); RESC(); ROT();
    }
#define ENDW(tt) do { if ((tt) + 3 < NT) { WAIT_BAR(3); } else if ((tt) + 2 < NT) { WAIT_BAR(2); } else { WAIT_BAR(0); } } while (0)
    for (; t + 1 < NT; t += 2) {
        STEP(pB0, pB1, pA0, pA1, t, (t + 3 < NT), (t + 1 < NT), (t + 2 < NT), (t + 1 < NT), (t + 7 >= NT));         ENDW(t);     RESC(); ROT();
        STEP(pA0, pA1, pB0, pB1, t + 1, (t + 4 < NT), (t + 2 < NT), (t + 3 < NT), (t + 2 < NT), (t + 8 >= NT));     ENDW(t + 1); RESC(); ROT();
    }
    STEP(pB0, pB1, pA0, pA1, NT - 1, false, false, false, false, true); RESC();
    { float sacc = pB0[0] + pB0[1]; _Pragma("unroll") for (int r = 2; r < 16; ++r) sacc += pB0[r]; _Pragma("unroll") for (int r = 0; r < 16; ++r) sacc += pB1[r]; l_reg += sacc;
      pw0 = (u32x4){PKW(pB0, 0), PKW(pB0, 2), PKW(pB0, 4), PKW(pB0, 6)}; pw1 = (u32x4){PKW(pB0, 8), PKW(pB0, 10), PKW(pB0, 12), PKW(pB0, 14)}; pw2 = (u32x4){PKW(pB1, 0), PKW(pB1, 2), PKW(pB1, 4), PKW(pB1, 6)}; pw3 = (u32x4){PKW(pB1, 8), PKW(pB1, 10), PKW(pB1, 12), PKW(pB1, 14)};
      SBAR(); pv(o, vb0 + sl_cur, PAF(0), PAF(1), PAF(2), PAF(3)); }
#undef PKW
#undef PAF
#undef VFR
#undef PIN
#undef MX3
#undef GAPA
#undef GAPB
#undef EX
#undef VRD
#undef KRD
#undef STEP
#undef ENDW
    { auto rr = __builtin_amdgcn_permlane32_swap(__float_as_uint(l_reg), __float_as_uint(l_reg), false, false); l_reg = __uint_as_float(rr[0]) + __uint_as_float(rr[1]); }
    if (hi == 0) wsf[32 + r32] = l_reg; asm volatile("s_waitcnt lgkmcnt(0)" ::: "memory");
    float rli[16];
#pragma unroll
    for (int r = 0; r < 16; ++r) rli[r] = __builtin_amdgcn_rcpf(wsf[32 + crow(r, hi)]);
    bf16_t* Ow = O + (rowbase + q0 + wid * QBLK) * OP + h * D;
    { bf16_t* stg = (bf16_t*)(shm + LDS_OST) + wid * 2048;
#pragma unroll
      for (int r = 0; r < 16; ++r) { const int orow = crow(r, hi);
#pragma unroll
          for (int d0 = 0; d0 < 2; ++d0) stg[orow * 64 + d0 * 32 + r32] = (bf16_t)f2bf(o[d0][r] * rli[r]); }
      asm volatile("s_waitcnt lgkmcnt(0)" ::: "memory");
#pragma unroll
      for (int i = 0; i < 4; ++i) { const int row = i * 8 + (lane >> 3), ch = lane & 7; const u32x4 v = *(const u32x4*)(stg + row * 64 + ch * 8); *(u32x4*)(Ow + (long)row * OP + ch * 8) = v; } }
    asm volatile("s_waitcnt lgkmcnt(0)\n\ts_barrier" ::: "memory");
#undef DMA_K
#undef DMA_V
#undef DMA_M
#undef START
#undef RESC
#undef ROT
#undef BIASP
}
#undef SBAR
#undef WAIT_BAR
}
constexpr size_t MiB = 1u << 20;
constexpr size_t WS_CTL = 0, CTL_ZERO_BYTES = 1 * MiB;
constexpr size_t WS_MOD = 1 * MiB;
constexpr size_t WS_ROT = 2 * MiB;
constexpr size_t WS_TOPE = 4 * MiB;
constexpr size_t WS_GATE = WS_TOPE + 512 * 1024;
constexpr size_t WS_RANK = 5 * MiB;
constexpr size_t WS_POS = WS_RANK + 512 * 1024;
constexpr size_t WS_ROWTOK = 6 * MiB;
constexpr size_t WS_ROWGATE = 7 * MiB;
constexpr size_t WS_BLKEXP = 8 * MiB;
constexpr size_t WS_WIN = 10 * MiB;
constexpr size_t WS_WOUT = 17 * MiB;
constexpr size_t WS_WGU = 20 * MiB;
constexpr size_t WS_WD = 148 * MiB;
constexpr size_t WS_X1 = 212 * MiB;
constexpr size_t WS_H2 = 340 * MiB;
constexpr size_t WS_ACT = 404 * MiB;
constexpr size_t WS_Y = 676 * MiB;
constexpr size_t WS_END = 948 * MiB;
constexpr size_t WS_H = 404 * MiB;
constexpr size_t WS_QA = 468 * MiB, WS_KA = 500 * MiB, WS_VA = 508 * MiB, WS_QI = 516 * MiB, WS_KIW = 532 * MiB;
constexpr size_t WS_QR = 540 * MiB, WS_KR = 572 * MiB, WS_VR = 604 * MiB, WS_GR = 636 * MiB;
constexpr size_t WS_MASK = 668 * MiB;
constexpr size_t WS_U = 684 * MiB;
constexpr size_t WS_S = 748 * MiB;
static_assert(WS_S + 32 * MiB <= WS_END, "ws map");
constexpr int CW_BAR = 4096;
constexpr int CW_CNT = 1024;

constexpr int NWAVES = 8;
constexpr int LDS_BYTES = 160 * 1024;

#define XB_TMO      128
#define XB_XCNT(j)  (256  + 64 * (j))
#define XB_XSUB(j)  (1280 + 64 * (j))
#define XB_XGEN(j)  (2304 + 64 * (j))
#define XB_TOP      3328
#define XB_TOPGEN   3392
#define XCD_BAR_WORDS 3456
#define XB_SPIN_CAP (1u << 22)
__device__ __forceinline__ unsigned xb_ld(unsigned* p)              { return __hip_atomic_load(p, __ATOMIC_RELAXED, __HIP_MEMORY_SCOPE_AGENT); }
__device__ __forceinline__ unsigned xb_add(unsigned* p, unsigned v) { return __hip_atomic_fetch_add(p, v, __ATOMIC_RELAXED, __HIP_MEMORY_SCOPE_AGENT); }
__device__ __forceinline__ unsigned xb_xcc_id() { return (unsigned)__builtin_amdgcn_s_getreg((3 << 11) | 20) & 0xFu; }
#define XB_SPIN(cond, bar) do { unsigned _sp = 0; while (cond) { __builtin_amdgcn_s_sleep(1); \
    if ((++_sp & 255u) == 0u) { if (xb_ld(&(bar)[XB_TMO])) break; if (_sp > XB_SPIN_CAP) { atomicAdd(&(bar)[XB_TMO], 1u); break; } } } } while (0)
struct XcdBarrier { unsigned* bar; unsigned x; volatile LAS unsigned* st; };
__device__ __forceinline__ XcdBarrier xcd_barrier_post(unsigned* bar, volatile LAS unsigned* st) {
    XcdBarrier b; b.bar = bar; b.x = xb_xcc_id(); b.st = st;
    if (threadIdx.x == 0) (void)xb_add(&bar[XB_XCNT(b.x)], 1u);
    return b;
}
__device__ __forceinline__ void xcd_barrier_complete(unsigned* bar, unsigned x, unsigned& nloc, unsigned& nx) {
    const unsigned G = gridDim.x * gridDim.y * gridDim.z;
    unsigned sum, cnt, mine, sp = 0u;
    for (;;) {
        sum = 0u; cnt = 0u; mine = 0u;
#pragma unroll
        for (unsigned j = 0; j < 16; ++j) { const unsigned c = xb_ld(&bar[XB_XCNT(j)]); sum += c; cnt += (c > 0u) ? 1u : 0u; mine = (j == x) ? c : mine; }
        if (sum == G) break;
        __builtin_amdgcn_s_sleep(1);
        if ((++sp & 255u) == 0u) { if (xb_ld(&bar[XB_TMO])) break; if (sp > XB_SPIN_CAP) { atomicAdd(&bar[XB_TMO], 1u); break; } }
    }
    nloc = mine > 0u ? mine : 1u; nx = cnt > 0u ? cnt : 1u;
}
__device__ __forceinline__ void xcd_barrier(const XcdBarrier& b) {
    asm volatile("s_waitcnt vmcnt(0)" ::: "memory");
    __syncthreads();
    if (threadIdx.x == 0) {
        unsigned* bar = b.bar;
        __builtin_amdgcn_s_waitcnt(0);
        unsigned nloc = b.st[0], nx = b.st[1];
        if (nloc == 0u) { xcd_barrier_complete(bar, b.x, nloc, nx); b.st[0] = nloc; b.st[1] = nx; }
        const unsigned old = xb_add(&bar[XB_XSUB(b.x)], 1u);
        const unsigned gen = old / nloc;
        if (old + 1u == (gen + 1u) * nloc) {
            __builtin_amdgcn_fence(__ATOMIC_RELEASE, "agent");
            asm volatile("s_waitcnt vmcnt(0)" ::: "memory");
            const unsigned og = xb_add(&bar[XB_TOP], 1u);
            const unsigned tg = og / nx;
            if (og + 1u == (tg + 1u) * nx) xb_add(&bar[XB_TOPGEN], 1u);
            else XB_SPIN(xb_ld(&bar[XB_TOPGEN]) == tg, bar);
            __builtin_amdgcn_fence(__ATOMIC_ACQUIRE, "agent");
            xb_add(&bar[XB_XGEN(b.x)], 1u);
            asm volatile("s_waitcnt vmcnt(0)" ::: "memory");
        } else {
            XB_SPIN(xb_ld(&bar[XB_XGEN(b.x)]) == gen, bar);
            __builtin_amdgcn_fence(__ATOMIC_ACQUIRE, "agent");
            asm volatile("s_waitcnt vmcnt(0)" ::: "memory");
        }
    }
    __syncthreads();
}

struct Frame {
    unsigned char* ws; int tid, lane, wave, vcu, G;
    const float *x, *c, *rel_bias, *w_ada, *b_ada, *w_in, *ret_g, *w_out, *ln1_g, *ln1_b, *w_router, *b_router, *w_gu, *b_gu, *w_d, *b_d, *ln2_g, *ln2_b;
    float* out;
};
__device__ __forceinline__ float wave_sum(float v) {
#pragma unroll
    for (int o = 1; o < 64; o <<= 1) v += __shfl_xor(v, o);
    return v;
}
__device__ __forceinline__ float wave_max(float v) {
#pragma unroll
    for (int o = 1; o < 64; o <<= 1) v = fmaxf(v, __shfl_xor(v, o));
    return v;
}
#define LDS_WAIT() asm volatile("s_waitcnt lgkmcnt(0)" ::: "memory")
__device__ __forceinline__ void p0_transpose_item(const float* W, int K, int N, int src_col0, bf16_t* WT, int dest_row0, int k0, LAS float* scr, int lane) {
#pragma unroll 8
    for (int i = 0; i < 32; ++i) { const int kk = 2 * i + (lane >> 5); scr[kk * 33 + (lane & 31)] = W[(size_t)(k0 + kk) * N + src_col0 + (lane & 31)]; }
    LDS_WAIT(); asm volatile("" ::: "memory");
    const int c = lane & 7;
#pragma unroll
    for (int j = 0; j < 4; ++j) { const int n = (lane >> 3) + 8 * j; const LAS float* s = scr + (8 * c) * 33 + n;
        u32x4 o; o.x = pk2(s[0 * 33], s[1 * 33]); o.y = pk2(s[2 * 33], s[3 * 33]); o.z = pk2(s[4 * 33], s[5 * 33]); o.w = pk2(s[6 * 33], s[7 * 33]);
        *(u32x4*)(WT + (size_t)(dest_row0 + n) * K + k0 + 8 * c) = o; }
    LDS_WAIT(); asm volatile("" ::: "memory");
}
__device__ __forceinline__ void p0_prologue(Frame& F, LAS unsigned char* lds) {
    LAS float* scr = (LAS float*)(lds + F.wave * 16384);
    const int gw = F.vcu * NWAVES + F.wave, NGW = F.G * NWAVES;
    bf16_t* WinT = (bf16_t*)(F.ws + WS_WIN); bf16_t* WoutT = (bf16_t*)(F.ws + WS_WOUT); bf16_t* WguT = (bf16_t*)(F.ws + WS_WGU); bf16_t* WdT = (bf16_t*)(F.ws + WS_WD);
    {
        LAS float* red = (LAS float*)(lds + 131072);
        for (int it = F.vcu; it < 96; it += F.G) {
            const int n = it * 64 + F.lane; float a[8];
#pragma unroll
            for (int b = 0; b < 8; ++b) a[b] = 0.f;
            for (int k = F.wave * 128; k < F.wave * 128 + 128; ++k) {
                const float w = F.w_ada[(size_t)k * 6144 + n];
#pragma unroll
                for (int b = 0; b < 8; ++b) { const float cv = F.c[b * DM + k]; const float sl = cv / (1.f + __expf(-cv)); a[b] = fmaf(sl, w, a[b]); }
            }
#pragma unroll
            for (int b = 0; b < 8; ++b) red[(F.wave * 8 + b) * 64 + F.lane] = a[b];
            __syncthreads();
            { const int b = F.wave; float s = F.b_ada[n];
#pragma unroll
              for (int w = 0; w < 8; ++w) s += red[(w * 8 + b) * 64 + F.lane];
              ((float*)(F.ws + WS_MOD))[b * 6144 + n] = s; }
            __syncthreads();
        }
    }
    {
        float* rc = (float*)(F.ws + WS_ROT); float* rs = rc + SEQ * 64;
        for (int i = (F.vcu * 512 + F.tid); i < SEQ * 64; i += F.G * 512) { const int t = i >> 6, j = i & 63;
            const float inv = 1.0f / powf(10000.0f, (float)(2 * j) / 128.0f); const float ang = (float)t * inv;
            rc[i] = (float)cos((double)ang); rs[i] = (float)sin((double)ang); }
    }
    constexpr int I_IN_A = 34 * 16, I_IN_B = 64 * 16, I_OUT = 32 * 16, I_GU = 32 * 64 * 16, I_D = 32 * 32 * 16, I_PAD = 192;
    constexpr int NITEMS = I_IN_A + I_IN_B + I_OUT + I_GU + I_D + I_PAD;
    for (int it = gw; it < NITEMS; it += NGW) {
        int r = it;
        if (r < I_IN_A) { const int nb = r >> 4, kb = r & 15; p0_transpose_item(F.w_in, DM, DIN_SRC, 32 * nb, WinT, 32 * nb, 64 * kb, scr, F.lane); continue; } r -= I_IN_A;
        if (r < I_IN_B) { const int nb = r >> 4, kb = r & 15; p0_transpose_item(F.w_in, DM, DIN_SRC, 1092 + 32 * nb, WinT, 1280 + 32 * nb, 64 * kb, scr, F.lane); continue; } r -= I_IN_B;
        if (r < I_OUT) { const int nb = r >> 4, kb = r & 15; p0_transpose_item(F.w_out, DM, DM, 32 * nb, WoutT, 32 * nb, 64 * kb, scr, F.lane); continue; } r -= I_OUT;
        if (r < I_GU) { const int e = r >> 10, q = r & 1023, nb = q >> 4, kb = q & 15; const int n0 = 32 * nb;
            const int half = n0 >> 10, nn = n0 & 1023; const int drow = e * 2048 + (nn >> 7) * 256 + half * 128 + (nn & 127);
            p0_transpose_item(F.w_gu + (size_t)e * DM * 2048, DM, 2048, n0, WguT, drow, 64 * kb, scr, F.lane); continue; } r -= I_GU;
        if (r < I_D) { const int e = r >> 9, q = r & 511, nb = q >> 4, kb = q & 15;
            p0_transpose_item(F.w_d + (size_t)e * DFF * DM, DFF, DM, 32 * nb, WdT, e * 1024 + 32 * nb, 64 * kb, scr, F.lane); continue; } r -= I_D;
        { const int row = 1088 + r;
          for (int k = F.lane; k < DM; k += 64) WinT[(size_t)row * DM + k] = (row < 1092) ? (bf16_t)f2bf(F.w_in[(size_t)k * DIN_SRC + row]) : (bf16_t)0; }
    }
}
__device__ __forceinline__ void p1_modulate(Frame& F) {
    const int gw = F.vcu * NWAVES + F.wave, NGW = F.G * NWAVES;
    const float* mod = (const float*)(F.ws + WS_MOD); bf16_t* H = (bf16_t*)(F.ws + WS_H);
    for (int m = gw; m < NTOK; m += NGW) {
        const int b = m / SEQ; const f32x4* xr = (const f32x4*)(F.x + (size_t)m * DM) + F.lane;
        const f32x4* sh = (const f32x4*)(mod + (size_t)b * 6144) + F.lane; const f32x4* sc = (const f32x4*)(mod + (size_t)b * 6144 + DM) + F.lane;
        unsigned long long* o8 = (unsigned long long*)(H + (size_t)m * DM) + F.lane;
#pragma unroll
        for (int j = 0; j < 4; ++j) { const f32x4 v = xr[64 * j] * (sc[64 * j] + 1.0f) + sh[64 * j];
            o8[64 * j] = (unsigned long long)pk2(v.x, v.y) | ((unsigned long long)pk2(v.z, v.w) << 32); }
    }
}
__device__ __forceinline__ unsigned sortable(float s) { s = s + 0.0f; const unsigned u = __float_as_uint(s); return (u & 0x80000000u) ? ~u : (u | 0x80000000u); }

#define CNT_OP(OP, c, a, b) asm volatile("v_cmp_" OP "_u32 vcc, %1, %2\n\tv_addc_co_u32 %0, vcc, 0, %0, vcc" : "+v"(c) : "v"(a), "v"(b) : "vcc")
__device__ __forceinline__ void select_item(Frame& F, LAS unsigned char* lds, int b, int qblk) {
    const int lane = F.lane, wid = F.wave, qn = lane & 15, kq = lane >> 4;
    const int t0 = qblk * 16, ntile = qblk + 1;
    const bf16_t* QI = (const bf16_t*)(F.ws + WS_QI); const bf16_t* KIW = (const bf16_t*)(F.ws + WS_KIW);
    LAS unsigned char* kst = lds;
    LAS unsigned* cntbuf = (LAS unsigned*)(lds + 131072);
    LAS unsigned* lmask = (LAS unsigned*)(lds + 131072 + 1024);
    LAS unsigned* flag = (LAS unsigned*)(lds + 131072 + 1024 + 8192);
    const size_t rowq = (size_t)b * SEQ + t0 + qn;
    bf16x8 bq[4][2]; float wv[4];
#pragma unroll
    for (int h = 0; h < 4; ++h) {
#pragma unroll
        for (int s = 0; s < 2; ++s) bq[h][s] = *(const bf16x8*)(QI + rowq * 256 + h * 64 + s * 32 + kq * 8);
        wv[h] = 0.5f * bf2f(KIW[rowq * 128 + 64 + h]); }
    { int tz = F.tid; asm volatile("" : "+v"(tz));
#pragma unroll 1
      for (int i = tz; i < 2048; i += 512) lmask[i] = 0u; }
    unsigned key[32][4];
    int ibase_i = 16 * wid + 4 * kq; asm volatile("" : "+v"(ibase_i));
    const unsigned ibase = (unsigned)ibase_i;
    const int dq = t0 + qn - ibase_i;
    int fragoff0 = (16 * wid + qn) * 128 + ((kq ^ (qn & 7)) << 4), fragoff1 = (16 * wid + qn) * 128 + (((4 + kq) ^ (qn & 7)) << 4); asm volatile("" : "+v"(fragoff0), "+v"(fragoff1));
#pragma unroll
    for (int ch = 0; ch < 4; ++ch) {
        if (ch * 64 < ntile) {
            __syncthreads();
            { const int nrow = min(1024, t0 + 16 - ch * 1024);
              int srow = F.tid >> 3; asm volatile("" : "+v"(srow));
              const int spc = F.tid & 7;
              const bf16_t* gsrc = KIW + ((size_t)b * SEQ + ch * 1024 + srow) * 128 + spc * 8;
              LAS unsigned char* ldst = kst + srow * 128 + ((spc ^ (srow & 7)) << 4);
              for (int jr = 0; jr < 2; ++jr) {
              u32x4 tmp[8];
#pragma unroll
              for (int j = 0; j < 8; ++j) { const int jj = jr * 8 + j; if (srow + 64 * jj < nrow) tmp[j] = *(const u32x4*)(gsrc + (size_t)jj * 64 * 128); }
#pragma unroll
              for (int j = 0; j < 8; ++j) { const int jj = jr * 8 + j; if (srow + 64 * jj < nrow) *(LAS u32x4*)(ldst + jj * 8192) = tmp[j]; } } }
            __syncthreads();
#pragma unroll
            for (int ii = 0; ii < 8; ++ii) {
                const int i = ch * 8 + ii; const int T = wid + 8 * i;
                if (T < ntile) {
                    const bf16x8 a0 = *(const LAS bf16x8*)(kst + fragoff0 + 16384 * ii), a1 = *(const LAS bf16x8*)(kst + fragoff1 + 16384 * ii);
                    f32x4 sc = {0.f, 0.f, 0.f, 0.f};
#pragma unroll
                    for (int h = 0; h < 4; ++h) { f32x4 c = {0.f, 0.f, 0.f, 0.f};
                        c = __builtin_amdgcn_mfma_f32_16x16x32_bf16(a0, bq[h][0], c, 0, 0, 0); c = __builtin_amdgcn_mfma_f32_16x16x32_bf16(a1, bq[h][1], c, 0, 0, 0);
#pragma unroll
                        for (int r = 0; r < 4; ++r) sc[r] = fmaf(wv[h], fmaxf(c[r], 0.f), sc[r]); }
#pragma unroll
                    for (int r = 0; r < 4; ++r) key[i][r] = (128 * i + r <= dq) ? sortable(sc[r]) : 0u;
                } else {
#pragma unroll
                    for (int r = 0; r < 4; ++r) key[i][r] = 0u;
                }
            }
        } else {
#pragma unroll
            for (int ii = 0; ii < 8; ++ii)
#pragma unroll
                for (int r = 0; r < 4; ++r) key[ch * 8 + ii][r] = 0u;
        }
    }
    int par = 0;
#define SEL_REDUCE(cnt_, out_) do { unsigned c_ = (cnt_); c_ += __shfl_xor(c_, 16); c_ += __shfl_xor(c_, 32); \
        if (kq == 0) cntbuf[(par * 8 + wid) * 16 + qn] = c_; __syncthreads(); unsigned s_ = 0; \
        _Pragma("unroll") for (int w_ = 0; w_ < 8; ++w_) s_ += cntbuf[(par * 8 + w_) * 16 + qn]; par ^= 1; (out_) = s_; } while (0)
    const unsigned KSEL = 256u;
    unsigned thr = 0u;
    for (int bit = 31; bit >= 0; --bit) {
        const unsigned cand = thr | (1u << bit); unsigned c = 0;
#pragma unroll
        for (int i = 0; i < 32; ++i)
#pragma unroll
            for (int r = 0; r < 4; ++r) CNT_OP("ge", c, key[i][r], cand);
        unsigned tot; SEL_REDUCE(c, tot);
        if (tot >= KSEL) thr = cand;
    }
    unsigned cg = 0, ce = 0;
#pragma unroll
    for (int i = 0; i < 32; ++i)
#pragma unroll
        for (int r = 0; r < 4; ++r) { CNT_OP("gt", cg, key[i][r], thr); CNT_OP("eq", ce, key[i][r], thr); }
    unsigned cgt, ceq; { unsigned pk = cg | (ce << 16); unsigned tot; SEL_REDUCE(pk, tot); cgt = tot & 0xffffu; ceq = tot >> 16; }
    const unsigned need = KSEL - cgt;
    const bool excess = (thr != 0u) && (ceq > need);
    if (F.tid == 0) flag[0] = 0u;
    __syncthreads();
    if (excess) flag[0] = 1u;
    __syncthreads();
    { const unsigned teq = thr ? thr : 0xffffffffu, lowv = 0xfffffffeu;
#pragma unroll
      for (int i = 0; i < 32; ++i)
#pragma unroll
          for (int r = 0; r < 4; ++r) { unsigned idxv; unsigned k;
              asm volatile("v_add_u32 %0, %5, %4\n\tv_cmp_eq_u32 vcc, %1, %2\n\tv_cndmask_b32 %0, %3, %0, vcc" : "=&v"(idxv) : "v"(key[i][r]), "v"(teq), "v"(lowv), "v"(ibase), "i"(128 * i + r) : "vcc");
              asm volatile("v_cmp_gt_u32 vcc, %1, %2\n\tv_cndmask_b32 %0, %3, -1, vcc" : "=v"(k) : "v"(key[i][r]), "v"(thr), "v"(idxv) : "vcc");
              key[i][r] = k; } }
    unsigned cut = 0xffffu;
    if (flag[0] != 0u) {
        unsigned ans = 0u;
        for (int bit = 11; bit >= 0; --bit) {
            const unsigned cand = ans | (1u << bit); unsigned c = 0;
#pragma unroll
            for (int i = 0; i < 32; ++i)
#pragma unroll
                for (int r = 0; r < 4; ++r) CNT_OP("lt", c, key[i][r], cand);
            unsigned tot; SEL_REDUCE(c, tot);
            if (tot < need) ans = cand;
        }
        if (excess) cut = ans;
    }
    { const unsigned cut1 = cut + 1u; int mbase = qn * 128 + (wid >> 1); asm volatile("" : "+v"(mbase)); const int msh = 16 * (wid & 1) + 4 * kq;
#pragma unroll
      for (int i = 0; i < 32; ++i) {
          unsigned nib = 0;
#pragma unroll
          for (int r = 3; r >= 0; --r) { unsigned t_;
              asm volatile("v_add_u32 %1, 1, %2\n\tv_cmp_le_u32 vcc, %1, %3\n\tv_addc_co_u32 %0, vcc, %0, %0, vcc" : "+v"(nib), "=&v"(t_) : "v"(key[i][r]), "v"(cut1) : "vcc"); }
          if (nib) atomicOr((unsigned*)&lmask[mbase + 4 * i], nib << msh); } }
    __syncthreads();
    { unsigned* mask = (unsigned*)(F.ws + WS_MASK); const int ntile64 = 4 * (t0 / 256 + 1);
      int tl0 = F.tid >> 5; asm volatile("" : "+v"(tl0)); const int q = (F.tid >> 1) & 15, w = F.tid & 1;
      unsigned* mp = mask + (((size_t)b * 64 + tl0) * SEQ + t0 + q) * 2 + w; const LAS unsigned* lp = lmask + q * 128 + tl0 * 2 + w;
#pragma unroll 1
      for (int tl = tl0; tl < ntile64; tl += 16) { *mp = *lp; mp += (size_t)16 * SEQ * 2; lp += 32; } }
    __syncthreads();
#undef SEL_REDUCE
#undef CNT_OP
}
constexpr int RP = 272;
constexpr int RT = 128 * RP;
__device__ __forceinline__ void block_gemm128(f32x16 (&acc)[2], const LAS unsigned char* A, const LAS unsigned char* Bt, int wr, int wc, int r32, int hi) {
#pragma unroll
    for (int ks = 0; ks < 8; ++ks) {
        const bf16x8 a = *(const LAS bf16x8*)(A + (32 * wr + r32) * RP + ks * 32 + hi * 16);
#pragma unroll
        for (int n = 0; n < 2; ++n) { const bf16x8 bf = *(const LAS bf16x8*)(Bt + (64 * wc + 32 * n + r32) * RP + ks * 32 + hi * 16);
            acc[n] = __builtin_amdgcn_mfma_f32_32x32x16_bf16(bf, a, acc[n], 0, 0, 0); }
    }
}
__device__ __forceinline__ float ret_gamma_log2(int h) { return log2f(1.0f - exp2f(-5.0f - (float)h)); }

template <bool ROT, bool TR>
__device__ __forceinline__ void ret_stage(Frame& F, LAS unsigned char* dst, const bf16_t* src, int b, int h, int c, float sc, float rowdecay_l2  ) {
    const float* rc = (const float*)(F.ws + WS_ROT); const float* rs = rc + SEQ * 64;
    const int i = F.tid >> 2, q = F.tid & 3;
    const int t = c * 128 + i; const bf16_t* row = src + ((size_t)b * SEQ + t) * 512 + h * 128;
    const float rsc = sc * ((rowdecay_l2 != 0.f) ? exp2f(rowdecay_l2 * (float)(127 - i)) : 1.0f);
#pragma unroll
    for (int m = 0; m < 2; ++m) {
        const int d0 = 8 * q + 32 * m;
        const bf16x8 x1 = *(const bf16x8*)(row + d0), x2 = *(const bf16x8*)(row + d0 + 64);
        float o1[8], o2[8];
        if (ROT) {
            const f32x4 c0 = *(const f32x4*)(rc + (size_t)t * 64 + d0), c1 = *(const f32x4*)(rc + (size_t)t * 64 + d0 + 4);
            const f32x4 s0 = *(const f32x4*)(rs + (size_t)t * 64 + d0), s1 = *(const f32x4*)(rs + (size_t)t * 64 + d0 + 4);
#pragma unroll
            for (int j = 0; j < 8; ++j) { const float a = bf2f((unsigned short)x1[j]), bb = bf2f((unsigned short)x2[j]); const float cs = j < 4 ? c0[j] : c1[j - 4], sn = j < 4 ? s0[j] : s1[j - 4];
                o1[j] = (a * cs - bb * sn) * rsc; o2[j] = (a * sn + bb * cs) * rsc; }
        } else {
#pragma unroll
            for (int j = 0; j < 8; ++j) { o1[j] = bf2f((unsigned short)x1[j]) * rsc; o2[j] = bf2f((unsigned short)x2[j]) * rsc; }
        }
        if (!TR) {
            u32x4 w1, w2; w1.x = pk2(o1[0], o1[1]); w1.y = pk2(o1[2], o1[3]); w1.z = pk2(o1[4], o1[5]); w1.w = pk2(o1[6], o1[7]);
            w2.x = pk2(o2[0], o2[1]); w2.y = pk2(o2[2], o2[3]); w2.z = pk2(o2[4], o2[5]); w2.w = pk2(o2[6], o2[7]);
            *(LAS u32x4*)(dst + i * RP + d0 * 2) = w1; *(LAS u32x4*)(dst + i * RP + (d0 + 64) * 2) = w2;
        } else {
#pragma unroll
            for (int j = 0; j < 8; ++j) { *(LAS bf16_t*)(dst + (d0 + j) * RP + i * 2) = (bf16_t)f2bf(o1[j]); *(LAS bf16_t*)(dst + (d0 + 64 + j) * RP + i * 2) = (bf16_t)f2bf(o2[j]); }
        }
    }
}
__device__ __forceinline__ void ret_state_item(Frame& F, LAS unsigned char* lds, int unit) {
    const int b = unit >> 7, h = (unit >> 5) & 3, c = unit & 31;
    const int lane = F.lane, wid = F.wave, wr = wid >> 1, wc = wid & 1, r32 = lane & 31, hi = lane >> 5;
    LAS unsigned char* Vt = lds; LAS unsigned char* Kt = lds + RT;
    const float lg = ret_gamma_log2(h);
    ret_stage<false, true>(F, Vt, (const bf16_t*)(F.ws + WS_VR), b, h, c, 1.0f, 0.f);
    ret_stage<true, true>(F, Kt, (const bf16_t*)(F.ws + WS_KR), b, h, c, 0.08838834764831845f, lg);
    __syncthreads();
    f32x16 acc[2]; acc[0] = f32x16{}; acc[1] = f32x16{};
    block_gemm128(acc, Vt, Kt, wr, wc, r32, hi);
    float* U = (float*)(F.ws + WS_U) + (size_t)unit * 16384;
#pragma unroll
    for (int n = 0; n < 2; ++n)
#pragma unroll
        for (int gq = 0; gq < 4; ++gq) { const f32x4 v = {acc[n][4 * gq], acc[n][4 * gq + 1], acc[n][4 * gq + 2], acc[n][4 * gq + 3]};
            *(f32x4*)(U + (size_t)(32 * wr + r32) * 128 + 64 * wc + 32 * n + 8 * gq + 4 * hi) = v; }
    __syncthreads();
}
__device__ __forceinline__ void ret_scan(Frame& F) {
    const float* U = (const float*)(F.ws + WS_U); bf16_t* S = (bf16_t*)(F.ws + WS_S);
    const int nthr = F.G * 512;
    for (int idx = F.vcu * 512 + F.tid; idx < 32 * 4096; idx += nthr) {
        const int bh = idx >> 12, e4 = (idx & 4095) * 4, h = bh & 3;
        const float cd = exp2f(128.0f * ret_gamma_log2(h));
        f32x4 s = {0.f, 0.f, 0.f, 0.f};
        for (int c = 0; c < 31; ++c) {
            const f32x4 u = *(const f32x4*)(U + ((size_t)(bh * 32 + c)) * 16384 + e4);
            s = s * cd + u;
            u32x2 w; w.x = pk2(s.x, s.y); w.y = pk2(s.z, s.w);
            *(u32x2*)(S + ((size_t)(bh * 32 + c + 1)) * 16384 + e4) = w;
        }
    }
}
__device__ __forceinline__ void ret_out_item(Frame& F, LAS unsigned char* lds, int unit) {
    const int b = unit >> 7, h = (unit >> 5) & 3, c = unit & 31;
    const int lane = F.lane, wid = F.wave, wr = wid >> 1, wc = wid & 1, r32 = lane & 31, hi = lane >> 5;
    LAS unsigned char* Qs = lds; LAS unsigned char* Ks = lds + RT; LAS unsigned char* Vt = lds + 2 * RT; LAS unsigned char* St = lds + 3 * RT;
    LAS float* red = (LAS float*)(lds + 4 * RT);
    const float lg = ret_gamma_log2(h);
    ret_stage<true, false>(F, Qs, (const bf16_t*)(F.ws + WS_QR), b, h, c, 1.0f, 0.f);
    ret_stage<true, false>(F, Ks, (const bf16_t*)(F.ws + WS_KR), b, h, c, 0.08838834764831845f, 0.f);
    ret_stage<false, true>(F, Vt, (const bf16_t*)(F.ws + WS_VR), b, h, c, 1.0f, 0.f);
    if (c > 0) { const bf16_t* S = (const bf16_t*)(F.ws + WS_S) + (size_t)unit * 16384;
        for (int i = F.tid; i < 2048; i += 512) { const int r = i >> 4, ch = i & 15; *(LAS u32x4*)(St + r * RP + ch * 16) = *(const u32x4*)(S + r * 128 + ch * 8); } }
    __syncthreads();
    f32x16 p[2]; p[0] = f32x16{}; p[1] = f32x16{};
    block_gemm128(p, Ks, Qs, wr, wc, r32, hi);
    __syncthreads();
    LAS unsigned char* Ps = Ks;
    { const int j = 32 * wr + r32;
#pragma unroll
      for (int n = 0; n < 2; ++n)
#pragma unroll
          for (int rg = 0; rg < 16; ++rg) { const int i = 64 * wc + 32 * n + (rg & 3) + 8 * (rg >> 2) + 4 * hi;
              const float v = (i >= j) ? p[n][rg] * exp2f(lg * (float)(i - j)) : 0.f;
              *(LAS bf16_t*)(Ps + i * RP + j * 2) = (bf16_t)f2bf(v); } }
    __syncthreads();
    f32x16 acc[2], cr[2]; acc[0] = f32x16{}; acc[1] = f32x16{}; cr[0] = f32x16{}; cr[1] = f32x16{};
    block_gemm128(acc, Ps, Vt, wr, wc, r32, hi);
    if (c > 0) block_gemm128(cr, Qs, St, wr, wc, r32, hi);
    const int i = 32 * wr + r32; const float qd = exp2f(lg * (float)(i + 1));
    float s1 = 0.f, s2 = 0.f;
#pragma unroll
    for (int n = 0; n < 2; ++n)
#pragma unroll
        for (int rg = 0; rg < 16; ++rg) { const float v = acc[n][rg] + qd * cr[n][rg]; acc[n][rg] = v; s1 += v; s2 += v * v; }
    s1 += __shfl_xor(s1, 32); s2 += __shfl_xor(s2, 32);
    if (hi == 0) { red[(wc * 128 + i) * 2] = s1; red[(wc * 128 + i) * 2 + 1] = s2; }
    __syncthreads();
    const float t1 = red[i * 2] + red[(128 + i) * 2], t2 = red[i * 2 + 1] + red[(128 + i) * 2 + 1];
    const float mean = t1 * (1.0f / 128.0f); const float var = fmaxf(t2 * (1.0f / 128.0f) - mean * mean, 0.f); const float rstd = 1.0f / sqrtf(var + LN_EPS);
    const size_t tok = (size_t)b * SEQ + c * 128 + i;
    const bf16_t* GR = (const bf16_t*)(F.ws + WS_GR) + tok * 512 + h * 128; bf16_t* CC = (bf16_t*)(F.ws + WS_H) + tok * 1024 + 512 + h * 128;
#pragma unroll
    for (int n = 0; n < 2; ++n)
#pragma unroll
        for (int gq = 0; gq < 4; ++gq) { const int col = 64 * wc + 32 * n + 8 * gq + 4 * hi;
            const u32x2 gw = *(const u32x2*)(GR + col); const f32x4 ng = *(const f32x4*)(F.ret_g + h * 128 + col);
            float o[4];
#pragma unroll
            for (int k = 0; k < 4; ++k) { const unsigned short gb = (unsigned short)((k < 2 ? gw.x : gw.y) >> (16 * (k & 1))); const float gg = bf2f(gb);
                const float sl = gg / (1.0f + __expf(-gg)); o[k] = (acc[n][4 * gq + k] - mean) * rstd * ng[k] * sl; }
            u32x2 w; w.x = pk2(o[0], o[1]); w.y = pk2(o[2], o[3]);
            *(u32x2*)(CC + col) = w; }
    __syncthreads();
}
constexpr int WRP = 1028;
__device__ __forceinline__ void p6_rows(Frame& F, LAS unsigned char* lds) {
    LAS float* wrt = (LAS float*)lds;
    LAS unsigned* lcnt = (LAS unsigned*)(lds + 32 * WRP * 4);
    LAS unsigned* lbase = lcnt + 32;
    for (int i = F.tid; i < DM * NEXP; i += 512) { const int k = i >> 5, e = i & 31; wrt[e * WRP + k] = F.w_router[i]; }
    const float* mod = (const float*)(F.ws + WS_MOD);
    float* X1 = (float*)(F.ws + WS_X1); bf16_t* H2 = (bf16_t*)(F.ws + WS_H2);
    int* tope = (int*)(F.ws + WS_TOPE); float* gate = (float*)(F.ws + WS_GATE); int* rank = (int*)(F.ws + WS_RANK);
    unsigned* gcnt = (unsigned*)(F.ws + WS_CTL) + CW_CNT;
    const int lane = F.lane;
    f32x4 g1[4], b1[4];
#pragma unroll
    for (int j = 0; j < 4; ++j) { g1[j] = ((const f32x4*)F.ln1_g)[lane + 64 * j]; b1[j] = ((const f32x4*)F.ln1_b)[lane + 64 * j]; }
    const float br = F.b_router[(lane >> 1) & 31];
    for (int chunk = F.vcu; chunk < NTOK / 128; chunk += F.G) {
        if (F.tid < 32) lcnt[F.tid] = 0u;
        __syncthreads();
        const int b = (chunk * 128) / SEQ;
        const f32x4* shf = (const f32x4*)(mod + (size_t)b * 6144 + 3 * DM) + lane; const f32x4* scf = (const f32x4*)(mod + (size_t)b * 6144 + 4 * DM) + lane;
        for (int tt = 0; tt < 16; ++tt) {
            const int tok = chunk * 128 + F.wave * 16 + tt;
            f32x4 v[4]; float s = 0.f;
            f32x4* xr = (f32x4*)(X1 + (size_t)tok * DM) + lane;
#pragma unroll
            for (int j = 0; j < 4; ++j) { v[j] = xr[64 * j]; s += (v[j].x + v[j].y) + (v[j].z + v[j].w); }
            const float mean = wave_sum(s) * (1.f / DM); float s2 = 0.f;
#pragma unroll
            for (int j = 0; j < 4; ++j) { v[j] = v[j] - mean; s2 += (v[j].x * v[j].x + v[j].y * v[j].y) + (v[j].z * v[j].z + v[j].w * v[j].w); }
            const float rstd = 1.f / sqrtf(wave_sum(s2) * (1.f / DM) + LN_EPS);
            unsigned long long* o8 = (unsigned long long*)(H2 + (size_t)tok * DM) + lane;
#pragma unroll
            for (int j = 0; j < 4; ++j) { const f32x4 x1 = v[j] * rstd * g1[j] + b1[j]; xr[64 * j] = x1;
                v[j] = x1 * (scf[64 * j] + 1.0f) + shf[64 * j];
                o8[64 * j] = (unsigned long long)pk2(v[j].x, v[j].y) | ((unsigned long long)pk2(v[j].z, v[j].w) << 32); }
            float a[32];
#pragma unroll
            for (int e = 0; e < 32; ++e) { float acc = 0.f;
#pragma unroll
                for (int j = 0; j < 4; ++j) { const f32x4 w = *(const LAS f32x4*)(wrt + e * WRP + 4 * lane + 256 * j); acc += v[j].x * w.x + v[j].y * w.y + v[j].z * w.z + v[j].w * w.w; }
                a[e] = acc; }
#define RS_STEP(N, XM, BITSEL) _Pragma("unroll") for (int e = 0; e < (N); ++e) { const bool up = (lane & (XM)) != 0; const float send = up ? a[e] : a[e + (N)]; const float keep = up ? a[e + (N)] : a[e]; a[e] = keep + __shfl_xor(send, (XM)); }
            RS_STEP(16, 32, 0) RS_STEP(8, 16, 0) RS_STEP(4, 8, 0) RS_STEP(2, 4, 0) RS_STEP(1, 2, 0)
#undef RS_STEP
            float lg = a[0] + __shfl_xor(a[0], 1) + br;
            int es[4]; float vs[4];
#pragma unroll
            for (int k = 0; k < 4; ++k) { const float m = wave_max(lg); const unsigned long long bal = __ballot(lg == m); const int l0 = __ffsll((long long)bal) - 1; es[k] = l0 >> 1; vs[k] = m; if ((lane >> 1) == es[k]) lg = -INFINITY; }
            const float e1 = __expf(vs[1] - vs[0]), e2 = __expf(vs[2] - vs[0]), e3 = __expf(vs[3] - vs[0]); const float inv = 1.f / (1.f + e1 + e2 + e3);
            if (lane < 4) { const int e = lane == 0 ? es[0] : lane == 1 ? es[1] : lane == 2 ? es[2] : es[3]; const float gv = (lane == 0 ? 1.f : lane == 1 ? e1 : lane == 2 ? e2 : e3) * inv;
                const unsigned r = atomicAdd((unsigned*)&lcnt[e], 1u);
                tope[tok * 4 + lane] = e; gate[tok * 4 + lane] = gv; rank[tok * 4 + lane] = (int)r; }
        }
        __syncthreads();
        if (F.tid < 32) lbase[F.tid] = __hip_atomic_fetch_add(gcnt + F.tid, lcnt[F.tid], __ATOMIC_RELAXED, __HIP_MEMORY_SCOPE_AGENT);
        __syncthreads();
        { const int i = F.tid; const int tok = chunk * 128 + (i >> 2); rank[tok * 4 + (i & 3)] += (int)lbase[tope[tok * 4 + (i & 3)]]; }
        __syncthreads();
    }
}
__device__ __forceinline__ void p6b_scatter(Frame& F, LAS unsigned char* lds) {
    LAS int* pst = (LAS int*)lds; LAS int* cnts = pst + 32;
    unsigned* gcnt = (unsigned*)(F.ws + WS_CTL) + CW_CNT;
    if (F.tid == 0) { int acc = 0; for (int e = 0; e < 32; ++e) { const int c = (int)__hip_atomic_load(gcnt + e, __ATOMIC_RELAXED, __HIP_MEMORY_SCOPE_AGENT); cnts[e] = c; pst[e] = acc; acc += (c + 255) / 256 * 256; }
        pst[64] = acc; }
    __syncthreads();
    const int* tope = (const int*)(F.ws + WS_TOPE); const float* gate = (const float*)(F.ws + WS_GATE); const int* rank = (const int*)(F.ws + WS_RANK);
    int* pos = (int*)(F.ws + WS_POS); int* rowtok = (int*)(F.ws + WS_ROWTOK); float* rowgate = (float*)(F.ws + WS_ROWGATE); int* blkexp = (int*)(F.ws + WS_BLKEXP);
    for (int i = F.vcu * 512 + F.tid; i < NTOK * 4; i += F.G * 512) { const int e = tope[i]; const int d = pst[e] + rank[i]; pos[i] = d; rowtok[d] = i >> 2; rowgate[d] = gate[i]; }
    for (int i = F.vcu * 512 + F.tid; i < 32 * 256; i += F.G * 512) { const int e = i >> 8, r = cnts[e] + (i & 255); if (r < (cnts[e] + 255) / 256 * 256) { rowtok[pst[e] + r] = 0; rowgate[pst[e] + r] = 0.f; } }
    if (F.vcu == 0) { const int nblk = pst[64] / 256;
        for (int rb = F.tid; rb < nblk; rb += 512) { int e = 0; for (int q = 1; q < 32; ++q) if (pst[q] <= rb * 256) e = q; blkexp[rb] = e; }
        if (F.tid == 0) blkexp[MAXBLK] = nblk; }
}
__device__ __forceinline__ void p9_final(Frame& F) {
    const int gw = F.vcu * NWAVES + F.wave, NGW = F.G * NWAVES, lane = F.lane;
    const float* mod = (const float*)(F.ws + WS_MOD); const float* X1 = (const float*)(F.ws + WS_X1); const bf16_t* Y = (const bf16_t*)(F.ws + WS_Y); const int* pos = (const int*)(F.ws + WS_POS);
    f32x4 g2[4], b2[4];
#pragma unroll
    for (int j = 0; j < 4; ++j) { g2[j] = ((const f32x4*)F.ln2_g)[lane + 64 * j]; b2[j] = ((const f32x4*)F.ln2_b)[lane + 64 * j]; }
    for (int tok = gw; tok < NTOK; tok += NGW) {
        const int b = tok / SEQ; const f32x4* gf = (const f32x4*)(mod + (size_t)b * 6144 + 5 * DM) + lane;
        const f32x4* xr = (const f32x4*)(X1 + (size_t)tok * DM) + lane;
        int p[4];
#pragma unroll
        for (int k = 0; k < 4; ++k) p[k] = pos[tok * 4 + k];
        f32x4 v[4]; float s = 0.f;
#pragma unroll
        for (int j = 0; j < 4; ++j) { f32x4 ff = {0.f, 0.f, 0.f, 0.f};
#pragma unroll
            for (int k = 0; k < 4; ++k) { const u32x2 w = *((const u32x2*)(Y + (size_t)p[k] * DM) + lane + 64 * j);
                ff.x += __uint_as_float(w.x << 16); ff.y += __uint_as_float(w.x & 0xffff0000u); ff.z += __uint_as_float(w.y << 16); ff.w += __uint_as_float(w.y & 0xffff0000u); }
            v[j] = xr[64 * j] * DN_ALPHA + (gf[64 * j] + 1.0f) * ff; s += (v[j].x + v[j].y) + (v[j].z + v[j].w); }
        const float mean = wave_sum(s) * (1.f / DM); float s2 = 0.f;
#pragma unroll
        for (int j = 0; j < 4; ++j) { v[j] = v[j] - mean; s2 += (v[j].x * v[j].x + v[j].y * v[j].y) + (v[j].z * v[j].z + v[j].w * v[j].w); }
        const float rstd = 1.f / sqrtf(wave_sum(s2) * (1.f / DM) + LN_EPS);
        f32x4* orow = (f32x4*)(F.out + (size_t)tok * DM) + lane;
#pragma unroll
        for (int j = 0; j < 4; ++j) orow[64 * j] = v[j] * rstd * g2[j] + b2[j];
    }
}
#ifndef MK_N_LAUNCHES
#define MK_N_LAUNCHES 12
#endif
constexpr int PER_PHASE = 12;
constexpr int N_LAUNCHES = MK_N_LAUNCHES;
struct Args { const float* in[18]; float* out; unsigned char* ws; int ph_lo, ph_hi; };
static_assert(sizeof(Args) == 18 * 8 + 8 + 8 + 8, "Args has no padding");

__global__ void __launch_bounds__(NWAVES * 64, 2) dsa_fwd(Args args) {
    extern __shared__ __attribute__((aligned(16))) unsigned char lds[];
    LAS unsigned char* L = (LAS unsigned char*)lds;
    Frame F;
    F.ws = args.ws; F.tid = threadIdx.x; F.lane = F.tid & 63; F.wave = __builtin_amdgcn_readfirstlane(F.tid >> 6);
    F.G = gridDim.x; { const int bx = blockIdx.x; F.vcu = (F.G % 8 == 0) ? (bx % 8) * (F.G / 8) + bx / 8 : bx; }
    F.x = args.in[0]; F.c = args.in[1]; F.rel_bias = args.in[2]; F.w_ada = args.in[3]; F.b_ada = args.in[4]; F.w_in = args.in[5]; F.ret_g = args.in[6]; F.w_out = args.in[7];
    F.ln1_g = args.in[8]; F.ln1_b = args.in[9]; F.w_router = args.in[10]; F.b_router = args.in[11]; F.w_gu = args.in[12]; F.b_gu = args.in[13]; F.w_d = args.in[14]; F.b_d = args.in[15];
    F.ln2_g = args.in[16]; F.ln2_b = args.in[17]; F.out = args.out;
    unsigned* ctl = (unsigned*)(F.ws + WS_CTL);
    volatile LAS unsigned* MISC = (volatile LAS unsigned*)(L + LDS_BYTES - 64);
    if (F.tid < 16) MISC[F.tid] = 0u;
    __syncthreads();
    XcdBarrier bar; bar.bar = ctl + CW_BAR; bar.x = 0; bar.st = nullptr;
    if (N_LAUNCHES == 1) bar = xcd_barrier_post(ctl + CW_BAR, MISC + 8);
    const int lo = args.ph_lo, hi = args.ph_hi;
#ifndef PHASE_MASK
#define PHASE_MASK 0xfff
#endif
#define IN(k) (((PHASE_MASK >> (k)) & 1) && lo <= (k) && (k) < hi)
#define SEAM(k) do { if (IN(k) && IN((k) + 1)) xcd_barrier(bar); } while (0)

    if (IN(0)) { p0_prologue(F, L); } SEAM(0);
    if (IN(1)) { p1_modulate(F); } SEAM(1);
    if (IN(2)) {
        pg8::Gemm g{(const bf16_t*)(F.ws + WS_H), (const bf16_t*)(F.ws + WS_WIN), DM, nullptr}; pg8::StaticOrder S; S.init(NTOK, NIN, F.G, (int)blockIdx.x);
        pg8::EpiInProj E{(bf16_t*)(F.ws + WS_QA), (bf16_t*)(F.ws + WS_KA), (bf16_t*)(F.ws + WS_VA), (bf16_t*)(F.ws + WS_QI), (bf16_t*)(F.ws + WS_KIW),
                         (bf16_t*)(F.ws + WS_QR), (bf16_t*)(F.ws + WS_KR), (bf16_t*)(F.ws + WS_VR), (bf16_t*)(F.ws + WS_GR)};
        pg8::gemm_phase<pg8::EpiInProj, pg8::StaticOrder, false>(L, g, S, E);
    } SEAM(2);
    if (IN(3)) {
#ifndef NO_SEL
        for (int i = 0;; ++i) { const int Lx = i * F.G + F.vcu; if (Lx >= BATCH * 256) break; const int b = Lx / 256, q = Lx % 256; select_item(F, L, b, (b & 1) ? 255 - q : q); }
#endif
#ifndef NO_RSTATE
        for (int u = F.vcu; u < 1024; u += F.G) ret_state_item(F, L, u);
#endif
    } SEAM(3);
    if (IN(4)) { ret_scan(F); } SEAM(4);
    if (IN(5)) {
        for (int i = 0;; ++i) { const int Lx = i * F.G + F.vcu; if (Lx >= 1024) break;
            int bh, qb;
            if (F.G == 256) { const int s = F.vcu & 3; bh = F.vcu >> 2; qb = (i == 0) ? 15 - s : (i == 1) ? 8 + s : (i == 2) ? 7 - s : s; }
            else { bh = Lx >> 4; qb = Lx & 15; }
            attn_body::attn_unit(bh >> 3, bh & 7, qb, (const bf16_t*)(F.ws + WS_QA), (const bf16_t*)(F.ws + WS_KA), (const bf16_t*)(F.ws + WS_VA), (bf16_t*)(F.ws + WS_H),
                                 (const unsigned*)(F.ws + WS_MASK), F.rel_bias, (char*)lds); }
        __syncthreads();
        for (int u = F.vcu; u < 1024; u += F.G) ret_out_item(F, L, u);
    } SEAM(5);
    if (IN(6)) {
        pg8::Gemm g{(const bf16_t*)(F.ws + WS_H), (const bf16_t*)(F.ws + WS_WOUT), DM, nullptr}; pg8::StaticOrder S; S.init(NTOK, DM, F.G, (int)blockIdx.x);
        pg8::EpiOutProj E{F.x, (const float*)(F.ws + WS_MOD), (float*)(F.ws + WS_X1)};
        pg8::gemm_phase<pg8::EpiOutProj, pg8::StaticOrder, false>(L, g, S, E);
    } SEAM(6);
    if (IN(7)) { p6_rows(F, L); } SEAM(7);
    if (IN(8)) { p6b_scatter(F, L); } SEAM(8);
    if (IN(9)) {
        const int* blkexp = (const int*)(F.ws + WS_BLKEXP); const int nblk = __hip_atomic_load(blkexp + MAXBLK, __ATOMIC_RELAXED, __HIP_MEMORY_SCOPE_AGENT);
        pg8::Gemm g{(const bf16_t*)(F.ws + WS_H2), (const bf16_t*)(F.ws + WS_WGU), DM, (const int*)(F.ws + WS_ROWTOK)}; pg8::MoeOrder S{blkexp, nblk, 8, F.G, (int)blockIdx.x};
        pg8::EpiGateUp E{(bf16_t*)(F.ws + WS_ACT), F.b_gu};
        pg8::gemm_phase<pg8::EpiGateUp, pg8::MoeOrder, true>(L, g, S, E);
    } SEAM(9);
    if (IN(10)) {
        const int* blkexp = (const int*)(F.ws + WS_BLKEXP); const int nblk = __hip_atomic_load(blkexp + MAXBLK, __ATOMIC_RELAXED, __HIP_MEMORY_SCOPE_AGENT);
        pg8::Gemm g{(const bf16_t*)(F.ws + WS_ACT), (const bf16_t*)(F.ws + WS_WD), DFF, nullptr}; pg8::MoeOrder S{blkexp, nblk, 4, F.G, (int)blockIdx.x};
        pg8::EpiDown E{(bf16_t*)(F.ws + WS_Y), F.b_d, (const float*)(F.ws + WS_ROWGATE)};
        pg8::gemm_phase<pg8::EpiDown, pg8::MoeOrder, false>(L, g, S, E);
    } SEAM(10);
    if (IN(11)) { p9_final(F); }
#undef IN
#undef SEAM
}

extern "C" void kernel_launch(void* const* d_in, const int* in_sizes, int n_in, void* d_out, int out_size, void* d_ws, size_t ws_size, hipStream_t stream) {
    static int grid = 0;
    if (grid == 0) {
        if (n_in != 18 || out_size != NTOK * DM || ws_size < WS_END) { fprintf(stderr, "kernel_launch: unexpected shapes (n_in %d out %d ws %zu)\n", n_in, out_size, ws_size); grid = -1; return; }
        int dev = 0, cus = 0, per_cu = 0;
        if (hipGetDevice(&dev) != hipSuccess || hipDeviceGetAttribute(&cus, hipDeviceAttributeMultiprocessorCount, dev) != hipSuccess) { grid = -1; return; }
        if (hipFuncSetAttribute((const void*)dsa_fwd, hipFuncAttributeMaxDynamicSharedMemorySize, LDS_BYTES) != hipSuccess) { fprintf(stderr, "kernel_launch: hipFuncSetAttribute failed\n"); grid = -1; return; }
        if (hipOccupancyMaxActiveBlocksPerMultiprocessor(&per_cu, (const void*)dsa_fwd, NWAVES * 64, LDS_BYTES) != hipSuccess || per_cu < 1) { fprintf(stderr, "kernel_launch: occupancy query says %d blocks per CU\n", per_cu); (void)hipGetLastError(); per_cu = 1; }
        grid = cus;
    }
    if (grid < 0) return;
    (void)hipMemsetAsync((char*)d_ws + WS_CTL, 0, CTL_ZERO_BYTES, stream);
    Args a{};
    for (int i = 0; i < 18; ++i) a.in[i] = (const float*)d_in[i];
    a.out = (float*)d_out; a.ws = (unsigned char*)d_ws;
    if (N_LAUNCHES == 1) {
        a.ph_lo = 0; a.ph_hi = PER_PHASE;
        void* kargs[] = {&a};
        hipError_t e = hipLaunchCooperativeKernel((const void*)dsa_fwd, dim3(grid), dim3(NWAVES * 64), kargs, LDS_BYTES, stream);
        if (e != hipSuccess) { fprintf(stderr, "kernel_launch: cooperative launch failed: %s (grid %d)\n", hipGetErrorString(e), grid); }
    } else {
        for (int li = 0; li < PER_PHASE; ++li) { a.ph_lo = li; a.ph_hi = li + 1; hipLaunchKernelGGL(dsa_fwd, dim3(grid), dim3(NWAVES * 64), LDS_BYTES, stream, a); }
    }
}
```

```cpp
#include <hip/hip_runtime.h>
#include <hip/hip_bf16.h>
#include <cstdio>
#include <cstdint>
#include <cmath>

#define LAS __attribute__((address_space(3)))
#define GAS __attribute__((address_space(1)))
typedef unsigned short bf16_t;
typedef short bf16x8 __attribute__((ext_vector_type(8)));
typedef short s16x4 __attribute__((ext_vector_type(4)));
typedef float f32x2 __attribute__((ext_vector_type(2)));
typedef float f32x4 __attribute__((ext_vector_type(4)));
typedef float f32x16 __attribute__((ext_vector_type(16)));
typedef unsigned u32x2 __attribute__((ext_vector_type(2)));
typedef unsigned u32x4 __attribute__((ext_vector_type(4)));
typedef int i32x4 __attribute__((ext_vector_type(4)));
typedef int i32x8 __attribute__((ext_vector_type(8)));

constexpr int BATCH = 8, SEQ = 4096, DM = 1024, NTOK = BATCH * SEQ;
constexpr int NIN = 3328;
constexpr int DIN_SRC = 3140;
constexpr int NEXP = 32, DFF = 1024, TOPK = 4, MOE_BLK = 256, MAXBLK = 544, PROWS = MAXBLK * 256;
constexpr float LN_EPS = 1e-5f;
constexpr float DN_ALPHA = 1.189207115002721f;
constexpr float LOG2E = 1.4426950408889634f;
constexpr float QSCALE = 0.125f * LOG2E;

__device__ __forceinline__ unsigned f2bf(float f) { unsigned u = __builtin_bit_cast(unsigned, f); return (u + 0x7fffu + ((u >> 16) & 1u)) >> 16; }
__device__ __forceinline__ unsigned pk2(float lo, float hi) { return f2bf(lo) | (f2bf(hi) << 16); }
__device__ __forceinline__ float bf2f(unsigned short b) { return __uint_as_float(((unsigned)b) << 16); }
__device__ __forceinline__ unsigned cvt_pk_bf16(float lo, float hi) { unsigned r; asm volatile("v_cvt_pk_bf16_f32 %0, %1, %2" : "=v"(r) : "v"(lo), "v"(hi)); return r; }

namespace pg8 {
constexpr int BM = 256, BK = 64, HALF = 128, HTB = HALF * BK * 2, STAGE_BYTES = 8 * HTB, NXCD = 8, WGM = 8;
__host__ __device__ __forceinline__ int lds_byte(int r, int c) { const int st = (r >> 4) * 2 + (c >> 5), rr = r & 15, cc = c & 31, ob = rr * 64 + cc * 2; return st * 1024 + (ob ^ (((ob >> 9) & 1) << 5)); }
__host__ __device__ __forceinline__ void stage_rc(int b, int& R, int& C) { const int st = b / 1024, sb = b % 1024, swz = sb ^ (((sb >> 9) & 1) << 5); R = (st >> 1) * 16 + swz / 64; C = (st & 1) * 32 + (swz % 64) / 2; }
__host__ __device__ __forceinline__ int perm32(int rho) { const int n = rho >> 4, i = rho & 15; return 8 * (i >> 2) + 4 * n + (i & 3); }

struct Unit { int pm, pn; };
struct Gemm { const bf16_t* A; const bf16_t* Bt; int K; const int* rowidx; };

struct StaticOrder {
    int nM, nN, nwg, G, c;
    __device__ void init(int M, int N, int G_, int c_) { nM = M / BM; nN = N / BM; nwg = nM * nN; G = G_; c = c_; }
    __device__ bool next(int i, Unit& u) const {
        const long L = (long)i * G + c; if (L >= nwg) return false;
        int wgid = (int)L; { const int q = nwg / NXCD, r = nwg % NXCD, xcd = wgid % NXCD, off = wgid / NXCD; wgid = (xcd < r ? xcd * (q + 1) : r * (q + 1) + (xcd - r) * q) + off; }
        const int nig = WGM * nN, gid = wgid / nig, fm = gid * WGM, gsz = (nM - fm) < WGM ? (nM - fm) : WGM;
        u.pm = fm + ((wgid % nig) % gsz); u.pn = (wgid % nig) / gsz; return true;
    }
};
struct RemapOrder {
    StaticOrder base; int from, off;
    __device__ bool next(int i, Unit& u) const { if (!base.next(i, u)) return false; if (u.pn >= from) u.pn += off; return true; }
};
struct MoeOrder {
    const int* block_exp; int nblk, nN, G, c;
    __device__ bool next(int i, Unit& u) const {
        if (false && G == 256) {
            const int x = c >> 5, j = c & 31; int q = i * 32 + j;
#pragma unroll 1
            for (int k = 0; k < 4; ++k) { const int e = x + 8 * k; const int b0 = block_exp[600 + e], nb = block_exp[601 + e] - b0;
                if (q < nb * nN) { u.pm = b0 + q / nN; u.pn = e * nN + q % nN; return true; }
                q -= nb * nN; }
            return false;
        }
        const long L = (long)i * G + c; if (L >= (long)nblk * nN) return false;
        const int rb = (int)(L / nN), pnl = (int)(L % nN);
        u.pm = rb; u.pn = block_exp[rb] * nN + pnl; return true;
    }
};

template <class Epi, class Sched, bool GATHER, bool I8 = false, bool F8 = false>
__device__ __forceinline__ void gemm_phase(LAS unsigned char* lds, const Gemm g, const Sched& S, const Epi& E) {
    int tid = threadIdx.x; asm volatile("" : "+v"(tid));
    const int wid = __builtin_amdgcn_readfirstlane(tid >> 6), lane = tid & 63, wr = wid >> 2, wc = wid & 3, fr = lane & 15, fq = lane >> 4;
    const int K = g.K, nt = K / BK;
    unsigned voffA0[2], voffA1[2], voffB[2], nvA0[2], nvA1[2]; int RA[2], CA[2];
    const size_t hstep = (size_t)HALF * K * 2;
    const size_t tstep = 2 * hstep;
#pragma unroll
    for (int i = 0; i < 2; ++i) { int R, C; stage_rc(tid * 16 + i * 8192, R, C); const int Rb = Epi::PERM ? ((R & ~31) + perm32(R & 31)) : R;
        RA[i] = R; CA[i] = C;
        voffA0[i] = (unsigned)(R * K + C) * 2u; voffA1[i] = voffA0[i] + (unsigned)hstep; voffB[i] = (unsigned)(Rb * K + C) * 2u; nvA0[i] = voffA0[i]; nvA1[i] = voffA1[i]; }
    const size_t kstep = (size_t)(BK * 2);
    const unsigned ldsw = (unsigned)wid * 1024u;
    const int aoff = lds_byte(wr * 64 + fr, fq * 8), boff = lds_byte(wc * 32 + fr, fq * 8);
#define PG8_SA(b, h) (((b) * 2 + (h)) * HTB)
#define PG8_SB(b, h) ((4 + (b) * 2 + (h)) * HTB)
#define PG8_STAGE(bufoff, gbase, voff) do { _Pragma("unroll") for (int _i = 0; _i < 2; ++_i) \
        __builtin_amdgcn_global_load_lds((const unsigned*)((const char*)(gbase) + (voff)[_i]), (LAS unsigned*)(lds + (bufoff) + ldsw + _i * 8192), 16, 0, 0); } while (0)
#define PG8_LDA(dst, b, h) do { if constexpr (F8) { _Pragma("unroll") for (int m = 0; m < 4; ++m) { const i32x4 lo_ = *(const LAS i32x4*)(lds + PG8_SA(b, h) + aoff + m * 2048), hi_ = *(const LAS i32x4*)(lds + PG8_SA(b, h) + aoff + m * 2048 + 1024); dst##8[m] = __builtin_shufflevector(lo_, hi_, 0, 1, 2, 3, 4, 5, 6, 7); } } \
        else { _Pragma("unroll") for (int m = 0; m < 4; ++m) _Pragma("unroll") for (int k = 0; k < 2; ++k) dst[m][k] = *(const LAS bf16x8*)(lds + PG8_SA(b, h) + aoff + m * 2048 + k * 1024); } } while (0)
#define PG8_LDB(dst, b, h) do { if constexpr (F8) { _Pragma("unroll") for (int n = 0; n < 2; ++n) { const i32x4 lo_ = *(const LAS i32x4*)(lds + PG8_SB(b, h) + boff + n * 2048), hi_ = *(const LAS i32x4*)(lds + PG8_SB(b, h) + boff + n * 2048 + 1024); dst##8[n] = __builtin_shufflevector(lo_, hi_, 0, 1, 2, 3, 4, 5, 6, 7); } } \
        else { _Pragma("unroll") for (int n = 0; n < 2; ++n) _Pragma("unroll") for (int k = 0; k < 2; ++k) dst[n][k] = *(const LAS bf16x8*)(lds + PG8_SB(b, h) + boff + n * 2048 + k * 1024); } } while (0)
#define PG8_MMA(ai, bj, At, Bt) do { __builtin_amdgcn_s_setprio(1); _Pragma("unroll") for (int m = 0; m < 4; ++m) _Pragma("unroll") for (int n = 0; n < 2; ++n) { \
        if constexpr (F8) { asm volatile("v_mfma_scale_f32_16x16x128_f8f6f4 %0, %1, %2, %0, %3, %3 op_sel_hi:[0,0,0]" : "+v"(acc[ai][bj][m][n]) : "v"(Bt##8[n]), "v"(At##8[m]), "v"(mxone)); } \
        else { _Pragma("unroll") for (int k = 0; k < 2; ++k) { \
          if constexpr (I8) { asm volatile("v_mfma_i32_16x16x64_i8 %0, %1, %2, %0" : "+v"(acc[ai][bj][m][n]) : "v"(Bt[n][k]), "v"(At[m][k])); } \
          else acc[ai][bj][m][n] = __builtin_bit_cast(acc_t, __builtin_amdgcn_mfma_f32_16x16x32_bf16(Bt[n][k], At[m][k], __builtin_bit_cast(f32x4, acc[ai][bj][m][n]), 0, 0, 0)); } } } __builtin_amdgcn_s_setprio(0); } while (0)
#define PG8_WAIT_V(n) asm volatile("s_waitcnt vmcnt(" #n ")" ::: "memory")
#define PG8_WAIT_L(n) asm volatile("s_waitcnt lgkmcnt(" #n ")" ::: "memory")
#define PG8_BAR __builtin_amdgcn_s_barrier()
#define PG8_SCHED __builtin_amdgcn_sched_barrier(0)
#define PG8_GLOAD(u, o0, o1) do { if constexpr (GATHER) { _Pragma("unroll") for (int _i = 0; _i < 2; ++_i) { \
        const int r0_ = g.rowidx[(u).pm * BM + RA[_i]], r1_ = g.rowidx[(u).pm * BM + HALF + RA[_i]]; \
        o0[_i] = (unsigned)(r0_ * K + CA[_i]) * 2u; o1[_i] = (unsigned)(r1_ * K + CA[_i]) * 2u; } } } while (0)
    Unit cur, nxt; int ui = 0;
    if (!S.next(0, cur)) return;
    typedef typename Epi::acc_t acc_t;
    acc_t acc[2][2][4][2];
#pragma unroll
    for (int a = 0; a < 2; ++a)
#pragma unroll
        for (int b = 0; b < 2; ++b)
#pragma unroll
            for (int m = 0; m < 4; ++m)
#pragma unroll
                for (int n = 0; n < 2; ++n) acc[a][b][m][n] = acc_t{};
    bf16x8 At[4][2], B0[2][2], B1[2][2];
    int mxone = 0x7f7f7f7f; asm volatile("" : "+v"(mxone));
    i32x8 At8[4], B08[2], B18[2];
    PG8_GLOAD(cur, voffA0, voffA1);
    E.stage(cur, lds + STAGE_BYTES, wid, lane);
    const char* cA = (const char*)g.A + (GATHER ? (size_t)0 : (size_t)cur.pm * tstep); const char* cB = (const char*)g.Bt + (size_t)cur.pn * tstep;
    PG8_STAGE(PG8_SB(0, 0), cB, voffB); PG8_STAGE(PG8_SB(0, 1), cB + hstep, voffB); PG8_STAGE(PG8_SA(0, 0), cA, voffA0); PG8_STAGE(PG8_SA(0, 1), cA, voffA1);
    if (wr == 1) PG8_BAR;
    PG8_WAIT_V(2); PG8_BAR;
    PG8_STAGE(PG8_SB(1, 0), cB + kstep, voffB); PG8_STAGE(PG8_SA(1, 0), cA + kstep, voffA0); PG8_STAGE(PG8_SB(1, 1), cB + hstep + kstep, voffB);
    PG8_WAIT_V(6); PG8_BAR;
    for (;;) {
        const bool has_next = S.next(ui + 1, nxt);
        const char* nA = has_next ? (const char*)g.A + (GATHER ? (size_t)0 : (size_t)nxt.pm * tstep) : cA; const char* nB = has_next ? (const char*)g.Bt + (size_t)nxt.pn * tstep : cB;
        for (int t = 0; t < nt; t += 2) {
            const bool last = (t == nt - 2);
            const char* a1 = cA + (size_t)(t + 1) * kstep;
            const char* a2 = last ? nA : cA + (size_t)(t + 2) * kstep; const char* b2 = last ? nB : cB + (size_t)(t + 2) * kstep;
            const char* a3 = a2 + kstep; const char* b3 = b2 + kstep;
            if (last && has_next) { int ln_ = lane; asm volatile("" : "+v"(ln_)); E.stage(nxt, lds + STAGE_BYTES + ((ui + 1) & 1) * 4096, wid, ln_); }
            if constexpr (GATHER) { if (last) { if (has_next) { PG8_GLOAD(nxt, nvA0, nvA1); } else { nvA0[0] = voffA0[0]; nvA0[1] = voffA0[1]; nvA1[0] = voffA1[0]; nvA1[1] = voffA1[1]; } } }
            unsigned x0[2], x1[2];
#pragma unroll
            for (int _i = 0; _i < 2; ++_i) { x0[_i] = (GATHER && last) ? nvA0[_i] : voffA0[_i]; x1[_i] = (GATHER && last) ? nvA1[_i] : voffA1[_i]; }
            PG8_LDB(B0, 0, 0); PG8_LDB(B1, 0, 1); PG8_SCHED; PG8_LDA(At, 0, 0); PG8_STAGE(PG8_SA(1, 1), a1, voffA1);
            PG8_WAIT_V(8); PG8_WAIT_L(0); PG8_BAR; PG8_MMA(0, 0, At, B0); PG8_MMA(0, 1, At, B1); PG8_BAR; PG8_SCHED;
            PG8_LDA(At, 0, 1); PG8_STAGE(PG8_SB(0, 0), b2, voffB); PG8_STAGE(PG8_SB(0, 1), b2 + hstep, voffB); PG8_STAGE(PG8_SA(0, 0), a2, x0);
            PG8_WAIT_V(8); PG8_WAIT_L(0); PG8_BAR; PG8_MMA(1, 0, At, B0); PG8_MMA(1, 1, At, B1); PG8_BAR; PG8_SCHED;
            PG8_LDB(B0, 1, 0); PG8_LDB(B1, 1, 1); PG8_SCHED; PG8_LDA(At, 1, 0); PG8_STAGE(PG8_SA(0, 1), a2, x1);
            PG8_WAIT_V(8); PG8_WAIT_L(0); PG8_BAR; PG8_MMA(0, 0, At, B0); PG8_MMA(0, 1, At, B1); PG8_BAR; PG8_SCHED;
            PG8_LDA(At, 1, 1); PG8_STAGE(PG8_SB(1, 0), b3, voffB); PG8_STAGE(PG8_SB(1, 1), b3 + hstep, voffB); PG8_STAGE(PG8_SA(1, 0), a3, x0);
            PG8_WAIT_V(8); PG8_WAIT_L(0); PG8_BAR; PG8_MMA(1, 0, At, B0); PG8_MMA(1, 1, At, B1); PG8_BAR; PG8_SCHED;
        }
        if (wr == 0) PG8_BAR;
        if constexpr (F8 || I8) asm volatile("s_nop 15\n\ts_nop 15" ::: "memory");
        { int fr_ = fr, fq_ = fq; asm volatile("" : "+v"(fr_), "+v"(fq_));
          E(acc, cur, wr, wc, fr_, fq_, lds + STAGE_BYTES + (ui & 1) * 4096); }
        if (!has_next) break;
#pragma unroll
        for (int a = 0; a < 2; ++a)
#pragma unroll
            for (int b = 0; b < 2; ++b)
#pragma unroll
                for (int m = 0; m < 4; ++m)
#pragma unroll
                    for (int n = 0; n < 2; ++n) acc[a][b][m][n] = acc_t{};
        cur = nxt; cA = nA; cB = nB; ++ui;
        if constexpr (GATHER) { voffA0[0] = nvA0[0]; voffA0[1] = nvA0[1]; voffA1[0] = nvA1[0]; voffA1[1] = nvA1[1]; }
        if (wr == 1) PG8_BAR;
    }
    PG8_WAIT_V(0);
    PG8_BAR;
#undef PG8_SA
#undef PG8_SB
#undef PG8_STAGE
#undef PG8_LDA
#undef PG8_LDB
#undef PG8_MMA
#undef PG8_WAIT_V
#undef PG8_WAIT_L
#undef PG8_BAR
#undef PG8_SCHED
#undef PG8_GLOAD
}
}
namespace pg8 {
struct EpiInProj {
    static constexpr bool PERM = true; typedef f32x4 acc_t;
    bf16_t *QA, *KA, *VA, *QI, *KIW, *QR, *KR, *VR, *GR;
    __device__ __forceinline__ void stage(const Unit&, LAS unsigned char*, int, int) const {}
    __device__ __forceinline__ void operator()(const f32x4 (&acc)[2][2][4][2], const Unit& u, int wr, int wc, int fr, int fq, LAS unsigned char* aux) const {
        const int row0 = u.pm * BM + wr * 64 + fr;
#pragma unroll
        for (int bj = 0; bj < 2; ++bj) {
            const int hb = u.pn * 2 + bj;
            bf16_t* base; int pitch; float sc = 1.f;
            if (hb < 4) { base = QA + hb * 128; pitch = 512; sc = QSCALE; }
            else if (hb == 4) { base = KA; pitch = 128; }
            else if (hb == 5) { base = VA; pitch = 128; }
            else if (hb < 8) { base = QI + (hb - 6) * 128; pitch = 256; sc = 0.125f; }
            else if (hb == 8) { base = KIW; pitch = 128; }
            else if (hb == 9) { continue; }
            else if (hb < 14) { base = QR + (hb - 10) * 128; pitch = 512; }
            else if (hb < 18) { base = KR + (hb - 14) * 128; pitch = 512; }
            else if (hb < 22) { base = VR + (hb - 18) * 128; pitch = 512; }
            else { base = GR + (hb - 22) * 128; pitch = 512; }
            const int col0 = wc * 32 + 8 * fq;
#pragma unroll
            for (int ai = 0; ai < 2; ++ai)
#pragma unroll
                for (int m = 0; m < 4; ++m) {
                    const f32x4 v0 = acc[ai][bj][m][0] * sc, v1 = acc[ai][bj][m][1] * sc;
                    u32x4 w; w.x = cvt_pk_bf16(v0[0], v0[1]); w.y = cvt_pk_bf16(v0[2], v0[3]); w.z = cvt_pk_bf16(v1[0], v1[1]); w.w = cvt_pk_bf16(v1[2], v1[3]);
                    *(u32x4*)(base + (size_t)(row0 + ai * HALF + m * 16) * pitch + col0) = w; }
        }
    }
};
struct EpiInProjI8 {
    static constexpr bool PERM = true; typedef i32x4 acc_t;
    bf16_t *QA, *KA, *VA, *QR, *KR, *VR, *GR; const float* srow; const float* scol;
    __device__ __forceinline__ void stage(const Unit& u, LAS unsigned char* aux, int wid, int lane) const {
        if (wid == 0) { const f32x4 sr = *(const f32x4*)(srow + (size_t)u.pm * BM + lane * 4), sc = *(const f32x4*)(scol + (size_t)u.pn * BM + lane * 4);
            *(LAS f32x4*)(aux + lane * 16) = sr; *(LAS f32x4*)(aux + 1024 + lane * 16) = sc; }
    }
    __device__ __forceinline__ void operator()(const i32x4 (&acc)[2][2][4][2], const Unit& u, int wr, int wc, int fr, int fq, LAS unsigned char* aux) const {
        const int rl0 = wr * 64 + fr;
#pragma unroll
        for (int bj = 0; bj < 2; ++bj) {
            const int hb = u.pn * 2 + bj;
            bf16_t* base; int pitch; float sc = 1.f;
            if (hb < 4) { base = QA + hb * 128; pitch = 512; sc = QSCALE; }
            else if (hb == 4) { base = KA; pitch = 128; }
            else if (hb == 5) { base = VA; pitch = 128; }
            else if (hb < 14) { base = QR + (hb - 10) * 128; pitch = 512; }
            else if (hb < 18) { base = KR + (hb - 14) * 128; pitch = 512; }
            else if (hb < 22) { base = VR + (hb - 18) * 128; pitch = 512; }
            else { base = GR + (hb - 22) * 128; pitch = 512; }
            const int cl0 = wc * 32 + 8 * fq;
#pragma unroll
            for (int ai = 0; ai < 2; ++ai)
#pragma unroll
                for (int m = 0; m < 4; ++m) { const int rl = rl0 + ai * HALF + m * 16; const float sr = *(const LAS float*)(aux + rl * 4) * sc;
                    const f32x4 c0 = *(const LAS f32x4*)(aux + 1024 + (bj * HALF + cl0) * 4), c1 = *(const LAS f32x4*)(aux + 1024 + (bj * HALF + cl0 + 4) * 4);
                    const i32x4 a0 = acc[ai][bj][m][0], a1 = acc[ai][bj][m][1];
                    const f32x4 v0 = (f32x4){(float)a0[0], (float)a0[1], (float)a0[2], (float)a0[3]} * c0 * sr, v1 = (f32x4){(float)a1[0], (float)a1[1], (float)a1[2], (float)a1[3]} * c1 * sr;
                    u32x4 w; w.x = cvt_pk_bf16(v0[0], v0[1]); w.y = cvt_pk_bf16(v0[2], v0[3]); w.z = cvt_pk_bf16(v1[0], v1[1]); w.w = cvt_pk_bf16(v1[2], v1[3]);
                    *(u32x4*)(base + (size_t)(u.pm * BM + rl) * pitch + cl0) = w; asm volatile("" ::: "memory"); }
        }
    }
};
struct EpiOutProj {
    static constexpr bool PERM = true; typedef f32x4 acc_t;
    const float* mod; bf16_t* MIX;
    __device__ __forceinline__ void stage(const Unit&, LAS unsigned char*, int, int) const {}
    __device__ __forceinline__ void operator()(const f32x4 (&acc)[2][2][4][2], const Unit& u, int wr, int wc, int fr, int fq, LAS unsigned char* aux) const {
        const int row0 = u.pm * BM + wr * 64 + fr, col0 = u.pn * BM + wc * 32 + 8 * fq;
        const int b = (u.pm * BM) / SEQ;
        f32x4 gv[2][2];
#pragma unroll
        for (int bj = 0; bj < 2; ++bj)
#pragma unroll
            for (int n = 0; n < 2; ++n) gv[bj][n] = *(const f32x4*)(mod + (size_t)b * 6 * DM + 2 * DM + col0 + bj * HALF + 4 * n) + 1.0f;
#pragma unroll
        for (int ai = 0; ai < 2; ++ai)
#pragma unroll
            for (int m = 0; m < 4; ++m) { bf16_t* rowp = MIX + (size_t)(row0 + ai * HALF + m * 16) * DM + col0;
#pragma unroll
                for (int bj = 0; bj < 2; ++bj) { const f32x4 v0 = acc[ai][bj][m][0] * gv[bj][0], v1 = acc[ai][bj][m][1] * gv[bj][1];
                    u32x4 w; w.x = cvt_pk_bf16(v0[0], v0[1]); w.y = cvt_pk_bf16(v0[2], v0[3]); w.z = cvt_pk_bf16(v1[0], v1[1]); w.w = cvt_pk_bf16(v1[2], v1[3]);
                    *(u32x4*)(rowp + bj * HALF) = w; } }
    }
};
struct EpiGateUp {
    static constexpr bool PERM = true; typedef i32x4 acc_t;
    unsigned char* act; const float* bgu; const float* swgu; const float* rowscale;
    __device__ __forceinline__ void stage(const Unit& u, LAS unsigned char* aux, int wid, int lane) const {
        if (wid == 0) { const int e = u.pn >> 3, pnl = u.pn & 7;
            const f32x4 v = *(const f32x4*)(bgu + (size_t)e * 2048 + (lane >> 5) * 1024 + pnl * 128 + (lane & 31) * 4);
            const f32x4 sc = *(const f32x4*)(swgu + (size_t)e * 2048 + pnl * 256 + lane * 4);
            const f32x4 sr = *(const f32x4*)(rowscale + (size_t)u.pm * BM + lane * 4);
            *(LAS f32x4*)(aux + lane * 16) = v; *(LAS f32x4*)(aux + 1024 + lane * 16) = sc; *(LAS f32x4*)(aux + 2048 + lane * 16) = sr; }
    }
    __device__ __forceinline__ void operator()(const i32x4 (&acc)[2][2][4][2], const Unit& u, int wr, int wc, int fr, int fq, LAS unsigned char* aux) const {
        const int pnl = u.pn & 7;
        const int rl0 = wr * 64 + fr, j0 = wc * 32 + 8 * fq;
#pragma unroll
        for (int ai = 0; ai < 2; ++ai)
#pragma unroll
            for (int m = 0; m < 4; ++m) { const int rl = rl0 + ai * HALF + m * 16; const float sr = *(const LAS float*)(aux + 2048 + rl * 4);
                f32x2 ov[4];
#pragma unroll
                for (int q = 0; q < 4; ++q) { const i32x4 ga = acc[ai][0][m][q >> 1], ua = acc[ai][1][m][q >> 1];
                    f32x2 g2 = (q & 1) ? (f32x2){(float)ga[2], (float)ga[3]} : (f32x2){(float)ga[0], (float)ga[1]}; f32x2 u2 = (q & 1) ? (f32x2){(float)ua[2], (float)ua[3]} : (f32x2){(float)ua[0], (float)ua[1]};
                    g2 = g2 * (*(const LAS f32x2*)(aux + 1024 + (j0 + 2 * q) * 4) * sr) + *(const LAS f32x2*)(aux + (j0 + 2 * q) * 4);
                    u2 = u2 * (*(const LAS f32x2*)(aux + 1536 + (j0 + 2 * q) * 4) * sr) + *(const LAS f32x2*)(aux + 512 + (j0 + 2 * q) * 4);
                    g2.x = fminf(g2.x, 7.0f); g2.y = fminf(g2.y, 7.0f); u2.x = __builtin_amdgcn_fmed3f(u2.x, -7.0f, 7.0f); u2.y = __builtin_amdgcn_fmed3f(u2.y, -7.0f, 7.0f);
                    f32x2 t = g2 * (-1.702f * LOG2E); t.x = __builtin_amdgcn_exp2f(t.x); t.y = __builtin_amdgcn_exp2f(t.y); t = t + 1.0f;
                    f32x2 sg; sg.x = __builtin_amdgcn_rcpf(t.x); sg.y = __builtin_amdgcn_rcpf(t.y);
                    ov[q] = (u2 + 1.0f) * (g2 * sg) * 8.0f; ov[q].x = __builtin_amdgcn_fmed3f(ov[q].x, -448.0f, 448.0f); ov[q].y = __builtin_amdgcn_fmed3f(ov[q].y, -448.0f, 448.0f); }
                int w0 = __builtin_amdgcn_cvt_pk_fp8_f32(ov[0].x, ov[0].y, 0, false); w0 = __builtin_amdgcn_cvt_pk_fp8_f32(ov[1].x, ov[1].y, w0, true);
                int w1 = __builtin_amdgcn_cvt_pk_fp8_f32(ov[2].x, ov[2].y, 0, false); w1 = __builtin_amdgcn_cvt_pk_fp8_f32(ov[3].x, ov[3].y, w1, true);
                u32x2 wv; wv.x = (unsigned)w0; wv.y = (unsigned)w1;
                *(u32x2*)(act + (size_t)(u.pm * BM + rl) * DFF + pnl * 128 + j0) = wv; asm volatile("" ::: "memory"); }
    }
};
struct EpiDown {
    static constexpr bool PERM = true; typedef f32x4 acc_t;
    unsigned char* Y; const float* bd; const float* row_gate; const float* swd;
    __device__ __forceinline__ void stage(const Unit& u, LAS unsigned char* aux, int wid, int lane) const {
        if (wid == 0) { const int e = u.pn >> 2, pnl = u.pn & 3;
            const f32x4 v = *(const f32x4*)(bd + (size_t)e * DM + pnl * BM + lane * 4); const f32x4 g = *(const f32x4*)(row_gate + (size_t)u.pm * BM + lane * 4) * 64.0f;
            const f32x4 cs = *(const f32x4*)(swd + (size_t)e * DM + pnl * BM + lane * 4) * 0.125f;
            *(LAS f32x4*)(aux + lane * 16) = v; *(LAS f32x4*)(aux + 1024 + lane * 16) = g; *(LAS f32x4*)(aux + 2048 + lane * 16) = cs; }
    }
    __device__ __forceinline__ void operator()(const f32x4 (&acc)[2][2][4][2], const Unit& u, int wr, int wc, int fr, int fq, LAS unsigned char* aux) const {
        const int pnl = u.pn & 3;
        const int rl0 = wr * 64 + fr, cl0 = wc * 32 + 8 * fq;
#pragma unroll
        for (int ai = 0; ai < 2; ++ai)
#pragma unroll
            for (int m = 0; m < 4; ++m) { const int rl = rl0 + ai * HALF + m * 16; const float gt = *(const LAS float*)(aux + 1024 + rl * 4);
#pragma unroll
                for (int bj = 0; bj < 2; ++bj) { const f32x4 b0 = *(const LAS f32x4*)(aux + (cl0 + bj * HALF) * 4), b1 = *(const LAS f32x4*)(aux + (cl0 + bj * HALF + 4) * 4);
                    const f32x4 c0 = *(const LAS f32x4*)(aux + 2048 + (cl0 + bj * HALF) * 4), c1 = *(const LAS f32x4*)(aux + 2048 + (cl0 + bj * HALF + 4) * 4);
                    f32x4 v0 = (acc[ai][bj][m][0] * c0 + b0) * gt, v1 = (acc[ai][bj][m][1] * c1 + b1) * gt;
#pragma unroll
                    for (int i = 0; i < 4; ++i) { v0[i] = __builtin_amdgcn_fmed3f(v0[i], -448.0f, 448.0f); v1[i] = __builtin_amdgcn_fmed3f(v1[i], -448.0f, 448.0f); }
                    int w0 = __builtin_amdgcn_cvt_pk_fp8_f32(v0[0], v0[1], 0, false); w0 = __builtin_amdgcn_cvt_pk_fp8_f32(v0[2], v0[3], w0, true);
                    int w1 = __builtin_amdgcn_cvt_pk_fp8_f32(v1[0], v1[1], 0, false); w1 = __builtin_amdgcn_cvt_pk_fp8_f32(v1[2], v1[3], w1, true);
                    u32x2 w; w.x = (unsigned)w0; w.y = (unsigned)w1;
                    *(u32x2*)(Y + (size_t)(u.pm * BM + rl) * DM + pnl * BM + cl0 + bj * HALF) = w; } }
    }
};
}
namespace attn_body {
constexpr int D = 64, QP = 512, KP = 128, VP = 128, OP = 1024;
constexpr int NW = 8, QBLK = 32, QB = QBLK * NW, KVBLK = 64;
__device__ __forceinline__ int crow(int r, int hi) { return (r & 3) + 8 * (r >> 2) + 4 * hi; }
#define SBAR() __builtin_amdgcn_sched_barrier(0)
constexpr int NSLOT = 3, SLOTB = 8192, MSLOT = 2048;
constexpr int LDS_K = 0, LDS_V = NSLOT * SLOTB, LDS_WS = 2 * NSLOT * SLOTB, LDS_OST = LDS_WS + NW * 64 * 4, LDS_M = LDS_OST + NW * 4096, LDS_BT = LDS_M + NSLOT * MSLOT, BT_N = 704, LDS_BYTES = LDS_BT + BT_N * 4;
__device__ __forceinline__ void glds16(const void* gsrc, unsigned lds_dst) { unsigned keep;
    asm volatile("s_mov_b32 %0, m0\n\ts_mov_b32 m0, %2\n\ts_nop 0\n\tglobal_load_lds_dwordx4 %1, off\n\ts_mov_b32 m0, %0" : "=&s"(keep) : "v"(gsrc), "s"(lds_dst) : "memory"); }
__device__ __forceinline__ void glds4(const void* gsrc, unsigned lds_dst) { unsigned keep;
    asm volatile("s_mov_b32 %0, m0\n\ts_mov_b32 m0, %2\n\ts_nop 0\n\tglobal_load_lds_dword %1, off\n\ts_mov_b32 m0, %0" : "=&s"(keep) : "v"(gsrc), "s"(lds_dst) : "memory"); }
__device__ __forceinline__ float max3f(float a, float b, float c) { float r; asm("v_max3_f32 %0, %1, %2, %3" : "=v"(r) : "v"(a), "v"(b), "v"(c)); return r; }
__device__ __forceinline__ float max2f(float a, float b) { float r; asm("v_max_f32_e32 %0, %1, %2" : "=v"(r) : "v"(a), "v"(b)); return r; }
__device__ __forceinline__ float fadd_s(float a, float b) { float r; asm("v_add_f32_e32 %0, %1, %2" : "=v"(r) : "v"(a), "v"(b)); return r; }
__device__ __forceinline__ float fsub_s(float a, float b) { float r; asm("v_sub_f32_e32 %0, %1, %2" : "=v"(r) : "v"(a), "v"(b)); return r; }
typedef __bf16 bf16x2_t __attribute__((ext_vector_type(2)));
__device__ __forceinline__ unsigned cvtpk_s(float lo, float hi) { f32x2 v = {lo, hi}; bf16x2_t b = __builtin_convertvector(v, bf16x2_t); return __builtin_bit_cast(unsigned, b); }
#define WAIT_BAR(N) asm volatile("s_waitcnt vmcnt(" #N ") lgkmcnt(0)\n\ts_barrier" ::: "memory")

__device__ __forceinline__ void qkt(f32x16& p0, f32x16& p1, const char* Kslot, const bf16x8* qr, const f32x16& negm, int r32, int hi) {
    const char* kb = Kslot + hi * 1024 + r32 * 16;
#pragma unroll
    for (int d0 = 0; d0 < 4; ++d0) {
        const bf16x8 b0 = *reinterpret_cast<const bf16x8*>(kb + d0 * 2048);
        const bf16x8 b1 = *reinterpret_cast<const bf16x8*>(kb + d0 * 2048 + 512);
        if (d0 == 0) { p0 = __builtin_amdgcn_mfma_f32_32x32x16_bf16(b0, qr[0], negm, 0, 0, 0); p1 = __builtin_amdgcn_mfma_f32_32x32x16_bf16(b1, qr[0], negm, 0, 0, 0); }
        else { p0 = __builtin_amdgcn_mfma_f32_32x32x16_bf16(b0, qr[d0], p0, 0, 0, 0); p1 = __builtin_amdgcn_mfma_f32_32x32x16_bf16(b1, qr[d0], p1, 0, 0, 0); } }
}
typedef LAS const char* lds_cptr;
typedef short v4i16_t __attribute__((ext_vector_type(4)));
__device__ __forceinline__ void kload8(bf16x8* kf, lds_cptr kp) {
    kf[0] = *(const LAS bf16x8*)(kp);        kf[1] = *(const LAS bf16x8*)(kp + 512);
    kf[2] = *(const LAS bf16x8*)(kp + 2048); kf[3] = *(const LAS bf16x8*)(kp + 2560);
    kf[4] = *(const LAS bf16x8*)(kp + 4096); kf[5] = *(const LAS bf16x8*)(kp + 4608);
    kf[6] = *(const LAS bf16x8*)(kp + 6144); kf[7] = *(const LAS bf16x8*)(kp + 6656);
}
__device__ __forceinline__ void kload2(bf16x8* kf, lds_cptr kp, int j) { kf[2 * j] = *(const LAS bf16x8*)(kp + j * 2048); kf[2 * j + 1] = *(const LAS bf16x8*)(kp + j * 2048 + 512); }
__device__ __forceinline__ s16x4 vtr(lds_cptr p) { return __builtin_bit_cast(s16x4, __builtin_amdgcn_ds_read_tr16_b64_v4i16((LAS v4i16_t*)p)); }
__device__ __forceinline__ float rowmax(const f32x16& p0, const f32x16& p1) {
    float a = max3f(p0[0], p0[1], p1[0]), b = max3f(p0[2], p0[3], p1[1]); a = max3f(a, p1[2], p1[3]);
#pragma unroll
    for (int r = 4; r < 16; r += 4) { a = max3f(a, p0[r], p0[r + 1]); b = max3f(b, p0[r + 2], p0[r + 3]); a = max3f(a, p1[r], p1[r + 1]); b = max3f(b, p1[r + 2], p1[r + 3]); }
    const float m = max2f(a, b);
    auto rr = __builtin_amdgcn_permlane32_swap(__float_as_uint(m), __float_as_uint(m), false, false);
    return max2f(__uint_as_float(rr[0]), __uint_as_float(rr[1]));
}
__device__ __forceinline__ void pv(f32x16* o, int vb, bf16x8 pa0, bf16x8 pa1, bf16x8 pa2, bf16x8 pa3) {
#pragma unroll
    for (int d0 = 0; d0 < 2; ++d0) { s16x4 lo[4], hi[4];
#pragma unroll
        for (int ks = 0; ks < 4; ++ks) {
            asm volatile("ds_read_b64_tr_b16 %0,%1 offset:%c2" : "=&v"(lo[ks]) : "v"(vb), "i"(d0 * 4096 + ks * 1024) : "memory");
            asm volatile("ds_read_b64_tr_b16 %0,%1 offset:%c2" : "=&v"(hi[ks]) : "v"(vb), "i"(d0 * 4096 + ks * 1024 + 512) : "memory"); }
        asm volatile("s_waitcnt lgkmcnt(0)" ::: "memory"); SBAR();
#define PK(k) (bf16x8){lo[k][0], lo[k][1], lo[k][2], lo[k][3], hi[k][0], hi[k][1], hi[k][2], hi[k][3]}
        o[d0] = __builtin_amdgcn_mfma_f32_32x32x16_bf16(pa0, PK(0), o[d0], 0, 0, 0);
        o[d0] = __builtin_amdgcn_mfma_f32_32x32x16_bf16(pa1, PK(1), o[d0], 0, 0, 0);
        o[d0] = __builtin_amdgcn_mfma_f32_32x32x16_bf16(pa2, PK(2), o[d0], 0, 0, 0);
        o[d0] = __builtin_amdgcn_mfma_f32_32x32x16_bf16(pa3, PK(3), o[d0], 0, 0, 0);
#undef PK
    }
}
__device__ __forceinline__ void apply_mask(f32x16& p0, f32x16& p1, unsigned w0, unsigned w1, float mh) {
#pragma unroll
    for (int r = 0; r < 16; ++r) { const int c = (r & 3) + 8 * (r >> 2);
        const unsigned m0 = (unsigned)__builtin_amdgcn_sbfe((int)w0, c, 1), m1 = (unsigned)__builtin_amdgcn_sbfe((int)w1, c, 1);
        p0[r] = __uint_as_float((__float_as_uint(p0[r] - mh) & m0) | (0xff800000u & ~m0));
        p1[r] = __uint_as_float((__float_as_uint(p1[r] - mh) & m1) | (0xff800000u & ~m1)); }
}
__device__ __forceinline__ void apply_bias(f32x16& p0, f32x16& p1, lds_cptr bp) {
#pragma unroll
    for (int r = 0; r < 16; ++r) { const int c = (r & 3) + 8 * (r >> 2);
        p0[r] += *(const LAS float*)(bp + 4 * c); p1[r] += *(const LAS float*)(bp + 4 * c + 128); }
}

#ifdef ABL_NOBIAS
#define ABL_NOBIAS_V 1
#else
#define ABL_NOBIAS_V 0
#endif
#ifndef ATTN_THRL
#define ATTN_THRL 8
#endif
__device__ __forceinline__ void attn_unit(int b, int h, int qb, const bf16_t* Q, const bf16_t* __restrict__ K, const bf16_t* __restrict__ V, bf16_t* O,
                                          const unsigned* __restrict__ mask, const float* __restrict__ rel_bias, char* shm) {
    constexpr int THRL = ATTN_THRL;
    const int tid = threadIdx.x, lane = tid & 63, r32 = lane & 31, hi = lane >> 5; const int wid = __builtin_amdgcn_readfirstlane(tid >> 6);
    const long rowbase = (long)b * SEQ; const int q0 = qb * QB; const int g = h >> 2;
    const bf16_t* Qw = Q + (rowbase + q0 + wid * QBLK) * QP + h * D;
    const bf16_t* Kh = K + rowbase * KP + g * D; const bf16_t* Vh = V + rowbase * VP + g * D;
    const unsigned lds0 = (unsigned)(uintptr_t)shm;
    float* wsf = (float*)(shm + LDS_WS) + wid * 64;
    const bf16_t* ksrc = Kh + (long)lane * KP + wid * 8;
    const bf16_t* vsrc = Vh + (long)(16 * (wid & 3) + (lane >> 2)) * VP + (wid >> 2) * 32 + (lane & 3) * 8;
    const unsigned* msrc = mask + ((size_t)b * 64 * SEQ + q0 + wid * QBLK) * 2 + lane;
    const unsigned kdst = lds0 + LDS_K + wid * 1024, vdst = lds0 + LDS_V + wid * 1024, mdst = lds0 + LDS_M + wid * 256;
#define DMA_K(t, slot) glds16(ksrc + (long)(t) * KVBLK * KP, (unsigned)__builtin_amdgcn_readfirstlane(kdst + (slot)))
#define DMA_V(t, slot) glds16(vsrc + (long)(t) * KVBLK * VP, (unsigned)__builtin_amdgcn_readfirstlane(vdst + (slot)))
#define DMA_M(t, slot) glds4(msrc + (size_t)(t) * SEQ * 2, (unsigned)__builtin_amdgcn_readfirstlane(mdst + ((slot) >> 2)))
    const int vb0 = (int)(lds0 + LDS_V) + ((lane >> 4) & 1) * 32 + (lane & 3) * 8 + (4 * hi + ((lane & 15) >> 2)) * 64;
    const char* Kbase = shm + LDS_K; bf16x8 kf[8];
    const lds_cptr shm3 = (lds_cptr)shm; const lds_cptr kp0 = shm3 + LDS_K + hi * 1024 + r32 * 16; const lds_cptr vp0 = shm3 + LDS_V + ((lane >> 4) & 1) * 32 + (lane & 3) * 8 + (4 * hi + ((lane & 15) >> 2)) * 64;
    const lds_cptr mp0 = shm3 + LDS_M + wid * 256 + r32 * 8;
    const int NT = (q0 + QB) / KVBLK;
    { float* TR = (float*)(shm + LDS_BT); const float cfar = rel_bias[31 * 8 + h];
      for (int j = tid; j < BT_N; j += 512) { const int d = 447 - j; float v = 0.f;
          if (d >= 0 && d < 113) { int bk;
              if (d < 16) bk = d; else { bk = 16 + (d >= 19) + (d >= 21) + (d >= 24) + (d >= 27) + (d >= 31) + (d >= 35) + (d >= 40) + (d >= 46) + (d >= 52) + (d >= 59) + (d >= 67) + (d >= 77) + (d >= 87) + (d >= 99); }
              v = (rel_bias[bk * 8 + h] - cfar) * LOG2E; }
          TR[j] = v; } }
    DMA_K(0, 0); DMA_V(0, 0); DMA_K(1, SLOTB); DMA_M(0, 0); DMA_M(1, SLOTB);
    bf16x8 qr[4];
#pragma unroll
    for (int d0 = 0; d0 < 4; ++d0) qr[d0] = *reinterpret_cast<const bf16x8*>(&Qw[(long)r32 * QP + d0 * 16 + hi * 8]);
    float mhat = 0.f, l_reg = 0.f; f32x16 o[2]; o[0] = f32x16{}; o[1] = f32x16{}; const f32x16 zero16 = f32x16{};
    const int qrel = wid * QBLK + r32;
#define BIASP(t) (shm3 + LDS_BT + 4 * (447 - qrel + 4 * hi - 64 * (NT - 4 - (t))))
    bool resc = false;
#define START(P0, P1) do { const float rm = rowmax(P0, P1); resc = false; \
    { const float dl = __builtin_fmaxf(rm, -256.f); mhat = fadd_s(mhat, dl); \
      _Pragma("unroll") for (int r = 0; r < 16; ++r) { P0[r] = fsub_s(P0[r], dl); P1[r] = fsub_s(P1[r], dl); } \
      } \
    _Pragma("unroll") for (int r = 0; r < 16; ++r) P0[r] = __builtin_amdgcn_exp2f(P0[r]); } while (0)
#define RESC() do { if (resc) { asm volatile("s_waitcnt lgkmcnt(0)" ::: "memory"); \
      _Pragma("unroll") for (int d_ = 0; d_ < 2; ++d_) _Pragma("unroll") for (int r = 0; r < 16; ++r) o[d_][r] *= wsf[crow(r, hi)]; } } while (0)
    f32x16 pA0, pA1, pB0, pB1;
    int sl_prev = 0, sl_cur = 0, sl_next = SLOTB;
#define ROT() do { sl_prev = sl_cur; sl_cur = sl_next; sl_next = (sl_next == (NSLOT - 1) * SLOTB) ? 0 : sl_next + SLOTB; } while (0)
    DMA_K(2, 2 * SLOTB);
    WAIT_BAR(3);
    u32x2 mw = *(const LAS u32x2*)(mp0);
    qkt(pA0, pA1, Kbase, qr, zero16, r32, hi); asm volatile("s_nop 15\n\ts_nop 7" : "+v"(pA0), "+v"(pA1));
    apply_mask(pA0, pA1, mw.x >> (4 * hi), mw.y >> (4 * hi), 0.f);
#ifndef ABL_NOBIAS
    if (NT <= 7) apply_bias(pA0, pA1, BIASP(0));
#endif
    START(pA0, pA1);
    _Pragma("unroll") for (int r = 0; r < 16; ++r) pA1[r] = __builtin_amdgcn_exp2f(pA1[r]);
    WAIT_BAR(0);
    DMA_K(3, 0); DMA_V(1, SLOTB); DMA_M(2, 2 * SLOTB);
    ROT();
    kload8(kf, kp0 + sl_cur);
    WAIT_BAR(3);
    s16x4 vlo[8], vhi[8]; u32x4 pw0, pw1, pw2, pw3;
#define PKW(P, B) cvtpk_s(P[B], P[B + 1])
#define PAF(k) __builtin_bit_cast(bf16x8, pw##k)
#define VFR(i) (bf16x8){vlo[i][0], vlo[i][1], vlo[i][2], vlo[i][3], vhi[i][0], vhi[i][1], vhi[i][2], vhi[i][3]}
#define PIN(x) asm volatile("" : "+v"(x))
#define MX3(a, b, c) __builtin_fmaxf(__builtin_fmaxf((a), (b)), (c))
#define GAPA(MF, A0, A1, A2, A3, W0, W1, PW) do { MF; sacc += A0; sacc += A1; sacc += A2; sacc += A3; PIN(sacc); W0; W1; PIN(PW); SBAR(); } while (0)
#define EX(v) __builtin_amdgcn_exp2f(v)
#define GAPB(MF, X, B) do { MF; X[B] = EX(X[B]); X[B + 1] = EX(X[B + 1]); X[B + 2] = EX(X[B + 2]); X[B + 3] = EX(X[B + 3]); PIN(X); SBAR(); } while (0)
#define VRD(i) do { vlo[i] = vtr(vp_ + (((i) >> 2) * 4096 + ((i) & 3) * 1024)); vhi[i] = vtr(vp_ + (((i) >> 2) * 4096 + ((i) & 3) * 1024 + 512)); } while (0)
#define KRD(G, j) do { if (G) { kload2(kf, kp0 + sl_next, j); SBAR(); } } while (0)
#define STEP(C0, C1, P0, P1, t, GK, GV, GM, GL, GB) do { SBAR(); \
    const lds_cptr vp_ = vp0 + sl_prev; \
    const u32x2 mw_ = *(const LAS u32x2*)(mp0 + (sl_cur >> 2)); \
    VRD(0); SBAR(); float sacc = (P0[0] + P0[1]); \
    GAPA(C0 = __builtin_amdgcn_mfma_f32_32x32x16_bf16(kf[0], qr[0], zero16, 0, 0, 0), P0[2], P0[3], P0[4], P0[5],     pw0[0] = PKW(P0, 0), pw0[1] = PKW(P0, 2), pw0); \
    VRD(4); SBAR(); GAPA(C1 = __builtin_amdgcn_mfma_f32_32x32x16_bf16(kf[1], qr[0], zero16, 0, 0, 0), P0[6], P0[7], P0[8], P0[9],     pw0[2] = PKW(P0, 4), pw0[3] = PKW(P0, 6), pw0); \
    VRD(1); SBAR(); GAPA(C0 = __builtin_amdgcn_mfma_f32_32x32x16_bf16(kf[2], qr[1], C0, 0, 0, 0),   P0[10], P0[11], P0[12], P0[13], pw1[0] = PKW(P0, 8), pw1[1] = PKW(P0, 10), pw1); \
    VRD(5); SBAR(); GAPA(C1 = __builtin_amdgcn_mfma_f32_32x32x16_bf16(kf[3], qr[1], C1, 0, 0, 0),   P0[14], P0[15], P1[0], P1[1],   pw1[2] = PKW(P0, 12), pw1[3] = PKW(P0, 14), pw1); \
    VRD(2); SBAR(); GAPA(C0 = __builtin_amdgcn_mfma_f32_32x32x16_bf16(kf[4], qr[2], C0, 0, 0, 0),   P1[2], P1[3], P1[4], P1[5],     pw2[0] = PKW(P1, 0), pw2[1] = PKW(P1, 2), pw2); \
    VRD(6); SBAR(); GAPA(C1 = __builtin_amdgcn_mfma_f32_32x32x16_bf16(kf[5], qr[2], C1, 0, 0, 0),   P1[6], P1[7], P1[8], P1[9],     pw2[2] = PKW(P1, 4), pw2[3] = PKW(P1, 6), pw2); \
    VRD(3); SBAR(); GAPA(C0 = __builtin_amdgcn_mfma_f32_32x32x16_bf16(kf[6], qr[3], C0, 0, 0, 0),   P1[10], P1[11], P1[12], P1[13], pw3[0] = PKW(P1, 8), pw3[1] = PKW(P1, 10), pw3); \
    VRD(7); SBAR(); GAPA(C1 = __builtin_amdgcn_mfma_f32_32x32x16_bf16(kf[7], qr[3], C1, 0, 0, 0),   P1[14], P1[15], 0.f, 0.f,       pw3[2] = PKW(P1, 12), pw3[3] = PKW(P1, 14), pw3); \
    l_reg += sacc; \
    if (GK) { DMA_K((t) + 3, sl_cur); } if (GV) { DMA_V((t) + 1, sl_next); } if (GM) { DMA_M((t) + 2, sl_prev); } \
    apply_mask(C0, C1, mw_.x >> (4 * hi), mw_.y >> (4 * hi), mhat); \
    if (GB && !ABL_NOBIAS_V) { apply_bias(C0, C1, BIASP(t)); } \
    { float a = MX3(C0[0], C0[1], C1[0]), b = MX3(C0[2], C0[3], C1[1]); a = MX3(a, C1[2], C1[3]); \
      _Pragma("unroll") for (int r = 4; r < 16; r += 4) { a = MX3(a, C0[r], C0[r + 1]); b = MX3(b, C0[r + 2], C0[r + 3]); a = MX3(a, C1[r], C1[r + 1]); b = MX3(b, C1[r + 2], C1[r + 3]); } \
      float rm = __builtin_fmaxf(a, b); { auto rr = __builtin_amdgcn_permlane32_swap(__float_as_uint(rm), __float_as_uint(rm), false, false); rm = __builtin_fmaxf(__uint_as_float(rr[0]), __uint_as_float(rr[1])); } \
      resc = false; \
      if (__builtin_expect(__any(rm > (float)THRL), 0)) { const float dl = __builtin_fmaxf(rm, 0.f); mhat += dl; \
        _Pragma("unroll") for (int r = 0; r < 16; ++r) { C0[r] -= dl; C1[r] -= dl; } \
        const float f = __builtin_amdgcn_exp2f(-dl); l_reg *= f; if (hi == 0) wsf[r32] = f; resc = true; } } \
    SBAR(); \
    GAPB(o[0] = __builtin_amdgcn_mfma_f32_32x32x16_bf16(PAF(0), VFR(0), o[0], 0, 0, 0), C0, 0); \
    GAPB(o[1] = __builtin_amdgcn_mfma_f32_32x32x16_bf16(PAF(0), VFR(4), o[1], 0, 0, 0), C0, 4); \
    KRD(GL, 0); GAPB(o[0] = __builtin_amdgcn_mfma_f32_32x32x16_bf16(PAF(1), VFR(1), o[0], 0, 0, 0), C0, 8); \
    KRD(GL, 1); GAPB(o[1] = __builtin_amdgcn_mfma_f32_32x32x16_bf16(PAF(1), VFR(5), o[1], 0, 0, 0), C0, 12); \
    KRD(GL, 2); GAPB(o[0] = __builtin_amdgcn_mfma_f32_32x32x16_bf16(PAF(2), VFR(2), o[0], 0, 0, 0), C1, 0); \
    KRD(GL, 3); GAPB(o[1] = __builtin_amdgcn_mfma_f32_32x32x16_bf16(PAF(2), VFR(6), o[1], 0, 0, 0), C1, 4); \
    GAPB(o[0] = __builtin_amdgcn_mfma_f32_32x32x16_bf16(PAF(3), VFR(3), o[0], 0, 0, 0), C1, 8); \
    GAPB(o[1] = __builtin_amdgcn_mfma_f32_32x32x16_bf16(PAF(3), VFR(7), o[1], 0, 0, 0), C1, 12); \
    } while (0)
    int t = 1;
    for (; t + 7 < NT; t += 2) {
        STEP(pB0, pB1, pA0, pA1, t, true, true, true, true, false);     WAIT_BAR(3); RESC(); ROT();
        STEP(pA0, pA1, pB0, pB1, t + 1, true, true, true, true, false); WAIT_BAR(3); RESC(); ROT();
    }
#define ENDW(tt) do { if ((tt) + 3 < NT) { WAIT_BAR(3); } else if ((tt) + 2 < NT) { WAIT_BAR(2); } else { WAIT_BAR(0); } } while (0)
    for (; t + 1 < NT; t += 2) {
        STEP(pB0, pB1, pA0, pA1, t, (t + 3 < NT), (t + 1 < NT), (t + 2 < NT), (t + 1 < NT), (t + 7 >= NT));         ENDW(t);     RESC(); ROT();
        STEP(pA0, pA1, pB0, pB1, t + 1, (t + 4 < NT), (t + 2 < NT), (t + 3 < NT), (t + 2 < NT), (t + 8 >= NT));     ENDW(t + 1); RESC(); ROT();
    }
    STEP(pB0, pB1, pA0, pA1, NT - 1, false, false, false, false, true); RESC();
    { float sacc = pB0[0] + pB0[1]; _Pragma("unroll") for (int r = 2; r < 16; ++r) sacc += pB0[r]; _Pragma("unroll") for (int r = 0; r < 16; ++r) sacc += pB1[r]; l_reg += sacc;
      pw0 = (u32x4){PKW(pB0, 0), PKW(pB0, 2), PKW(pB0, 4), PKW(pB0, 6)}; pw1 = (u32x4){PKW(pB0, 8), PKW(pB0, 10), PKW(pB0, 12), PKW(pB0, 14)}; pw2 = (u32x4){PKW(pB1, 0), PKW(pB1, 2), PKW(pB1, 4), PKW(pB1, 6)}; pw3 = (u32x4){PKW(pB1, 8), PKW(pB1, 10), PKW(pB1, 12), PKW(pB1, 14)};
      SBAR(); pv(o, vb0 + sl_cur, PAF(0), PAF(1), PAF(2), PAF(3)); }
#undef PKW
#undef PAF
#undef VFR
#undef PIN
#undef MX3
#undef GAPA
#undef GAPB
#undef EX
#undef VRD
#undef KRD
#undef STEP
#undef ENDW
    { auto rr = __builtin_amdgcn_permlane32_swap(__float_as_uint(l_reg), __float_as_uint(l_reg), false, false); l_reg = __uint_as_float(rr[0]) + __uint_as_float(rr[1]); }
    if (hi == 0) wsf[32 + r32] = l_reg; asm volatile("s_waitcnt lgkmcnt(0)" ::: "memory");
    float rli[16];
#pragma unroll
    for (int r = 0; r < 16; ++r) rli[r] = __builtin_amdgcn_rcpf(wsf[32 + crow(r, hi)]);
    bf16_t* Ow = O + (rowbase + q0 + wid * QBLK) * OP + h * D;
    { bf16_t* stg = (bf16_t*)(shm + LDS_OST) + wid * 2048;
#pragma unroll
      for (int r = 0; r < 16; ++r) { const int orow = crow(r, hi);
#pragma unroll
          for (int d0 = 0; d0 < 2; ++d0) stg[orow * 64 + d0 * 32 + r32] = (bf16_t)f2bf(o[d0][r] * rli[r]
#ifdef ABL_NOATTN
              * 0.f
#endif
              ); }
      asm volatile("s_waitcnt lgkmcnt(0)" ::: "memory");
#pragma unroll
      for (int i = 0; i < 4; ++i) { const int row = i * 8 + (lane >> 3), ch = lane & 7; const u32x4 v = *(const u32x4*)(stg + row * 64 + ch * 8); *(u32x4*)(Ow + (long)row * OP + ch * 8) = v; } }
    asm volatile("s_waitcnt lgkmcnt(0)\n\ts_barrier" ::: "memory");
#undef DMA_K
#undef DMA_V
#undef DMA_M
#undef START
#undef RESC
#undef ROT
#undef BIASP
}
#undef SBAR
#undef WAIT_BAR
}
constexpr size_t MiB = 1u << 20;
constexpr size_t WS_CTL = 0, CTL_ZERO_BYTES = 1 * MiB;
constexpr size_t WS_MOD = 1 * MiB;
constexpr size_t WS_ROT = 2 * MiB;
constexpr size_t WS_TOPE = 4 * MiB;
constexpr size_t WS_GATE = WS_TOPE + 512 * 1024;
constexpr size_t WS_RANK = 5 * MiB;
constexpr size_t WS_POS = WS_RANK + 512 * 1024;
constexpr size_t WS_ROWTOK = 6 * MiB;
constexpr size_t WS_ROWGATE = 7 * MiB;
constexpr size_t WS_BLKEXP = 8 * MiB;
constexpr size_t WS_ROWSCALE = 9 * MiB;
constexpr size_t WS_WIN = 10 * MiB;
constexpr size_t WS_WOUT = 17 * MiB;
constexpr size_t WS_WGU = 20 * MiB;
constexpr size_t WS_SWGU = 100 * MiB;
constexpr size_t WS_WD = 148 * MiB;
constexpr size_t WS_SWD = 101 * MiB;
constexpr size_t WS_WINQ = 102 * MiB;
constexpr size_t WS_SWIN = 106 * MiB;
constexpr size_t WS_SH = 107 * MiB;
constexpr size_t WS_HQ = 108 * MiB;
constexpr size_t WS_X1 = 212 * MiB;
constexpr size_t WS_H2 = 340 * MiB;
constexpr size_t WS_STOK = 380 * MiB;
constexpr size_t WS_ACT = 404 * MiB;
constexpr size_t WS_Y = 676 * MiB;
constexpr size_t WS_END = 948 * MiB;
constexpr size_t WS_H = 404 * MiB;
constexpr size_t WS_QA = 468 * MiB, WS_KA = 500 * MiB, WS_VA = 508 * MiB, WS_QI = 516 * MiB, WS_KIW = 532 * MiB;
constexpr size_t WS_QR = 540 * MiB, WS_KR = 572 * MiB, WS_VR = 604 * MiB, WS_GR = 636 * MiB;
constexpr size_t WS_MIX = 468 * MiB;
constexpr size_t WS_MASK = 668 * MiB;
constexpr size_t WS_U = 684 * MiB;
constexpr size_t WS_S = 748 * MiB;
static_assert(WS_S + 32 * MiB <= WS_END, "ws map");
constexpr int CW_BAR = 4096;
constexpr int CW_QUEUE = 2048;
constexpr int CW_CNT = 1024;
constexpr int CW_AMAXIN = 240000;
constexpr int CW_AMAXD = 196608;
constexpr int CW_AMAX = 131072;

constexpr int NWAVES = 8;
constexpr int LDS_BYTES = 160 * 1024;

#define XB_TMO      128
#define XB_XCNT(j)  (256  + 64 * (j))
#define XB_XSUB(j)  (1280 + 64 * (j))
#define XB_XGEN(j)  (2304 + 64 * (j))
#define XB_TOP      3328
#define XB_TOPGEN   3392
#define XCD_BAR_WORDS 3456
#define XB_SPIN_CAP (1u << 22)
__device__ __forceinline__ unsigned xb_ld(unsigned* p)              { return __hip_atomic_load(p, __ATOMIC_RELAXED, __HIP_MEMORY_SCOPE_AGENT); }
__device__ __forceinline__ unsigned xb_add(unsigned* p, unsigned v) { return __hip_atomic_fetch_add(p, v, __ATOMIC_RELAXED, __HIP_MEMORY_SCOPE_AGENT); }
__device__ __forceinline__ unsigned xb_xcc_id() { return (unsigned)__builtin_amdgcn_s_getreg((3 << 11) | 20) & 0xFu; }
#define XB_SPIN(cond, bar) do { unsigned _sp = 0; while (cond) { __builtin_amdgcn_s_sleep(1); \
    if ((++_sp & 255u) == 0u) { if (xb_ld(&(bar)[XB_TMO])) break; if (_sp > XB_SPIN_CAP) { atomicAdd(&(bar)[XB_TMO], 1u); break; } } } } while (0)
struct XcdBarrier { unsigned* bar; unsigned x; volatile LAS unsigned* st; };
__device__ __forceinline__ XcdBarrier xcd_barrier_post(unsigned* bar, volatile LAS unsigned* st) {
    XcdBarrier b; b.bar = bar; b.x = xb_xcc_id(); b.st = st;
    if (threadIdx.x == 0) (void)xb_add(&bar[XB_XCNT(b.x)], 1u);
    return b;
}
__device__ __forceinline__ void xcd_barrier_complete(unsigned* bar, unsigned x, unsigned& nloc, unsigned& nx) {
    const unsigned G = gridDim.x * gridDim.y * gridDim.z;
    unsigned sum, cnt, mine, sp = 0u;
    for (;;) {
        sum = 0u; cnt = 0u; mine = 0u;
#pragma unroll
        for (unsigned j = 0; j < 16; ++j) { const unsigned c = xb_ld(&bar[XB_XCNT(j)]); sum += c; cnt += (c > 0u) ? 1u : 0u; mine = (j == x) ? c : mine; }
        if (sum == G) break;
        __builtin_amdgcn_s_sleep(1);
        if ((++sp & 255u) == 0u) { if (xb_ld(&bar[XB_TMO])) break; if (sp > XB_SPIN_CAP) { atomicAdd(&bar[XB_TMO], 1u); break; } }
    }
    nloc = mine > 0u ? mine : 1u; nx = cnt > 0u ? cnt : 1u;
}
__device__ __forceinline__ void xcd_barrier(const XcdBarrier& b) {
    asm volatile("s_waitcnt vmcnt(0)" ::: "memory");
    __syncthreads();
    if (threadIdx.x == 0) {
        unsigned* bar = b.bar;
        __builtin_amdgcn_s_waitcnt(0);
        unsigned nloc = b.st[0], nx = b.st[1];
        if (nloc == 0u) { xcd_barrier_complete(bar, b.x, nloc, nx); b.st[0] = nloc; b.st[1] = nx; }
        const unsigned old = xb_add(&bar[XB_XSUB(b.x)], 1u);
        const unsigned gen = old / nloc;
        if (old + 1u == (gen + 1u) * nloc) {
            __builtin_amdgcn_fence(__ATOMIC_RELEASE, "agent");
            asm volatile("s_waitcnt vmcnt(0)" ::: "memory");
            const unsigned og = xb_add(&bar[XB_TOP], 1u);
            const unsigned tg = og / nx;
            if (og + 1u == (tg + 1u) * nx) xb_add(&bar[XB_TOPGEN], 1u);
            else XB_SPIN(xb_ld(&bar[XB_TOPGEN]) == tg, bar);
            __builtin_amdgcn_fence(__ATOMIC_ACQUIRE, "agent");
            xb_add(&bar[XB_XGEN(b.x)], 1u);
            asm volatile("s_waitcnt vmcnt(0)" ::: "memory");
        } else {
            XB_SPIN(xb_ld(&bar[XB_XGEN(b.x)]) == gen, bar);
            __builtin_amdgcn_fence(__ATOMIC_ACQUIRE, "agent");
            asm volatile("s_waitcnt vmcnt(0)" ::: "memory");
        }
    }
    __syncthreads();
}

struct Frame {
    unsigned char* ws; int tid, lane, wave, vcu, G;
    const float *x, *c, *rel_bias, *w_ada, *b_ada, *w_in, *ret_g, *w_out, *ln1_g, *ln1_b, *w_router, *b_router, *w_gu, *b_gu, *w_d, *b_d, *ln2_g, *ln2_b;
    float* out;
};
__device__ __forceinline__ float wave_sum(float v) {
#pragma unroll
    for (int o = 1; o < 64; o <<= 1) v += __shfl_xor(v, o);
    return v;
}
__device__ __forceinline__ float wave_max(float v) {
#pragma unroll
    for (int o = 1; o < 64; o <<= 1) v = fmaxf(v, __shfl_xor(v, o));
    return v;
}
#define LDS_WAIT() asm volatile("s_waitcnt lgkmcnt(0)" ::: "memory")
__device__ __forceinline__ void p0_transpose_item(const float* W, int K, int N, int src_col0, bf16_t* WT, int dest_row0, int k0, LAS float* scr, int lane) {
#pragma unroll 8
    for (int i = 0; i < 32; ++i) { const int kk = 2 * i + (lane >> 5); scr[kk * 33 + (lane & 31)] = W[(size_t)(k0 + kk) * N + src_col0 + (lane & 31)]; }
    LDS_WAIT(); asm volatile("" ::: "memory");
    const int c = lane & 7;
#pragma unroll
    for (int j = 0; j < 4; ++j) { const int n = (lane >> 3) + 8 * j; const LAS float* s = scr + (8 * c) * 33 + n;
        u32x4 o; o.x = pk2(s[0 * 33], s[1 * 33]); o.y = pk2(s[2 * 33], s[3 * 33]); o.z = pk2(s[4 * 33], s[5 * 33]); o.w = pk2(s[6 * 33], s[7 * 33]);
        *(u32x4*)(WT + (size_t)(dest_row0 + n) * K + k0 + 8 * c) = o; }
    LDS_WAIT(); asm volatile("" ::: "memory");
}
__device__ __forceinline__ void p0_absmax_item(const float* W  , int N, int n0, int k0, unsigned* amax  , int lane) {
    const float* wp = W + (size_t)(k0 + (lane >> 5)) * N + n0 + (lane & 31);
    float m = 0.f;
#pragma unroll
    for (int i = 0; i < 32; ++i) m = fmaxf(m, fabsf(wp[(size_t)i * 2 * N]));
    { const unsigned u = __float_as_uint(m); auto r = __builtin_amdgcn_permlane32_swap(u, u, false, false); m = fmaxf(__uint_as_float(r[0]), __uint_as_float(r[1])); }
    if (lane < 32) atomicMax(amax + lane, __float_as_uint(m));
}
__device__ __forceinline__ void p1_quant_item(const float* W, int N, float widen, int n0, int k0, signed char* WQ  , const unsigned* amax, float* SW, LAS float* scr, int lane) {
    const float mx = widen * __uint_as_float(amax[lane & 31]); const float inv = mx > 0.f ? 127.0f / mx : 0.f;
    if (k0 == 0 && lane < 32) SW[lane] = mx > 0.f ? mx * (1.0f / 127.0f) : 1.0f;
    const float* wp = W + (size_t)(k0 + (lane >> 5)) * N + n0 + (lane & 31);
#pragma unroll
    for (int i = 0; i < 32; ++i) { const int kk = 2 * i + (lane >> 5); scr[kk * 33 + (lane & 31)] = wp[(size_t)i * 2 * N] * inv; }
    LDS_WAIT(); asm volatile("" ::: "memory");
    const int c = lane & 7;
#pragma unroll
    for (int j = 0; j < 4; ++j) { const int n = (lane >> 3) + 8 * j; const LAS float* sp = scr + (8 * c) * 33 + n;
        int q[8];
#pragma unroll
        for (int t = 0; t < 8; ++t) q[t] = (int)rintf(fminf(fmaxf(sp[t * 33], -127.0f), 127.0f)) & 0xff;
        u32x2 o; o.x = (unsigned)(q[0] | (q[1] << 8) | (q[2] << 16) | (q[3] << 24)); o.y = (unsigned)(q[4] | (q[5] << 8) | (q[6] << 16) | (q[7] << 24));
        *(u32x2*)(WQ + (size_t)n * 1024 + k0 + 8 * c) = o; }
    LDS_WAIT(); asm volatile("" ::: "memory");
}
__device__ __forceinline__ void p1_fp8_item(const float* W  , int n0, int k0, unsigned char* WQ  , const unsigned* amax, float* SW, LAS float* scr, int lane) {
    const float mx = 1.25f * __uint_as_float(amax[lane & 31]); const float inv = mx > 0.f ? 224.0f / mx : 0.f;
    if (k0 == 0 && lane < 32) SW[lane] = mx > 0.f ? mx * (1.0f / 224.0f) : 1.0f;
    const float* wp = W + (size_t)(k0 + (lane >> 5)) * 1024 + n0 + (lane & 31);
#pragma unroll
    for (int i = 0; i < 32; ++i) { const int kk = 2 * i + (lane >> 5); scr[kk * 33 + (lane & 31)] = __builtin_amdgcn_fmed3f(wp[(size_t)i * 2048] * inv, -448.0f, 448.0f); }
    LDS_WAIT(); asm volatile("" ::: "memory");
    const int c = lane & 7;
#pragma unroll
    for (int j = 0; j < 4; ++j) { const int n = (lane >> 3) + 8 * j; const LAS float* sp = scr + (8 * c) * 33 + n;
        int w0 = __builtin_amdgcn_cvt_pk_fp8_f32(sp[0 * 33], sp[1 * 33], 0, false); w0 = __builtin_amdgcn_cvt_pk_fp8_f32(sp[2 * 33], sp[3 * 33], w0, true);
        int w1 = __builtin_amdgcn_cvt_pk_fp8_f32(sp[4 * 33], sp[5 * 33], 0, false); w1 = __builtin_amdgcn_cvt_pk_fp8_f32(sp[6 * 33], sp[7 * 33], w1, true);
        u32x2 o; o.x = (unsigned)w0; o.y = (unsigned)w1;
        *(u32x2*)(WQ + (size_t)n * 1024 + k0 + 8 * c) = o; }
    LDS_WAIT(); asm volatile("" ::: "memory");
}
__device__ __forceinline__ void p0_prologue(Frame& F, LAS unsigned char* lds) {
    LAS float* scr = (LAS float*)(lds + F.wave * 16384);
    const int gw = F.vcu * NWAVES + F.wave, NGW = F.G * NWAVES;
    bf16_t* WinT = (bf16_t*)(F.ws + WS_WIN); bf16_t* WoutT = (bf16_t*)(F.ws + WS_WOUT); unsigned* amaxgu = (unsigned*)(F.ws + WS_CTL) + CW_AMAX; unsigned* amaxd = (unsigned*)(F.ws + WS_CTL) + CW_AMAXD; unsigned* amaxin = (unsigned*)(F.ws + WS_CTL) + CW_AMAXIN;
    if (F.vcu < 96) {
        LAS float* red = (LAS float*)(lds + 32768);
        LAS float* sil = (LAS float*)(lds);
        for (int i = F.tid; i < 8 * DM; i += 512) { const float cv = F.c[i]; sil[i] = cv / (1.f + __expf(-cv)); }
        __syncthreads();
        for (int it = F.vcu; it < 96; it += F.G) {
            const int n = it * 64 + F.lane; float a[8];
#pragma unroll
            for (int b = 0; b < 8; ++b) a[b] = 0.f;
            const float* wp = F.w_ada + (size_t)(F.wave * 128) * 6144 + n;
#pragma unroll 8
            for (int kk = 0; kk < 128; ++kk) {
                const float w = wp[(size_t)kk * 6144];
#pragma unroll
                for (int b = 0; b < 8; ++b) a[b] = fmaf(sil[b * DM + F.wave * 128 + kk], w, a[b]);
            }
#pragma unroll
            for (int b = 0; b < 8; ++b) red[(F.wave * 8 + b) * 64 + F.lane] = a[b];
            __syncthreads();
            { const int b = F.wave; float s = F.b_ada[n];
#pragma unroll
              for (int w = 0; w < 8; ++w) s += red[(w * 8 + b) * 64 + F.lane];
              ((float*)(F.ws + WS_MOD))[b * 6144 + n] = s; }
            __syncthreads();
        }
    }
    {
        float* rc = (float*)(F.ws + WS_ROT); float* rs = rc + SEQ * 64;
        for (int i = (F.vcu * 512 + F.tid); i < SEQ * 64; i += F.G * 512) { const int t = i >> 6, j = i & 63;
            const float inv = 1.0f / powf(10000.0f, (float)(2 * j) / 128.0f); const float ang = (float)t * inv;
            rc[i] = (float)cos((double)ang); rs[i] = (float)sin((double)ang); }
    }
    constexpr int I_IN_A = 34 * 16, I_IN_B = 64 * 16, I_OUT = 32 * 16, I_GU = 32 * 64 * 4, I_D = 32 * 32 * 4, I_PAD = 192;
    constexpr int I_INQ = (24 + 64) * 16;
    constexpr int NITEMS = I_IN_A + I_IN_B + I_OUT + I_GU + I_D + I_PAD + I_INQ;
    for (int it = gw; it < NITEMS; it += NGW) {
        int r = it;
        if (r < I_GU) { const int e = r >> 8, q = r & 255, nb = q >> 2, kb = (q & 3) * 4; const int n0 = 32 * nb;
            const int half = n0 >> 10, nn = n0 & 1023; const int drow = (nn >> 7) * 256 + half * 128 + (nn & 127);
            p0_absmax_item(F.w_gu + (size_t)e * DM * 2048, 2048, n0, 64 * kb, amaxgu + e * 2048 + drow, F.lane); continue; } r -= I_GU;
        if (r < I_IN_A) { const int nb = r >> 4, kb = r & 15; p0_transpose_item(F.w_in, DM, DIN_SRC, 32 * nb, WinT, 32 * nb, 64 * kb, scr, F.lane); continue; } r -= I_IN_A;
        if (r < I_IN_B) { const int nb = r >> 4, kb = r & 15; p0_transpose_item(F.w_in, DM, DIN_SRC, 1092 + 32 * nb, WinT, 1280 + 32 * nb, 64 * kb, scr, F.lane); continue; } r -= I_IN_B;
        if (r < I_OUT) { const int nb = r >> 4, kb = r & 15; p0_transpose_item(F.w_out, DM, DM, 32 * nb, WoutT, 32 * nb, 64 * kb, scr, F.lane); continue; } r -= I_OUT;
        if (r < I_D) { const int e = r >> 7, q = r & 127, nb = q >> 2, kb = (q & 3) * 4;
            p0_absmax_item(F.w_d + (size_t)e * DFF * DM, DM, 32 * nb, 64 * kb, amaxd + e * 1024 + 32 * nb, F.lane); continue; } r -= I_D;
        if (r >= I_PAD) { r -= I_PAD; const int nb = r >> 4, kb = r & 15; const int src = nb < 24 ? 32 * nb : 1092 + 32 * (nb - 24), dst = nb < 24 ? 32 * nb : 1280 + 32 * (nb - 24);
            p0_absmax_item(F.w_in, DIN_SRC, src, 64 * kb, amaxin + dst, F.lane); continue; }
        { const int row = 1088 + r;
          for (int k = F.lane; k < DM; k += 64) WinT[(size_t)row * DM + k] = (row < 1092) ? (bf16_t)f2bf(F.w_in[(size_t)k * DIN_SRC + row]) : (bf16_t)0; }
    }
}
__device__ __forceinline__ void p1_modulate(Frame& F, LAS unsigned char* lds) {
    const int gw = F.vcu * NWAVES + F.wave, NGW = F.G * NWAVES;
    { LAS float* scr = (LAS float*)(lds + F.wave * 16384); signed char* WguQ = (signed char*)(F.ws + WS_WGU); float* SWgu = (float*)(F.ws + WS_SWGU); const unsigned* amaxgu = (const unsigned*)(F.ws + WS_CTL) + CW_AMAX;
      for (int r = gw; r < 32 * 64 * 16; r += NGW) { const int e = r >> 10, q = r & 1023, nb = q >> 4, kb = q & 15; const int n0 = 32 * nb;
          const int half = n0 >> 10, nn = n0 & 1023; const int drow = (nn >> 7) * 256 + half * 128 + (nn & 127);
          p1_quant_item(F.w_gu + (size_t)e * DM * 2048, 2048, 1.25f, n0, 64 * kb, WguQ + ((size_t)e * 2048 + drow) * 1024, amaxgu + e * 2048 + drow, SWgu + e * 2048 + drow, scr, F.lane); }
      { signed char* WinQ = (signed char*)(F.ws + WS_WINQ); float* SWin = (float*)(F.ws + WS_SWIN); const unsigned* amaxin = (const unsigned*)(F.ws + WS_CTL) + CW_AMAXIN;
        for (int r = gw; r < (24 + 64) * 16; r += NGW) { const int nb = r >> 4, kb = r & 15; const int src = nb < 24 ? 32 * nb : 1092 + 32 * (nb - 24), dst = nb < 24 ? 32 * nb : 1280 + 32 * (nb - 24);
            p1_quant_item(F.w_in, DIN_SRC, 1.0f, src, 64 * kb, WinQ + (size_t)dst * 1024, amaxin + dst, SWin + dst, scr, F.lane); } }
      unsigned char* WdQ = (unsigned char*)(F.ws + WS_WD); float* SWd = (float*)(F.ws + WS_SWD); const unsigned* amaxd = (const unsigned*)(F.ws + WS_CTL) + CW_AMAXD;
      for (int r = gw; r < 32 * 32 * 16; r += NGW) { const int e = r >> 9, q = r & 511, nb = q >> 4, kb = q & 15;
          p1_fp8_item(F.w_d + (size_t)e * DFF * DM, 32 * nb, 64 * kb, WdQ + ((size_t)e * 1024 + 32 * nb) * 1024, amaxd + e * 1024 + 32 * nb, SWd + e * 1024 + 32 * nb, scr, F.lane); } }
    const float* mod = (const float*)(F.ws + WS_MOD); bf16_t* H = (bf16_t*)(F.ws + WS_H);
    unsigned* HQ = (unsigned*)(F.ws + WS_HQ); float* SH = (float*)(F.ws + WS_SH);
    for (int m = gw; m < NTOK; m += NGW) {
        const int b = m / SEQ; const f32x4* xr = (const f32x4*)(F.x + (size_t)m * DM) + F.lane;
        const f32x4* sh = (const f32x4*)(mod + (size_t)b * 6144) + F.lane; const f32x4* sc = (const f32x4*)(mod + (size_t)b * 6144 + DM) + F.lane;
        unsigned long long* o8 = (unsigned long long*)(H + (size_t)m * DM) + F.lane;
        f32x4 v[4]; float amx = 0.f;
#pragma unroll
        for (int j = 0; j < 4; ++j) { v[j] = xr[64 * j] * (sc[64 * j] + 1.0f) + sh[64 * j];
            o8[64 * j] = (unsigned long long)pk2(v[j].x, v[j].y) | ((unsigned long long)pk2(v[j].z, v[j].w) << 32);
            amx = fmaxf(fmaxf(amx, fmaxf(fabsf(v[j].x), fabsf(v[j].y))), fmaxf(fabsf(v[j].z), fabsf(v[j].w))); }
        amx = wave_max(amx);
        const float inv = amx > 0.f ? 127.0f / amx : 0.f; unsigned* q8 = HQ + (size_t)m * (DM / 4) + F.lane;
#pragma unroll
        for (int j = 0; j < 4; ++j) q8[64 * j] = (unsigned)(((int)rintf(v[j].x * inv) & 0xff) | (((int)rintf(v[j].y * inv) & 0xff) << 8) | (((int)rintf(v[j].z * inv) & 0xff) << 16) | (((int)rintf(v[j].w * inv) & 0xff) << 24));
        if (F.lane == 0) SH[m] = amx > 0.f ? amx * (1.0f / 127.0f) : 1.0f;
    }
}
__device__ __forceinline__ unsigned sortable(float s) { s = s + 0.0f; const unsigned u = __float_as_uint(s); return (u & 0x80000000u) ? ~u : (u | 0x80000000u); }

__device__ __forceinline__ unsigned wave_max_u32(unsigned v, int lane) {
    v = max(v, (unsigned)__builtin_amdgcn_update_dpp(0, (int)v, 0xB1, 0xF, 0xF, false)); v = max(v, (unsigned)__builtin_amdgcn_update_dpp(0, (int)v, 0x4E, 0xF, 0xF, false));
    v = max(v, (unsigned)__builtin_amdgcn_update_dpp(0, (int)v, 0x141, 0xF, 0xF, false)); v = max(v, (unsigned)__builtin_amdgcn_update_dpp(0, (int)v, 0x140, 0xF, 0xF, false));
    { auto r = __builtin_amdgcn_permlane16_swap(v, v, false, false); v = max(r[0], r[1]); } { auto r = __builtin_amdgcn_permlane32_swap(v, v, false, false); v = max(r[0], r[1]); }
    return v; }
__device__ __forceinline__ unsigned wave_sum_u32(unsigned v, int lane) {
    v += (unsigned)__builtin_amdgcn_update_dpp(0, (int)v, 0xB1, 0xF, 0xF, false); v += (unsigned)__builtin_amdgcn_update_dpp(0, (int)v, 0x4E, 0xF, 0xF, false);
    v += (unsigned)__builtin_amdgcn_update_dpp(0, (int)v, 0x141, 0xF, 0xF, false); v += (unsigned)__builtin_amdgcn_update_dpp(0, (int)v, 0x140, 0xF, 0xF, false);
    { auto r = __builtin_amdgcn_permlane16_swap(v, v, false, false); v = r[0] + r[1]; } { auto r = __builtin_amdgcn_permlane32_swap(v, v, false, false); v = r[0] + r[1]; }
    return v; }
#define CNT_OP(OP, c, a, b) asm volatile("v_cmp_" OP "_u32 vcc, %1, %2\n\tv_addc_co_u32 %0, vcc, 0, %0, vcc" : "+v"(c) : "v"(a), "v"(b) : "vcc")
__device__ __forceinline__ void sel_search(const unsigned (&kk)[64], const int tqw, const int qw, const int nblk, const int lane, LAS unsigned* lmask, const int flags) {
        unsigned lo = 1u, hi = 0xfffffff0u; int clo = tqw + 1, chi = 0;
        if (!(flags & 64))
        { unsigned m = 0;
#pragma unroll
          for (int j = 0; j < 64; ++j) m = max(m, kk[j]);
          m = wave_max_u32(m, lane);
          hi = __builtin_amdgcn_readfirstlane(m) + 1u; }
        int diag_it = 0;
        bool done = (clo <= 256);
        float wlo = 1.0f, whi = 1.0f; int side = 0;
        for (int it = 0; it < ((flags & 8) ? 0 : (flags & 128) ? 4 : (flags & 256) ? 12 : (flags & 512) ? 24 : 128) && (!done || (flags & 128)); ++it) {
            if (it >= 2 && lo == 1u) { unsigned mn = 0xffffffffu;
#pragma unroll
                for (int j = 0; j < 64; ++j) mn = min(mn, kk[j] - 1u);
                mn = ~wave_max_u32(~mn, lane); lo = __builtin_amdgcn_readfirstlane(mn) + 1u; }
            const unsigned width = hi - lo;
            unsigned cand;
            if (it == 0) cand = 0x80001000u;
            else if (it == 1 && hi <= 0x80001000u && lo < 0x80000000u) cand = 0x80000000u;
            else { const float flo = (__logf((float)clo + 0.5f) - 5.545177444f) * wlo, fhi = (__logf((float)chi + 0.5f) - 5.545177444f) * whi; const float fr = flo * __builtin_amdgcn_rcpf(flo - fhi);
                if (width <= 8192u) cand = lo + (unsigned)(fr * (float)width);
                else { const unsigned ul = (lo & 0x80000000u) ? (lo ^ 0x80000000u) : ~lo, uh = (hi & 0x80000000u) ? (hi ^ 0x80000000u) : ~hi;
                    const float fl = __uint_as_float(ul), fh = __uint_as_float(uh); const float fc = fl + fr * (fh - fl);
                    cand = sortable(fc); } }
            cand = max(lo + 1u, min(cand, hi - 1u));
            const unsigned cs = __builtin_amdgcn_readfirstlane(cand);
            unsigned c0_ = 0, c1_ = 0, c2_ = 0, c3_ = 0; int scnt = 0;
#pragma unroll
            for (int j = 0; j < 64; j += 8) { if (j < nblk) {
                unsigned long long m0, m1, m2, m3, m4, m5, m6, m7;
                if ((j & 8) == 0) {
                asm volatile("v_cmp_le_u32_e64 %[m0], %[cs], %[k0]\n\tv_cmp_le_u32_e64 %[m1], %[cs], %[k1]\n\tv_cmp_le_u32_e64 %[m2], %[cs], %[k2]\n\tv_cmp_le_u32_e64 %[m3], %[cs], %[k3]\n\t"
                             "v_cmp_le_u32_e64 %[m4], %[cs], %[k4]\n\tv_cmp_le_u32_e64 %[m5], %[cs], %[k5]\n\tv_cmp_le_u32_e64 %[m6], %[cs], %[k6]\n\tv_cmp_le_u32_e64 %[m7], %[cs], %[k7]\n\t"
                             "v_addc_co_u32_e64 %[c0], %[m0], 0, %[c0], %[m0]\n\tv_addc_co_u32_e64 %[c1], %[m1], 0, %[c1], %[m1]\n\tv_addc_co_u32_e64 %[c2], %[m2], 0, %[c2], %[m2]\n\tv_addc_co_u32_e64 %[c3], %[m3], 0, %[c3], %[m3]\n\t"
                             "v_addc_co_u32_e64 %[c0], %[m4], 0, %[c0], %[m4]\n\tv_addc_co_u32_e64 %[c1], %[m5], 0, %[c1], %[m5]\n\tv_addc_co_u32_e64 %[c2], %[m6], 0, %[c2], %[m6]\n\tv_addc_co_u32_e64 %[c3], %[m7], 0, %[c3], %[m7]"
                             : [c0] "+v"(c0_), [c1] "+v"(c1_), [c2] "+v"(c2_), [c3] "+v"(c3_), [m0] "=&s"(m0), [m1] "=&s"(m1), [m2] "=&s"(m2), [m3] "=&s"(m3), [m4] "=&s"(m4), [m5] "=&s"(m5), [m6] "=&s"(m6), [m7] "=&s"(m7)
                             : [cs] "s"(cs), [k0] "v"(kk[j]), [k1] "v"(kk[j + 1]), [k2] "v"(kk[j + 2]), [k3] "v"(kk[j + 3]), [k4] "v"(kk[j + 4]), [k5] "v"(kk[j + 5]), [k6] "v"(kk[j + 6]), [k7] "v"(kk[j + 7]));
                } else {
                int t0_, t1_, t2_, t3_, t4_, t5_, t6_, t7_;
                asm volatile("v_cmp_le_u32_e64 %[m0], %[cs], %[k0]\n\tv_cmp_le_u32_e64 %[m1], %[cs], %[k1]\n\tv_cmp_le_u32_e64 %[m2], %[cs], %[k2]\n\tv_cmp_le_u32_e64 %[m3], %[cs], %[k3]\n\t"
                             "v_cmp_le_u32_e64 %[m4], %[cs], %[k4]\n\tv_cmp_le_u32_e64 %[m5], %[cs], %[k5]\n\tv_cmp_le_u32_e64 %[m6], %[cs], %[k6]\n\tv_cmp_le_u32_e64 %[m7], %[cs], %[k7]\n\t"
                             "s_bcnt1_i32_b64 %[t0], %[m0]\n\ts_bcnt1_i32_b64 %[t1], %[m1]\n\ts_bcnt1_i32_b64 %[t2], %[m2]\n\ts_bcnt1_i32_b64 %[t3], %[m3]\n\t"
                             "s_bcnt1_i32_b64 %[t4], %[m4]\n\ts_bcnt1_i32_b64 %[t5], %[m5]\n\ts_bcnt1_i32_b64 %[t6], %[m6]\n\ts_bcnt1_i32_b64 %[t7], %[m7]\n\t"
                             "s_add_u32 %[t0], %[t0], %[t1]\n\ts_add_u32 %[t2], %[t2], %[t3]\n\ts_add_u32 %[t4], %[t4], %[t5]\n\ts_add_u32 %[t6], %[t6], %[t7]\n\t"
                             "s_add_u32 %[t0], %[t0], %[t2]\n\ts_add_u32 %[t4], %[t4], %[t6]\n\ts_add_u32 %[t0], %[t0], %[t4]\n\ts_add_u32 %[cnt], %[cnt], %[t0]"
                             : [cnt] "+s"(scnt), [m0] "=&s"(m0), [m1] "=&s"(m1), [m2] "=&s"(m2), [m3] "=&s"(m3), [m4] "=&s"(m4), [m5] "=&s"(m5), [m6] "=&s"(m6), [m7] "=&s"(m7),
                               [t0] "=&s"(t0_), [t1] "=&s"(t1_), [t2] "=&s"(t2_), [t3] "=&s"(t3_), [t4] "=&s"(t4_), [t5] "=&s"(t5_), [t6] "=&s"(t6_), [t7] "=&s"(t7_)
                             : [cs] "s"(cs), [k0] "v"(kk[j]), [k1] "v"(kk[j + 1]), [k2] "v"(kk[j + 2]), [k3] "v"(kk[j + 3]), [k4] "v"(kk[j + 4]), [k5] "v"(kk[j + 5]), [k6] "v"(kk[j + 6]), [k7] "v"(kk[j + 7])
                             : "scc"); } } }
            const int cnt = scnt + (int)__builtin_amdgcn_readfirstlane(wave_sum_u32((c0_ + c1_) + (c2_ + c3_), lane));
            if (cnt >= 256) { lo = cs; clo = cnt; wlo = 1.0f; if (side == 1) whi *= 0.5f; side = 1; }
            else { hi = cs; chi = cnt; whi = 1.0f; if (side == 2) wlo *= 0.5f; side = 2; }
            done = (clo == 256) || (hi - lo <= 1u); ++diag_it;
        }
        if (!(flags & 32)) {
#ifdef ABL_SELALL
          const unsigned thr = 1u;
#else
          const unsigned thr = __builtin_amdgcn_readfirstlane(lo);
#endif
          unsigned mlo = 0u, mhi = 0u;
#pragma unroll
          for (int j = 0; j < 64; ++j) { if (j < nblk) asm volatile("v_cmp_le_u32 vcc, %2, %3\n\ts_nop 1\n\tv_writelane_b32 %0, vcc_lo, %4\n\tv_writelane_b32 %1, vcc_hi, %4" : "+v"(mlo), "+v"(mhi) : "s"(thr), "v"(kk[j]), "i"(j) : "vcc"); }
          int ln = lane; asm volatile("" : "+v"(ln));
          u32x2 w; w.x = mlo; w.y = mhi; *(LAS u32x2*)((LAS unsigned char*)lmask + qw * 512 + ln * 8) = w; }
}
__device__ __forceinline__ int select_item(Frame& F, LAS unsigned char* lds, const int k, bool& staged, unsigned* qctr, volatile LAS unsigned* qslot, int flags) {
    const int b = k >> 8, qblk = 255 - (k & 255);
    unsigned kn_v = 0u; if (F.tid == 0) kn_v = __hip_atomic_fetch_add(qctr, 1u, __ATOMIC_RELAXED, __HIP_MEMORY_SCOPE_AGENT);
    const int lane = F.lane, wid = F.wave, qn = lane & 15, kq = lane >> 4;
    const int t0 = qblk * 16, ntile = qblk + 1;
    const bf16_t* QI = (const bf16_t*)(F.ws + WS_QI); const bf16_t* KIW = (const bf16_t*)(F.ws + WS_KIW);
    LAS unsigned char* kst = lds;
    LAS unsigned* lmask = (LAS unsigned*)(lds + 8 * 16400);
    const size_t rowq = (size_t)b * SEQ + t0 + qn;
    bf16x8 bq[4][2]; float wv[4];
#pragma unroll
    for (int h = 0; h < 4; ++h) {
#pragma unroll
        for (int s = 0; s < 2; ++s) bq[h][s] = *(const bf16x8*)(QI + rowq * 256 + h * 64 + s * 32 + kq * 8);
        wv[h] = 0.5f * bf2f(KIW[rowq * 128 + 64 + h]); }
    unsigned key[32][4];
    int ibase_i = 16 * wid + 4 * kq; asm volatile("" : "+v"(ibase_i));
    const unsigned ibase = (unsigned)ibase_i;
    const int dq = t0 + qn - ibase_i;
    const int dqmin = __builtin_amdgcn_readfirstlane(t0 - (16 * wid + 12));
    const unsigned nidx = 4095u - ibase;
    int fragoff0 = (16 * wid + qn) * 128 + ((kq ^ (qn & 7)) << 4), fragoff1 = (16 * wid + qn) * 128 + (((4 + kq) ^ (qn & 7)) << 4); asm volatile("" : "+v"(fragoff0), "+v"(fragoff1));
    { u32x4 tmp[8];
      int srow = F.tid >> 3; asm volatile("" : "+v"(srow));
      const int spc = F.tid & 7;
      const bf16_t* gsrc0 = KIW + ((size_t)b * SEQ + srow) * 128 + spc * 8;
      LAS unsigned char* ldst0 = kst + srow * 128 + ((spc ^ (srow & 7)) << 4);
      const int nsub = (t0 + 16 + 511) >> 9;
      if (!staged) {
          if (!(flags & 1024))
#pragma unroll
          for (int j = 0; j < 8; ++j) tmp[j] = *(const u32x4*)(gsrc0 + (size_t)j * 64 * 128);
          __syncthreads();
#pragma unroll
          for (int j = 0; j < 8; ++j) *(LAS u32x4*)(ldst0 + j * 8192) = tmp[j];
          __syncthreads();
      }
#pragma unroll
      for (int sb = 0; sb < 8; ++sb) {
          if (sb < nsub) {
              const bool more = (sb + 1 < nsub) && !(flags & 1024);
              if (more) {
#pragma unroll
                  for (int j = 0; j < 8; ++j) tmp[j] = *(const u32x4*)(gsrc0 + (size_t)((sb + 1) * 512 + j * 64) * 128); }
              const LAS unsigned char* kb = kst + (sb & 1) * 65536;
              if (flags & 2048) {
#pragma unroll
                  for (int ii = 0; ii < 4; ++ii)
#pragma unroll
                      for (int r = 0; r < 4; ++r) key[sb * 4 + ii][r] = 0u;
              } else
#pragma unroll
              for (int ii = 0; ii < 4; ++ii) {
                  const int i = sb * 4 + ii;
                  const bf16x8 a0 = *(const LAS bf16x8*)(kb + fragoff0 + 16384 * ii), a1 = *(const LAS bf16x8*)(kb + fragoff1 + 16384 * ii);
                  f32x4 sc = {0.f, 0.f, 0.f, 0.f};
#pragma unroll
                  for (int h = 0; h < 4; ++h) { f32x4 c = {0.f, 0.f, 0.f, 0.f};
                      c = __builtin_amdgcn_mfma_f32_16x16x32_bf16(a0, bq[h][0], c, 0, 0, 0); c = __builtin_amdgcn_mfma_f32_16x16x32_bf16(a1, bq[h][1], c, 0, 0, 0);
#pragma unroll
                      for (int r = 0; r < 4; ++r) sc[r] = fmaf(wv[h], fmaxf(c[r], 0.f), sc[r]); }
#pragma unroll
                  for (int r = 0; r < 4; ++r) { const unsigned u = __float_as_uint(sc[r]);
                      const unsigned sk = u ^ ((unsigned)((int)u >> 31) | 0x80000000u);
                      key[i][r] = (sk & 0xfffff000u) | (nidx - (128u * i + r)); }
                  if (128 * i + 3 > dqmin) {
#pragma unroll
                      for (int r = 0; r < 4; ++r) key[i][r] = (128 * i + r <= dq) ? key[i][r] : 0u; }
              }
              if (more) {
#pragma unroll
                  for (int j = 0; j < 8; ++j) *(LAS u32x4*)(ldst0 + ((sb + 1) & 1) * 65536 + j * 8192) = tmp[j]; }
              __syncthreads();
          } else {
#pragma unroll
              for (int ii = 0; ii < 4; ++ii)
#pragma unroll
                  for (int r = 0; r < 4; ++r) key[sb * 4 + ii][r] = 0u;
          }
      } }
    int knext = 0; u32x4 tmp2[8];
    constexpr int QPITCH = 16384 + 16;
    if (!(flags & 4096)) {
        unsigned kkA[64], kkB[64];
        int lo_ = lane; asm volatile("" : "+v"(lo_)); const LAS unsigned char* src = lds + wid * QPITCH + lo_ * 4;
        int qo = qn; asm volatile("" : "+v"(qo)); const int dsto = (qo & 7) * QPITCH + ibase_i * 4;
        if (F.tid == 0) qslot[0] = kn_v;
        __syncthreads();
        if ((qo >> 3) == 0) { LAS unsigned char* dst = lds + dsto;
#pragma unroll
            for (int i = 0; i < 32; ++i) { u32x4 v; v.x = key[i][0]; v.y = key[i][1]; v.z = key[i][2]; v.w = key[i][3]; *(LAS u32x4*)(dst + 512 * i) = v; } }
        __syncthreads();
#pragma unroll
        for (int j = 0; j < 64; ++j) kkA[j] = *(const LAS unsigned*)(src + 256 * j);
        __syncthreads();
        if ((qo >> 3) == 1) { LAS unsigned char* dst = lds + dsto;
#pragma unroll
            for (int i = 0; i < 32; ++i) { u32x4 v; v.x = key[i][0]; v.y = key[i][1]; v.z = key[i][2]; v.w = key[i][3]; *(LAS u32x4*)(dst + 512 * i) = v; } }
        __syncthreads();
#pragma unroll
        for (int j = 0; j < 64; ++j) kkB[j] = *(const LAS unsigned*)(src + 256 * j);
        knext = (int)qslot[0];
        sel_search(kkA, t0 + wid, wid, ((t0 + wid) >> 6) + 1, lane, lmask, flags);
        if (knext < BATCH * 256) { int srow = F.tid; asm volatile("" : "+v"(srow)); const int spc = srow & 7; srow >>= 3;
            const bf16_t* gn = KIW + ((size_t)(knext >> 8) * SEQ + srow) * 128 + spc * 8;
#pragma unroll
            for (int j = 0; j < 8; ++j) tmp2[j] = *(const u32x4*)(gn + (size_t)j * 64 * 128); }
        sel_search(kkB, t0 + 8 + wid, 8 + wid, ((t0 + 8 + wid) >> 6) + 1, lane, lmask, flags);
    }
    __syncthreads();
    staged = false;
    if (!(flags & 4096) && knext < BATCH * 256) { staged = true;
        int srow = F.tid; asm volatile("" : "+v"(srow)); const int spc = srow & 7; srow >>= 3;
        LAS unsigned char* ld0 = kst + srow * 128 + ((spc ^ (srow & 7)) << 4);
#pragma unroll
        for (int j = 0; j < 8; ++j) *(LAS u32x4*)(ld0 + j * 8192) = tmp2[j]; }
    { unsigned* mask = (unsigned*)(F.ws + ((flags & 4) ? WS_END : WS_MASK)); const int ntile64 = 4 * (t0 / 256 + 1);
      int tw = F.tid; asm volatile("" : "+v"(tw)); const int tl0 = tw >> 5, q = (tw >> 1) & 15, w = tw & 1;
      unsigned* mp = mask + (((size_t)b * 64 + tl0) * SEQ + t0 + q) * 2 + w; const LAS unsigned* lp = lmask + q * 128 + tl0 * 2 + w;
#pragma unroll 1
      for (int tl = tl0; tl < ntile64; tl += 16) { *mp = *lp; mp += (size_t)16 * SEQ * 2; lp += 32; } }
    if ((flags & 4096) && F.tid == 0) qslot[0] = kn_v;
    __syncthreads();
    if (flags & 4096) { knext = (int)qslot[0]; __syncthreads(); }
    return knext;
#undef CNT_OP
}
constexpr int RP = 272;
constexpr int RT = 128 * RP;
__device__ __forceinline__ void block_gemm128(f32x16 (&acc)[2], const LAS unsigned char* A, const LAS unsigned char* Bt, int wr, int wc, int r32, int hi) {
#pragma unroll
    for (int ks = 0; ks < 8; ++ks) {
        const bf16x8 a = *(const LAS bf16x8*)(A + (32 * wr + r32) * RP + ks * 32 + hi * 16);
#pragma unroll
        for (int n = 0; n < 2; ++n) { const bf16x8 bf = *(const LAS bf16x8*)(Bt + (64 * wc + 32 * n + r32) * RP + ks * 32 + hi * 16);
            acc[n] = __builtin_amdgcn_mfma_f32_32x32x16_bf16(bf, a, acc[n], 0, 0, 0); }
    }
}
__device__ __forceinline__ float ret_gamma_log2(int h) { return log2f(1.0f - exp2f(-5.0f - (float)h)); }

struct RetRaw { bf16x8 x1[2], x2[2]; };
struct RetRot { f32x4 c0[2], c1[2], s0[2], s1[2]; };
__device__ __forceinline__ void ret_ld(Frame& F, RetRaw& r, const bf16_t* src, int b, int h, int c) {
    const int i = F.tid >> 2, q = F.tid & 3; const bf16_t* row = src + ((size_t)b * SEQ + c * 128 + i) * 512 + h * 128;
#pragma unroll
    for (int m = 0; m < 2; ++m) { const int d0 = 8 * q + 32 * m; r.x1[m] = *(const bf16x8*)(row + d0); r.x2[m] = *(const bf16x8*)(row + d0 + 64); }
}
__device__ __forceinline__ void ret_ld_rot(Frame& F, RetRot& r, int c) {
    const float* rc = (const float*)(F.ws + WS_ROT); const float* rs = rc + SEQ * 64;
    const int i = F.tid >> 2, q = F.tid & 3; const size_t t = (size_t)(c * 128 + i);
#pragma unroll
    for (int m = 0; m < 2; ++m) { const int d0 = 8 * q + 32 * m;
        r.c0[m] = *(const f32x4*)(rc + t * 64 + d0); r.c1[m] = *(const f32x4*)(rc + t * 64 + d0 + 4); r.s0[m] = *(const f32x4*)(rs + t * 64 + d0); r.s1[m] = *(const f32x4*)(rs + t * 64 + d0 + 4); }
}
template <bool ROT, bool TR>
__device__ __forceinline__ void ret_st(Frame& F, LAS unsigned char* dst, const RetRaw& r, const RetRot& rr, float sc, float rowdecay_l2  ) {
    const int i = F.tid >> 2, q = F.tid & 3;
    const float rsc = sc * ((rowdecay_l2 != 0.f) ? exp2f(rowdecay_l2 * (float)(127 - i)) : 1.0f);
#pragma unroll
    for (int m = 0; m < 2; ++m) {
        const int d0 = 8 * q + 32 * m;
        float o1[8], o2[8];
        if (ROT) {
#pragma unroll
            for (int j = 0; j < 8; ++j) { const float a = bf2f((unsigned short)r.x1[m][j]), bb = bf2f((unsigned short)r.x2[m][j]); const float cs = j < 4 ? rr.c0[m][j] : rr.c1[m][j - 4], sn = j < 4 ? rr.s0[m][j] : rr.s1[m][j - 4];
                o1[j] = (a * cs - bb * sn) * rsc; o2[j] = (a * sn + bb * cs) * rsc; }
        } else {
#pragma unroll
            for (int j = 0; j < 8; ++j) { o1[j] = bf2f((unsigned short)r.x1[m][j]) * rsc; o2[j] = bf2f((unsigned short)r.x2[m][j]) * rsc; }
        }
        if (!TR) {
            u32x4 w1, w2; w1.x = pk2(o1[0], o1[1]); w1.y = pk2(o1[2], o1[3]); w1.z = pk2(o1[4], o1[5]); w1.w = pk2(o1[6], o1[7]);
            w2.x = pk2(o2[0], o2[1]); w2.y = pk2(o2[2], o2[3]); w2.z = pk2(o2[4], o2[5]); w2.w = pk2(o2[6], o2[7]);
            *(LAS u32x4*)(dst + i * RP + d0 * 2) = w1; *(LAS u32x4*)(dst + i * RP + (d0 + 64) * 2) = w2;
        } else {
#pragma unroll
            for (int j = 0; j < 8; ++j) { *(LAS bf16_t*)(dst + (d0 + j) * RP + i * 2) = (bf16_t)f2bf(o1[j]); *(LAS bf16_t*)(dst + (d0 + 64 + j) * RP + i * 2) = (bf16_t)f2bf(o2[j]); }
        }
    }
}
__device__ __forceinline__ void ret_state_item(Frame& F, LAS unsigned char* lds, int unit) {
    const int b = unit >> 7, h = (unit >> 5) & 3, c = unit & 31;
    const int lane = F.lane, wid = F.wave, wr = wid >> 1, wc = wid & 1, r32 = lane & 31, hi = lane >> 5;
    LAS unsigned char* Vt = lds; LAS unsigned char* Kt = lds + RT;
    const float lg = ret_gamma_log2(h);
    { RetRaw rv, rk; RetRot rr; ret_ld(F, rv, (const bf16_t*)(F.ws + WS_VR), b, h, c); ret_ld(F, rk, (const bf16_t*)(F.ws + WS_KR), b, h, c); ret_ld_rot(F, rr, c);
      ret_st<false, true>(F, Vt, rv, rr, 1.0f, 0.f); ret_st<true, true>(F, Kt, rk, rr, 0.08838834764831845f, lg); }
    __syncthreads();
    f32x16 acc[2]; acc[0] = f32x16{}; acc[1] = f32x16{};
    block_gemm128(acc, Vt, Kt, wr, wc, r32, hi);
    bf16_t* U = (bf16_t*)(F.ws + WS_U) + (size_t)unit * 16384;
#pragma unroll
    for (int n = 0; n < 2; ++n)
#pragma unroll
        for (int gq = 0; gq < 4; ++gq) { u32x2 w; w.x = pk2(acc[n][4 * gq], acc[n][4 * gq + 1]); w.y = pk2(acc[n][4 * gq + 2], acc[n][4 * gq + 3]);
            *(u32x2*)(U + (size_t)(32 * wr + r32) * 128 + 64 * wc + 32 * n + 8 * gq + 4 * hi) = w; }
    __syncthreads();
}
__device__ __forceinline__ void ret_scan(Frame& F) {
    const bf16_t* U = (const bf16_t*)(F.ws + WS_U); bf16_t* S = (bf16_t*)(F.ws + WS_S);
    const int nthr = F.G * 512;
    for (int idx = F.vcu * 512 + F.tid; idx < 32 * 4096; idx += nthr) {
        const int bh = idx >> 12, e4 = (idx & 4095) * 4, h = bh & 3;
        const float cd = exp2f(128.0f * ret_gamma_log2(h));
        f32x4 s = {0.f, 0.f, 0.f, 0.f};
        for (int c = 0; c < 31; ++c) {
            const u32x2 uw = *(const u32x2*)(U + ((size_t)(bh * 32 + c)) * 16384 + e4);
            f32x4 u; u.x = __uint_as_float(uw.x << 16); u.y = __uint_as_float(uw.x & 0xffff0000u); u.z = __uint_as_float(uw.y << 16); u.w = __uint_as_float(uw.y & 0xffff0000u);
            s = s * cd + u;
            u32x2 w; w.x = pk2(s.x, s.y); w.y = pk2(s.z, s.w);
            *(u32x2*)(S + ((size_t)(bh * 32 + c + 1)) * 16384 + e4) = w;
        }
    }
}
__device__ __forceinline__ void ret_out_item(Frame& F, LAS unsigned char* lds, int unit) {
    const int b = unit >> 7, h = (unit >> 5) & 3, c = unit & 31;
    const int lane = F.lane, wid = F.wave, wr = wid >> 1, wc = wid & 1, r32 = lane & 31, hi = lane >> 5;
    LAS unsigned char* Qs = lds; LAS unsigned char* Ks = lds + RT; LAS unsigned char* Vt = lds + 2 * RT; LAS unsigned char* St = lds + 3 * RT;
    LAS float* red = (LAS float*)(lds + 4 * RT);
    const float lg = ret_gamma_log2(h);
    { RetRaw rq, rk, rv; RetRot rr; u32x4 sv[4];
      ret_ld(F, rq, (const bf16_t*)(F.ws + WS_QR), b, h, c); ret_ld(F, rk, (const bf16_t*)(F.ws + WS_KR), b, h, c); ret_ld_rot(F, rr, c); ret_ld(F, rv, (const bf16_t*)(F.ws + WS_VR), b, h, c);
      const bf16_t* S = (const bf16_t*)(F.ws + WS_S) + (size_t)unit * 16384;
      if (c > 0) {
#pragma unroll
          for (int k = 0; k < 4; ++k) { const int i = F.tid + 512 * k; sv[k] = *(const u32x4*)(S + (i >> 4) * 128 + (i & 15) * 8); } }
      ret_st<true, false>(F, Qs, rq, rr, 1.0f, 0.f); ret_st<true, false>(F, Ks, rk, rr, 0.08838834764831845f, 0.f); ret_st<false, true>(F, Vt, rv, rr, 1.0f, 0.f);
      if (c > 0) {
#pragma unroll
          for (int k = 0; k < 4; ++k) { const int i = F.tid + 512 * k; *(LAS u32x4*)(St + (i >> 4) * RP + (i & 15) * 16) = sv[k]; } } }
    __syncthreads();
    f32x16 p[2]; p[0] = f32x16{}; p[1] = f32x16{};
    block_gemm128(p, Ks, Qs, wr, wc, r32, hi);
    __syncthreads();
    LAS unsigned char* Ps = Ks;
    { const int j = 32 * wr + r32;
#pragma unroll
      for (int n = 0; n < 2; ++n)
#pragma unroll
          for (int rg = 0; rg < 16; ++rg) { const int i = 64 * wc + 32 * n + (rg & 3) + 8 * (rg >> 2) + 4 * hi;
              const float v = (i >= j) ? p[n][rg] * exp2f(lg * (float)(i - j)) : 0.f;
              *(LAS bf16_t*)(Ps + i * RP + j * 2) = (bf16_t)f2bf(v); } }
    __syncthreads();
    f32x16 acc[2], cr[2]; acc[0] = f32x16{}; acc[1] = f32x16{}; cr[0] = f32x16{}; cr[1] = f32x16{};
    block_gemm128(acc, Ps, Vt, wr, wc, r32, hi);
    if (c > 0) block_gemm128(cr, Qs, St, wr, wc, r32, hi);
    const int i = 32 * wr + r32; const float qd = exp2f(lg * (float)(i + 1));
    float s1 = 0.f, s2 = 0.f;
#pragma unroll
    for (int n = 0; n < 2; ++n)
#pragma unroll
        for (int rg = 0; rg < 16; ++rg) { const float v = acc[n][rg] + qd * cr[n][rg]; acc[n][rg] = v; s1 += v; s2 += v * v; }
    s1 += __shfl_xor(s1, 32); s2 += __shfl_xor(s2, 32);
    if (hi == 0) { red[(wc * 128 + i) * 2] = s1; red[(wc * 128 + i) * 2 + 1] = s2; }
    __syncthreads();
    const float t1 = red[i * 2] + red[(128 + i) * 2], t2 = red[i * 2 + 1] + red[(128 + i) * 2 + 1];
    const float mean = t1 * (1.0f / 128.0f); const float var = fmaxf(t2 * (1.0f / 128.0f) - mean * mean, 0.f); const float rstd = 1.0f / sqrtf(var + LN_EPS);
    const size_t tok = (size_t)b * SEQ + c * 128 + i;
    const bf16_t* GR = (const bf16_t*)(F.ws + WS_GR) + tok * 512 + h * 128; bf16_t* CC = (bf16_t*)(F.ws + WS_H) + tok * 1024 + 512 + h * 128;
#pragma unroll
    for (int n = 0; n < 2; ++n)
#pragma unroll
        for (int gq = 0; gq < 4; ++gq) { const int col = 64 * wc + 32 * n + 8 * gq + 4 * hi;
            const u32x2 gw = *(const u32x2*)(GR + col); const f32x4 ng = *(const f32x4*)(F.ret_g + h * 128 + col);
            float o[4];
#pragma unroll
            for (int k = 0; k < 4; ++k) { const unsigned short gb = (unsigned short)((k < 2 ? gw.x : gw.y) >> (16 * (k & 1))); const float gg = bf2f(gb);
                const float sl = gg / (1.0f + __expf(-gg)); o[k] = (acc[n][4 * gq + k] - mean) * rstd * ng[k] * sl
#ifdef ABL_NORET
                    * 0.f
#endif
                    ; }
            u32x2 w; w.x = pk2(o[0], o[1]); w.y = pk2(o[2], o[3]);
            *(u32x2*)(CC + col) = w; }
    __syncthreads();
}
constexpr int WRP = 1028;
__device__ __forceinline__ float dpp_f(float v, int ctrl_sel) {
    const int u = __float_as_int(v);
    switch (ctrl_sel) {
        case 0: return __int_as_float(__builtin_amdgcn_update_dpp(0, u, 0xB1, 0xF, 0xF, false));
        case 1: return __int_as_float(__builtin_amdgcn_update_dpp(0, u, 0x4E, 0xF, 0xF, false));
        case 2: return __int_as_float(__builtin_amdgcn_update_dpp(0, u, 0x141, 0xF, 0xF, false));
        default: return __int_as_float(__builtin_amdgcn_update_dpp(0, u, 0x140, 0xF, 0xF, false));
    }
}
__device__ __forceinline__ float part16(float v, int lane) { const unsigned u = __float_as_uint(v); auto r = __builtin_amdgcn_permlane16_swap(u, u, false, false); return __uint_as_float((lane & 16) ? r[0] : r[1]); }
__device__ __forceinline__ float part32(float v, int lane) { const unsigned u = __float_as_uint(v); auto r = __builtin_amdgcn_permlane32_swap(u, u, false, false); return __uint_as_float((lane & 32) ? r[0] : r[1]); }
__device__ __forceinline__ float wsum(float v, int lane) { v += dpp_f(v, 0); v += dpp_f(v, 1); v += dpp_f(v, 2); v += dpp_f(v, 3); v += part16(v, lane); v += part32(v, lane); return v; }
__device__ __forceinline__ float wmax(float v, int lane) { v = fmaxf(v, dpp_f(v, 0)); v = fmaxf(v, dpp_f(v, 1)); v = fmaxf(v, dpp_f(v, 2)); v = fmaxf(v, dpp_f(v, 3)); v = fmaxf(v, part16(v, lane)); v = fmaxf(v, part32(v, lane)); return v; }
__device__ __forceinline__ float rs32(float (&a)[32], int lane) {
#pragma unroll
    for (int e = 0; e < 16; ++e) { const bool up = (lane & 32) != 0; const float send = up ? a[e] : a[e + 16], keep = up ? a[e + 16] : a[e]; a[e] = keep + part32(send, lane); }
#pragma unroll
    for (int e = 0; e < 8; ++e) { const bool up = (lane & 16) != 0; const float send = up ? a[e] : a[e + 8], keep = up ? a[e + 8] : a[e]; a[e] = keep + part16(send, lane); }
#pragma unroll
    for (int e = 0; e < 4; ++e) { const bool up = (lane & 8) != 0; const float send = up ? a[e] : a[e + 4], keep = up ? a[e + 4] : a[e]; a[e] = keep + dpp_f(send, 3); }
#pragma unroll
    for (int e = 0; e < 2; ++e) { const bool up = (lane & 4) != 0; const float send = up ? a[e] : a[e + 2], keep = up ? a[e + 2] : a[e]; a[e] = keep + dpp_f(send, 2); }
    { const bool up = (lane & 2) != 0; const float send = up ? a[0] : a[1], keep = up ? a[1] : a[0]; a[0] = keep + dpp_f(send, 1); }
    return a[0] + dpp_f(a[0], 0);
}
__device__ __forceinline__ f32x4 ld_v1(const float* x, const bf16_t* mix, int tok, int lane, int j) {
    const f32x4 xv = ((const f32x4*)(x + (size_t)tok * DM) + lane)[64 * j]; const u32x2 w = ((const u32x2*)(mix + (size_t)tok * DM) + lane)[64 * j];
    f32x4 m; m.x = __uint_as_float(w.x << 16); m.y = __uint_as_float(w.x & 0xffff0000u); m.z = __uint_as_float(w.y << 16); m.w = __uint_as_float(w.y & 0xffff0000u);
    return xv * DN_ALPHA + m; }
__device__ __forceinline__ void p6_rows(Frame& F, LAS unsigned char* lds) {
    LAS float* wrt = (LAS float*)lds;
    LAS unsigned* lcnt = (LAS unsigned*)(lds + 32 * WRP * 4);
    LAS unsigned* lbase = lcnt + 32;
    for (int i = F.tid; i < DM * NEXP; i += 512) { const int k = i >> 5, e = i & 31; wrt[e * WRP + k] = F.w_router[i]; }
    const float* mod = (const float*)(F.ws + WS_MOD);
    bf16_t* X1 = (bf16_t*)(F.ws + WS_X1); unsigned* H2Q = (unsigned*)(F.ws + WS_H2); float* STOK = (float*)(F.ws + WS_STOK); const bf16_t* MIXp = (const bf16_t*)(F.ws + WS_MIX);
    int* tope = (int*)(F.ws + WS_TOPE); float* gate = (float*)(F.ws + WS_GATE); int* rank = (int*)(F.ws + WS_RANK);
    unsigned* gcnt = (unsigned*)(F.ws + WS_CTL) + CW_CNT;
    const int lane = F.lane;
    const float br = F.b_router[(lane >> 1) & 31];
    for (int chunk = F.vcu; chunk < NTOK / 128; chunk += F.G) {
        if (F.tid < 32) lcnt[F.tid] = 0u;
        __syncthreads();
        const int b = (chunk * 128) / SEQ;
        const f32x4* shf = (const f32x4*)(mod + (size_t)b * 6144 + 3 * DM) + lane; const f32x4* scf = (const f32x4*)(mod + (size_t)b * 6144 + 4 * DM) + lane;
        const int tok0 = chunk * 128 + F.wave * 16;
        f32x4 na[4], nb[4];
#pragma unroll
        for (int j = 0; j < 4; ++j) { na[j] = ld_v1(F.x, MIXp, tok0, lane, j); nb[j] = ld_v1(F.x, MIXp, tok0 + 1, lane, j); }
        for (int pp = 0; pp < 8; ++pp) {
            const int tok = tok0 + 2 * pp;
            f32x4 va[4], vb[4];
#pragma unroll
            for (int j = 0; j < 4; ++j) { va[j] = na[j]; vb[j] = nb[j]; }
            if (pp < 7) {
#pragma unroll
                for (int j = 0; j < 4; ++j) { na[j] = ld_v1(F.x, MIXp, tok + 2, lane, j); nb[j] = ld_v1(F.x, MIXp, tok + 3, lane, j); } }
            float sa = 0.f, sb = 0.f;
#pragma unroll
            for (int j = 0; j < 4; ++j) { sa += (va[j].x + va[j].y) + (va[j].z + va[j].w); sb += (vb[j].x + vb[j].y) + (vb[j].z + vb[j].w); }
            const float ma = wsum(sa, lane) * (1.f / DM), mb = wsum(sb, lane) * (1.f / DM); float qa = 0.f, qb = 0.f;
#pragma unroll
            for (int j = 0; j < 4; ++j) { va[j] = va[j] - ma; vb[j] = vb[j] - mb; qa += (va[j].x * va[j].x + va[j].y * va[j].y) + (va[j].z * va[j].z + va[j].w * va[j].w); qb += (vb[j].x * vb[j].x + vb[j].y * vb[j].y) + (vb[j].z * vb[j].z + vb[j].w * vb[j].w); }
            const float ra = 1.f / sqrtf(wsum(qa, lane) * (1.f / DM) + LN_EPS), rb = 1.f / sqrtf(wsum(qb, lane) * (1.f / DM) + LN_EPS);
            unsigned long long* xa = (unsigned long long*)(X1 + (size_t)tok * DM) + lane; unsigned long long* xb = (unsigned long long*)(X1 + (size_t)(tok + 1) * DM) + lane;
            unsigned* oa = H2Q + (size_t)tok * (DM / 4) + lane; unsigned* ob = H2Q + (size_t)(tok + 1) * (DM / 4) + lane;
            float amxa = 0.f, amxb = 0.f;
#pragma unroll
            for (int j = 0; j < 4; ++j) { const f32x4 sc1 = scf[64 * j] + 1.0f, sh1 = shf[64 * j]; const f32x4 g1j = ((const f32x4*)F.ln1_g)[lane + 64 * j], b1j = ((const f32x4*)F.ln1_b)[lane + 64 * j];
                const f32x4 x1a = va[j] * ra * g1j + b1j, x1b = vb[j] * rb * g1j + b1j;
                xa[64 * j] = (unsigned long long)pk2(x1a.x, x1a.y) | ((unsigned long long)pk2(x1a.z, x1a.w) << 32); xb[64 * j] = (unsigned long long)pk2(x1b.x, x1b.y) | ((unsigned long long)pk2(x1b.z, x1b.w) << 32);
                va[j] = x1a * sc1 + sh1; vb[j] = x1b * sc1 + sh1;
                amxa = fmaxf(fmaxf(amxa, fmaxf(fabsf(va[j].x), fabsf(va[j].y))), fmaxf(fabsf(va[j].z), fabsf(va[j].w)));
                amxb = fmaxf(fmaxf(amxb, fmaxf(fabsf(vb[j].x), fabsf(vb[j].y))), fmaxf(fabsf(vb[j].z), fabsf(vb[j].w))); }
            amxa = wmax(amxa, lane); amxb = wmax(amxb, lane);
            { const float ia = amxa > 0.f ? 127.0f / amxa : 0.f, ib = amxb > 0.f ? 127.0f / amxb : 0.f;
#pragma unroll
              for (int j = 0; j < 4; ++j) {
                  oa[64 * j] = (unsigned)(((int)rintf(va[j].x * ia) & 0xff) | (((int)rintf(va[j].y * ia) & 0xff) << 8) | (((int)rintf(va[j].z * ia) & 0xff) << 16) | (((int)rintf(va[j].w * ia) & 0xff) << 24));
                  ob[64 * j] = (unsigned)(((int)rintf(vb[j].x * ib) & 0xff) | (((int)rintf(vb[j].y * ib) & 0xff) << 8) | (((int)rintf(vb[j].z * ib) & 0xff) << 16) | (((int)rintf(vb[j].w * ib) & 0xff) << 24)); }
              if (lane == 0) { STOK[tok] = amxa > 0.f ? amxa * (1.0f / 127.0f) : 1.0f; STOK[tok + 1] = amxb > 0.f ? amxb * (1.0f / 127.0f) : 1.0f; } }
            float a[32], c[32];
            f32x2 vp[4][4];
#pragma unroll
            for (int j = 0; j < 4; ++j) { vp[j][0] = (f32x2){va[j].x, vb[j].x}; vp[j][1] = (f32x2){va[j].y, vb[j].y}; vp[j][2] = (f32x2){va[j].z, vb[j].z}; vp[j][3] = (f32x2){va[j].w, vb[j].w}; }
#pragma unroll
            for (int e = 0; e < 32; ++e) { f32x2 acc2 = {0.f, 0.f};
#pragma unroll
                for (int j = 0; j < 4; ++j) { const f32x4 w = *(const LAS f32x4*)(wrt + e * WRP + 4 * lane + 256 * j);
                    acc2 = vp[j][0] * w.x + acc2; acc2 = vp[j][1] * w.y + acc2; acc2 = vp[j][2] * w.z + acc2; acc2 = vp[j][3] * w.w + acc2; }
                a[e] = acc2.x; c[e] = acc2.y; }
            float lga = rs32(a, lane) + br, lgb = rs32(c, lane) + br;
            int ea[4], eb[4]; float xa4[4], xb4[4];
#pragma unroll
            for (int k = 0; k < 4; ++k) {
                const float m1 = wmax(lga, lane), m2 = wmax(lgb, lane);
                const unsigned long long b1_ = __ballot(lga == m1), b2_ = __ballot(lgb == m2);
                ea[k] = (__ffsll((long long)b1_) - 1) >> 1; eb[k] = (__ffsll((long long)b2_) - 1) >> 1; xa4[k] = m1; xb4[k] = m2;
                if ((lane >> 1) == ea[k]) lga = -INFINITY; if ((lane >> 1) == eb[k]) lgb = -INFINITY; }
            { const float e1 = __expf(xa4[1] - xa4[0]), e2 = __expf(xa4[2] - xa4[0]), e3 = __expf(xa4[3] - xa4[0]); const float inv = 1.f / (1.f + e1 + e2 + e3);
              const float f1 = __expf(xb4[1] - xb4[0]), f2 = __expf(xb4[2] - xb4[0]), f3 = __expf(xb4[3] - xb4[0]); const float jnv = 1.f / (1.f + f1 + f2 + f3);
              if (lane < 8) { const int k = lane & 3; const bool second = lane >= 4;
                  const int e = second ? (k == 0 ? eb[0] : k == 1 ? eb[1] : k == 2 ? eb[2] : eb[3]) : (k == 0 ? ea[0] : k == 1 ? ea[1] : k == 2 ? ea[2] : ea[3]);
                  const float gv = second ? (k == 0 ? 1.f : k == 1 ? f1 : k == 2 ? f2 : f3) * jnv : (k == 0 ? 1.f : k == 1 ? e1 : k == 2 ? e2 : e3) * inv;
                  const unsigned r = atomicAdd((unsigned*)&lcnt[e], 1u); const int tk = tok + (second ? 1 : 0);
                  tope[tk * 4 + k] = e; gate[tk * 4 + k] = gv; rank[tk * 4 + k] = (int)r; } }
        }
        __syncthreads();
        if (F.tid < 32) lbase[F.tid] = __hip_atomic_fetch_add(gcnt + F.tid, lcnt[F.tid], __ATOMIC_RELAXED, __HIP_MEMORY_SCOPE_AGENT);
        __syncthreads();
        { const int i = F.tid; const int tok = chunk * 128 + (i >> 2); rank[tok * 4 + (i & 3)] += (int)lbase[tope[tok * 4 + (i & 3)]]; }
        __syncthreads();
    }
}
__device__ __forceinline__ void p6b_scatter(Frame& F, LAS unsigned char* lds) {
    LAS int* pst = (LAS int*)lds; LAS int* cnts = pst + 32;
    unsigned* gcnt = (unsigned*)(F.ws + WS_CTL) + CW_CNT;
    if (F.tid == 0) { int acc = 0; for (int e = 0; e < 32; ++e) { const int c = (int)__hip_atomic_load(gcnt + e, __ATOMIC_RELAXED, __HIP_MEMORY_SCOPE_AGENT); cnts[e] = c; pst[e] = acc; acc += (c + 255) / 256 * 256; }
        pst[64] = acc; }
    __syncthreads();
    const int* tope = (const int*)(F.ws + WS_TOPE); const float* gate = (const float*)(F.ws + WS_GATE); const int* rank = (const int*)(F.ws + WS_RANK);
    int* pos = (int*)(F.ws + WS_POS); int* rowtok = (int*)(F.ws + WS_ROWTOK); float* rowgate = (float*)(F.ws + WS_ROWGATE); int* blkexp = (int*)(F.ws + WS_BLKEXP);
    const float* stok = (const float*)(F.ws + WS_STOK); float* rowscale = (float*)(F.ws + WS_ROWSCALE);
    for (int i = F.vcu * 512 + F.tid; i < NTOK * 4; i += F.G * 512) { const int e = tope[i]; const int d = pst[e] + rank[i]; pos[i] = d; rowtok[d] = i >> 2; rowgate[d] = gate[i]; rowscale[d] = stok[i >> 2]; }
    for (int i = F.vcu * 512 + F.tid; i < 32 * 256; i += F.G * 512) { const int e = i >> 8, r = cnts[e] + (i & 255); if (r < (cnts[e] + 255) / 256 * 256) { rowtok[pst[e] + r] = 0; rowgate[pst[e] + r] = 0.f; rowscale[pst[e] + r] = 0.f; } }
    if (F.vcu == 0) { const int nblk = pst[64] / 256;
        for (int rb = F.tid; rb < nblk; rb += 512) { int e = 0; for (int q = 1; q < 32; ++q) if (pst[q] <= rb * 256) e = q; blkexp[rb] = e; }
        if (F.tid == 0) blkexp[MAXBLK] = nblk;
        if (F.tid < 33) blkexp[600 + F.tid] = (F.tid < 32 ? pst[F.tid] : pst[64]) / 256; }
}
__device__ __forceinline__ void p9_final(Frame& F) {
    const int gw = F.vcu * NWAVES + F.wave, NGW = F.G * NWAVES, lane = F.lane;
    const float* mod = (const float*)(F.ws + WS_MOD); const bf16_t* X1 = (const bf16_t*)(F.ws + WS_X1); const unsigned char* Y = (const unsigned char*)(F.ws + WS_Y); const int* pos = (const int*)(F.ws + WS_POS);
    f32x4 g2[4], b2[4];
#pragma unroll
    for (int j = 0; j < 4; ++j) { g2[j] = ((const f32x4*)F.ln2_g)[lane + 64 * j]; b2[j] = ((const f32x4*)F.ln2_b)[lane + 64 * j]; }
    for (int tok = gw; tok < NTOK; tok += NGW) {
        const int b = tok / SEQ; const f32x4* gf = (const f32x4*)(mod + (size_t)b * 6144 + 5 * DM) + lane;
        const u32x2* xr = (const u32x2*)(X1 + (size_t)tok * DM) + lane;
        int p[4];
#pragma unroll
        for (int k = 0; k < 4; ++k) p[k] = pos[tok * 4 + k];
        f32x4 v[4]; float s = 0.f;
#pragma unroll
        for (int j = 0; j < 4; ++j) { f32x4 ff = {0.f, 0.f, 0.f, 0.f};
#pragma unroll
            for (int k = 0; k < 4; ++k) { const int w = (int)*((const unsigned*)(Y + (size_t)p[k] * DM) + lane + 64 * j);
                const f32x2 lo = __builtin_amdgcn_cvt_pk_f32_fp8(w, false), hi = __builtin_amdgcn_cvt_pk_f32_fp8(w, true);
                ff.x += lo.x; ff.y += lo.y; ff.z += hi.x; ff.w += hi.y; }
            ff = ff * (1.0f / 64.0f);
            { const u32x2 xw = xr[64 * j]; f32x4 x1v; x1v.x = __uint_as_float(xw.x << 16); x1v.y = __uint_as_float(xw.x & 0xffff0000u); x1v.z = __uint_as_float(xw.y << 16); x1v.w = __uint_as_float(xw.y & 0xffff0000u);
              v[j] = x1v * DN_ALPHA + (gf[64 * j] + 1.0f) * ff; } s += (v[j].x + v[j].y) + (v[j].z + v[j].w); }
        const float mean = wave_sum(s) * (1.f / DM); float s2 = 0.f;
#pragma unroll
        for (int j = 0; j < 4; ++j) { v[j] = v[j] - mean; s2 += (v[j].x * v[j].x + v[j].y * v[j].y) + (v[j].z * v[j].z + v[j].w * v[j].w); }
        const float rstd = 1.f / sqrtf(wave_sum(s2) * (1.f / DM) + LN_EPS);
        f32x4* orow = (f32x4*)(F.out + (size_t)tok * DM) + lane;
#pragma unroll
        for (int j = 0; j < 4; ++j) orow[64 * j] = (v[j] * rstd * g2[j] + b2[j])
#ifdef DIAG_ITERS
            * (1.0f + 1e-3f * (DIAG_ITERS == 1 ? (float)((const unsigned*)(F.ws + WS_CTL))[2048] / (float)((const unsigned*)(F.ws + WS_CTL))[2050] : (float)((const unsigned*)(F.ws + WS_CTL))[2049]))
#endif
            ;
    }
}
#ifndef MK_N_LAUNCHES
#define MK_N_LAUNCHES 1
#endif
constexpr int PER_PHASE = 12;
constexpr int N_LAUNCHES = MK_N_LAUNCHES;
struct Args { const float* in[18]; float* out; unsigned char* ws; int ph_lo, ph_hi, sub, pad; };
static_assert(sizeof(Args) == 18 * 8 + 8 + 8 + 16, "Args has no padding");

__global__ void __launch_bounds__(NWAVES * 64, 2) dsa_fwd(Args args) {
    extern __shared__ __attribute__((aligned(16))) unsigned char lds[];
    LAS unsigned char* L = (LAS unsigned char*)lds;
    Frame F;
    F.ws = args.ws; F.tid = threadIdx.x; F.lane = F.tid & 63; F.wave = __builtin_amdgcn_readfirstlane(F.tid >> 6);
    F.G = gridDim.x; { const int bx = blockIdx.x; F.vcu = (F.G % 8 == 0) ? (bx % 8) * (F.G / 8) + bx / 8 : bx; }
    F.x = args.in[0]; F.c = args.in[1]; F.rel_bias = args.in[2]; F.w_ada = args.in[3]; F.b_ada = args.in[4]; F.w_in = args.in[5]; F.ret_g = args.in[6]; F.w_out = args.in[7];
    F.ln1_g = args.in[8]; F.ln1_b = args.in[9]; F.w_router = args.in[10]; F.b_router = args.in[11]; F.w_gu = args.in[12]; F.b_gu = args.in[13]; F.w_d = args.in[14]; F.b_d = args.in[15];
    F.ln2_g = args.in[16]; F.ln2_b = args.in[17]; F.out = args.out;
    unsigned* ctl = (unsigned*)(F.ws + WS_CTL);
    volatile LAS unsigned* MISC = (volatile LAS unsigned*)(L + LDS_BYTES - 64);
    if (F.tid < 16) MISC[F.tid] = 0u;
    __syncthreads();
    XcdBarrier bar; bar.bar = ctl + CW_BAR; bar.x = 0; bar.st = nullptr;
    if (N_LAUNCHES == 1) bar = xcd_barrier_post(ctl + CW_BAR, MISC + 8);
    const int lo = args.ph_lo, hi = args.ph_hi;
#ifndef PHASE_MASK
#define PHASE_MASK 0xfff
#endif
#define IN(k) (((PHASE_MASK >> (k)) & 1) && lo <= (k) && (k) < hi)
#define REFRESH() do { int t_ = threadIdx.x; asm volatile("" : "+v"(t_)); F.tid = t_; F.lane = t_ & 63; } while (0)
#define SEAM(k) do { if (IN(k) && IN((k) + 1)) xcd_barrier(bar); } while (0)

    if (IN(0)) { REFRESH(); p0_prologue(F, L); } SEAM(0);
    if (IN(1)) { REFRESH(); p1_modulate(F, L); } SEAM(1);
    if (IN(2)) { REFRESH();
        {
            pg8::Gemm g{(const bf16_t*)(F.ws + WS_H), (const bf16_t*)(F.ws + WS_WIN), DM, nullptr}; pg8::RemapOrder S; S.base.init(NTOK, 512, F.G, (int)blockIdx.x); S.from = 0; S.off = 3;
            pg8::EpiInProj E{(bf16_t*)(F.ws + WS_QA), (bf16_t*)(F.ws + WS_KA), (bf16_t*)(F.ws + WS_VA), (bf16_t*)(F.ws + WS_QI), (bf16_t*)(F.ws + WS_KIW),
                             (bf16_t*)(F.ws + WS_QR), (bf16_t*)(F.ws + WS_KR), (bf16_t*)(F.ws + WS_VR), (bf16_t*)(F.ws + WS_GR)};
            pg8::gemm_phase<pg8::EpiInProj, pg8::RemapOrder, false>(L, g, S, E); }
        {
            pg8::Gemm g{(const bf16_t*)(F.ws + WS_HQ), (const bf16_t*)(F.ws + WS_WINQ), DM / 2, nullptr}; pg8::RemapOrder S; S.base.init(NTOK, 11 * 256, F.G, (int)blockIdx.x); S.from = 3; S.off = 2;
            pg8::EpiInProjI8 E{(bf16_t*)(F.ws + WS_QA), (bf16_t*)(F.ws + WS_KA), (bf16_t*)(F.ws + WS_VA), (bf16_t*)(F.ws + WS_QR), (bf16_t*)(F.ws + WS_KR), (bf16_t*)(F.ws + WS_VR), (bf16_t*)(F.ws + WS_GR),
                               (const float*)(F.ws + WS_SH), (const float*)(F.ws + WS_SWIN)};
            pg8::gemm_phase<pg8::EpiInProjI8, pg8::RemapOrder, false, true>(L, g, S, E); }
    } SEAM(2);
    if (IN(3)) { REFRESH();
        unsigned* qctr = ctl + CW_QUEUE; volatile LAS unsigned* qslot = MISC;
        int k; bool staged = false;
        if (F.tid == 0) qslot[0] = __hip_atomic_fetch_add(qctr, 1u, __ATOMIC_RELAXED, __HIP_MEMORY_SCOPE_AGENT);
        __syncthreads(); k = (int)qslot[0]; __syncthreads();
        for (;;) {
            if (k >= BATCH * 256 + 1024) break;
            if (k < BATCH * 256 && (args.sub & 1)) { k = select_item(F, L, k, staged, qctr, qslot, args.sub); continue; }
            if (k >= BATCH * 256 && (args.sub & 2)) ret_state_item(F, L, k - BATCH * 256);
            if (F.tid == 0) qslot[0] = __hip_atomic_fetch_add(qctr, 1u, __ATOMIC_RELAXED, __HIP_MEMORY_SCOPE_AGENT);
            __syncthreads(); k = (int)qslot[0]; __syncthreads();
        }
    } SEAM(3);
    if (IN(4)) { REFRESH(); ret_scan(F); } SEAM(4);
    if (IN(5)) { REFRESH();
        if (args.sub & 1)
        for (int i = 0;; ++i) { const int Lx = i * F.G + F.vcu; if (Lx >= 1024) break;
            int bh, qb;
            if (F.G == 256) { const int s = F.vcu & 3; bh = F.vcu >> 2; qb = (i == 0) ? 15 - s : (i == 1) ? 8 + s : (i == 2) ? 7 - s : s; }
            else { bh = Lx >> 4; qb = Lx & 15; }
            attn_body::attn_unit(bh >> 3, bh & 7, qb, (const bf16_t*)(F.ws + WS_QA), (const bf16_t*)(F.ws + WS_KA), (const bf16_t*)(F.ws + WS_VA), (bf16_t*)(F.ws + WS_H),
                                 (const unsigned*)(F.ws + WS_MASK), F.rel_bias, (char*)lds); }
        __syncthreads();
        if (args.sub & 2)
        for (int u = F.vcu; u < 1024; u += F.G) ret_out_item(F, L, u);
    } SEAM(5);
    if (IN(6)) { REFRESH();
        pg8::Gemm g{(const bf16_t*)(F.ws + WS_H), (const bf16_t*)(F.ws + WS_WOUT), DM, nullptr}; pg8::StaticOrder S; S.init(NTOK, DM, F.G, (int)blockIdx.x);
        pg8::EpiOutProj E{(const float*)(F.ws + WS_MOD), (bf16_t*)(F.ws + WS_MIX)};
        pg8::gemm_phase<pg8::EpiOutProj, pg8::StaticOrder, false>(L, g, S, E);
    } SEAM(6);
    if (IN(7)) { REFRESH(); p6_rows(F, L); } SEAM(7);
    if (IN(8)) { REFRESH(); p6b_scatter(F, L); } SEAM(8);
    if (IN(9)) { REFRESH();
        const int* blkexp = (const int*)(F.ws + WS_BLKEXP); const int nblk = __hip_atomic_load(blkexp + MAXBLK, __ATOMIC_RELAXED, __HIP_MEMORY_SCOPE_AGENT);
        pg8::Gemm g{(const bf16_t*)(F.ws + WS_H2), (const bf16_t*)(F.ws + WS_WGU), DM / 2, (const int*)(F.ws + WS_ROWTOK)}; pg8::MoeOrder S{blkexp, nblk, 8, F.G, F.vcu};
        pg8::EpiGateUp E{(unsigned char*)(F.ws + WS_ACT), F.b_gu, (const float*)(F.ws + WS_SWGU), (const float*)(F.ws + WS_ROWSCALE)};
        pg8::gemm_phase<pg8::EpiGateUp, pg8::MoeOrder, true, true>(L, g, S, E);
    } SEAM(9);
    if (IN(10)) { REFRESH();
        const int* blkexp = (const int*)(F.ws + WS_BLKEXP); const int nblk = __hip_atomic_load(blkexp + MAXBLK, __ATOMIC_RELAXED, __HIP_MEMORY_SCOPE_AGENT);
        pg8::Gemm g{(const bf16_t*)(F.ws + WS_ACT), (const bf16_t*)(F.ws + WS_WD), DFF / 2, nullptr}; pg8::MoeOrder S{blkexp, nblk, 4, F.G, F.vcu};
        pg8::EpiDown E{(unsigned char*)(F.ws + WS_Y), F.b_d, (const float*)(F.ws + WS_ROWGATE), (const float*)(F.ws + WS_SWD)};
        pg8::gemm_phase<pg8::EpiDown, pg8::MoeOrder, false, false, true>(L, g, S, E);
    } SEAM(10);
    if (IN(11)) { REFRESH(); p9_final(F); }
#undef IN
#undef SEAM
}

extern "C" void kernel_launch(void* const* d_in, const int* in_sizes, int n_in, void* d_out, int out_size, void* d_ws, size_t ws_size, hipStream_t stream) {
    static int grid = 0;
    if (grid == 0) {
        if (n_in != 18 || out_size != NTOK * DM || ws_size < WS_END) { fprintf(stderr, "kernel_launch: unexpected shapes (n_in %d out %d ws %zu)\n", n_in, out_size, ws_size); grid = -1; return; }
        int dev = 0, cus = 0, per_cu = 0;
        if (hipGetDevice(&dev) != hipSuccess || hipDeviceGetAttribute(&cus, hipDeviceAttributeMultiprocessorCount, dev) != hipSuccess) { grid = -1; return; }
        if (hipFuncSetAttribute((const void*)dsa_fwd, hipFuncAttributeMaxDynamicSharedMemorySize, LDS_BYTES) != hipSuccess) { fprintf(stderr, "kernel_launch: hipFuncSetAttribute failed\n"); grid = -1; return; }
        if (hipOccupancyMaxActiveBlocksPerMultiprocessor(&per_cu, (const void*)dsa_fwd, NWAVES * 64, LDS_BYTES) != hipSuccess || per_cu < 1) { fprintf(stderr, "kernel_launch: occupancy query says %d blocks per CU\n", per_cu); (void)hipGetLastError(); per_cu = 1; }
        grid = cus;
    }
    if (grid < 0) return;
    (void)hipMemsetAsync((char*)d_ws + WS_CTL, 0, CTL_ZERO_BYTES, stream);
    Args a{};
    for (int i = 0; i < 18; ++i) a.in[i] = (const float*)d_in[i];
    a.out = (float*)d_out; a.ws = (unsigned char*)d_ws; a.sub = 3;
    if (N_LAUNCHES == 1) {
        a.ph_lo = 0; a.ph_hi = PER_PHASE;
        void* kargs[] = {&a};
        hipError_t e = hipLaunchCooperativeKernel((const void*)dsa_fwd, dim3(grid), dim3(NWAVES * 64), kargs, LDS_BYTES, stream);
        if (e != hipSuccess) { fprintf(stderr, "kernel_launch: cooperative launch failed: %s (grid %d)\n", hipGetErrorString(e), grid); }
#ifdef PROBE_PHASE
        a.ph_lo = PROBE_PHASE; a.ph_hi = PROBE_PHASE + 1;
#ifdef PROBE_SUB
        a.sub = PROBE_SUB;
#endif
        (void)hipMemsetAsync((char*)d_ws + WS_CTL + 4 * CW_QUEUE, 0, 64, stream);
        hipLaunchKernelGGL(dsa_fwd, dim3(grid), dim3(NWAVES * 64), LDS_BYTES, stream, a);
#endif
    } else {
        for (int li = 0; li < PER_PHASE; ++li) { a.ph_lo = li; a.ph_hi = li + 1; hipLaunchKernelGGL(dsa_fwd, dim3(grid), dim3(NWAVES * 64), LDS_BYTES, stream, a); }
    }
}
```

```cpp
#include <hip/hip_runtime.h>
#include <hip/hip_bf16.h>
#include <cstdio>
#include <cstdint>
#include <cmath>

#define LAS __attribute__((address_space(3)))
#define GAS __attribute__((address_space(1)))
typedef unsigned short bf16_t;
typedef short bf16x8 __attribute__((ext_vector_type(8)));
typedef short s16x4 __attribute__((ext_vector_type(4)));
typedef float f32x2 __attribute__((ext_vector_type(2)));
typedef float f32x4 __attribute__((ext_vector_type(4)));
typedef float f32x16 __attribute__((ext_vector_type(16)));
typedef unsigned u32x2 __attribute__((ext_vector_type(2)));
typedef unsigned u32x4 __attribute__((ext_vector_type(4)));
typedef int i32x4 __attribute__((ext_vector_type(4)));
typedef int i32x8 __attribute__((ext_vector_type(8)));

constexpr int BATCH = 8, SEQ = 4096, DM = 1024, NTOK = BATCH * SEQ;
constexpr int NIN = 3328;
constexpr int DIN_SRC = 3140;
constexpr int NEXP = 32, DFF = 1024, TOPK = 4, MOE_BLK = 256, MAXBLK = 544, PROWS = MAXBLK * 256;
constexpr float LN_EPS = 1e-5f;
constexpr float DN_ALPHA = 1.189207115002721f;
constexpr float LOG2E = 1.4426950408889634f;
constexpr float QSCALE = 0.125f * LOG2E;

__device__ __forceinline__ unsigned f2bf(float f) { unsigned u = __builtin_bit_cast(unsigned, f); return (u + 0x7fffu + ((u >> 16) & 1u)) >> 16; }
__device__ __forceinline__ unsigned pk2(float lo, float hi) { return f2bf(lo) | (f2bf(hi) << 16); }
__device__ __forceinline__ float bf2f(unsigned short b) { return __uint_as_float(((unsigned)b) << 16); }
__device__ __forceinline__ unsigned cvt_pk_bf16(float lo, float hi) { unsigned r; asm volatile("v_cvt_pk_bf16_f32 %0, %1, %2" : "=v"(r) : "v"(lo), "v"(hi)); return r; }

namespace pg8 {
constexpr int BM = 256, BK = 64, HALF = 128, HTB = HALF * BK * 2, STAGE_BYTES = 8 * HTB, NXCD = 8, WGM = 8;
__host__ __device__ __forceinline__ int lds_byte(int r, int c) { const int st = (r >> 4) * 2 + (c >> 5), rr = r & 15, cc = c & 31, ob = rr * 64 + cc * 2; return st * 1024 + (ob ^ (((ob >> 9) & 1) << 5)); }
__host__ __device__ __forceinline__ void stage_rc(int b, int& R, int& C) { const int st = b / 1024, sb = b % 1024, swz = sb ^ (((sb >> 9) & 1) << 5); R = (st >> 1) * 16 + swz / 64; C = (st & 1) * 32 + (swz % 64) / 2; }
__host__ __device__ __forceinline__ int perm32(int rho) { const int n = rho >> 4, i = rho & 15; return 8 * (i >> 2) + 4 * n + (i & 3); }

struct Unit { int pm, pn; };
struct Gemm { const bf16_t* A; const bf16_t* Bt; int K; const int* rowidx; };

struct StaticOrder {
    int nM, nN, nwg, G, c;
    __device__ void init(int M, int N, int G_, int c_) { nM = M / BM; nN = N / BM; nwg = nM * nN; G = G_; c = c_; }
    __device__ bool next(int i, Unit& u) const {
        const long L = (long)i * G + c; if (L >= nwg) return false;
        int wgid = (int)L; { const int q = nwg / NXCD, r = nwg % NXCD, xcd = wgid % NXCD, off = wgid / NXCD; wgid = (xcd < r ? xcd * (q + 1) : r * (q + 1) + (xcd - r) * q) + off; }
        const int nig = WGM * nN, gid = wgid / nig, fm = gid * WGM, gsz = (nM - fm) < WGM ? (nM - fm) : WGM;
        u.pm = fm + ((wgid % nig) % gsz); u.pn = (wgid % nig) / gsz; return true;
    }
};
struct RemapOrder {
    StaticOrder base; int from, off, off0;
    __device__ bool next(int i, Unit& u) const { if (!base.next(i, u)) return false; u.pn += (u.pn >= from) ? off : off0; return true; }
};
struct SingleOrder {
    int pm, pn;
    __device__ bool next(int i, Unit& u) const { if (i > 0) return false; u.pm = pm; u.pn = pn; return true; }
};
struct MoeOrder {
    const int* block_exp; int nblk, nN, G, c;
    __device__ bool next(int i, Unit& u) const {
        if (false && G == 256) {
            const int x = c >> 5, j = c & 31; int q = i * 32 + j;
#pragma unroll 1
            for (int k = 0; k < 4; ++k) { const int e = x + 8 * k; const int b0 = block_exp[600 + e], nb = block_exp[601 + e] - b0;
                if (q < nb * nN) { u.pm = b0 + q / nN; u.pn = e * nN + q % nN; return true; }
                q -= nb * nN; }
            return false;
        }
        const long L = (long)i * G + c; if (L >= (long)nblk * nN) return false;
        const int rb = (int)(L / nN), pnl = (int)(L % nN);
        u.pm = rb; u.pn = block_exp[rb] * nN + pnl; return true;
    }
};

template <class Epi, class Sched, bool GATHER, bool I8 = false, bool F8 = false>
__device__ __forceinline__ void gemm_phase(LAS unsigned char* lds, const Gemm g, const Sched& S, const Epi& E) {
    int tid = threadIdx.x; asm volatile("" : "+v"(tid));
    const int wid = __builtin_amdgcn_readfirstlane(tid >> 6), lane = tid & 63, wr = wid >> 2, wc = wid & 3, fr = lane & 15, fq = lane >> 4;
    const int K = g.K, nt = K / BK;
    unsigned voffA0[2], voffA1[2], voffB[2], nvA0[2], nvA1[2]; int RA[2], CA[2];
    const size_t hstep = (size_t)HALF * K * 2;
    const size_t tstep = 2 * hstep;
#pragma unroll
    for (int i = 0; i < 2; ++i) { int R, C; stage_rc(tid * 16 + i * 8192, R, C); const int Rb = Epi::PERM ? ((R & ~31) + perm32(R & 31)) : R;
        RA[i] = R; CA[i] = C;
        voffA0[i] = (unsigned)(R * K + C) * 2u; voffA1[i] = voffA0[i] + (unsigned)hstep; voffB[i] = (unsigned)(Rb * K + C) * 2u; nvA0[i] = voffA0[i]; nvA1[i] = voffA1[i]; }
    const size_t kstep = (size_t)(BK * 2);
    const unsigned ldsw = (unsigned)wid * 1024u;
    const int aoff = lds_byte(wr * 64 + fr, fq * 8), boff = lds_byte(wc * 32 + fr, fq * 8);
#define PG8_SA(b, h) (((b) * 2 + (h)) * HTB)
#define PG8_SB(b, h) ((4 + (b) * 2 + (h)) * HTB)
#define PG8_STAGE(bufoff, gbase, voff) do { _Pragma("unroll") for (int _i = 0; _i < 2; ++_i) \
        __builtin_amdgcn_global_load_lds((const unsigned*)((const char*)(gbase) + (voff)[_i]), (LAS unsigned*)(lds + (bufoff) + ldsw + _i * 8192), 16, 0, 0); } while (0)
#define PG8_LDA(dst, b, h) do { if constexpr (F8) { _Pragma("unroll") for (int m = 0; m < 4; ++m) { const i32x4 lo_ = *(const LAS i32x4*)(lds + PG8_SA(b, h) + aoff + m * 2048), hi_ = *(const LAS i32x4*)(lds + PG8_SA(b, h) + aoff + m * 2048 + 1024); dst##8[m] = __builtin_shufflevector(lo_, hi_, 0, 1, 2, 3, 4, 5, 6, 7); } } \
        else { _Pragma("unroll") for (int m = 0; m < 4; ++m) _Pragma("unroll") for (int k = 0; k < 2; ++k) dst[m][k] = *(const LAS bf16x8*)(lds + PG8_SA(b, h) + aoff + m * 2048 + k * 1024); } } while (0)
#define PG8_LDB(dst, b, h) do { if constexpr (F8) { _Pragma("unroll") for (int n = 0; n < 2; ++n) { const i32x4 lo_ = *(const LAS i32x4*)(lds + PG8_SB(b, h) + boff + n * 2048), hi_ = *(const LAS i32x4*)(lds + PG8_SB(b, h) + boff + n * 2048 + 1024); dst##8[n] = __builtin_shufflevector(lo_, hi_, 0, 1, 2, 3, 4, 5, 6, 7); } } \
        else { _Pragma("unroll") for (int n = 0; n < 2; ++n) _Pragma("unroll") for (int k = 0; k < 2; ++k) dst[n][k] = *(const LAS bf16x8*)(lds + PG8_SB(b, h) + boff + n * 2048 + k * 1024); } } while (0)
#define PG8_MMA(ai, bj, At, Bt) do { __builtin_amdgcn_s_setprio(1); _Pragma("unroll") for (int m = 0; m < 4; ++m) _Pragma("unroll") for (int n = 0; n < 2; ++n) { \
        if constexpr (F8) { asm volatile("v_mfma_scale_f32_16x16x128_f8f6f4 %0, %1, %2, %0, %3, %3 op_sel_hi:[0,0,0]" : "+v"(acc[ai][bj][m][n]) : "v"(Bt##8[n]), "v"(At##8[m]), "v"(mxone)); } \
        else { _Pragma("unroll") for (int k = 0; k < 2; ++k) { \
          if constexpr (I8) { asm volatile("v_mfma_i32_16x16x64_i8 %0, %1, %2, %0" : "+v"(acc[ai][bj][m][n]) : "v"(Bt[n][k]), "v"(At[m][k])); } \
          else acc[ai][bj][m][n] = __builtin_bit_cast(acc_t, __builtin_amdgcn_mfma_f32_16x16x32_bf16(Bt[n][k], At[m][k], __builtin_bit_cast(f32x4, acc[ai][bj][m][n]), 0, 0, 0)); } } } __builtin_amdgcn_s_setprio(0); } while (0)
#define PG8_WAIT_V(n) asm volatile("s_waitcnt vmcnt(" #n ")" ::: "memory")
#define PG8_WAIT_L(n) asm volatile("s_waitcnt lgkmcnt(" #n ")" ::: "memory")
#define PG8_BAR __builtin_amdgcn_s_barrier()
#define PG8_SCHED __builtin_amdgcn_sched_barrier(0)
#define PG8_GLOAD(u, o0, o1) do { if constexpr (GATHER) { _Pragma("unroll") for (int _i = 0; _i < 2; ++_i) { \
        const int r0_ = g.rowidx[(u).pm * BM + RA[_i]], r1_ = g.rowidx[(u).pm * BM + HALF + RA[_i]]; \
        o0[_i] = (unsigned)(r0_ * K + CA[_i]) * 2u; o1[_i] = (unsigned)(r1_ * K + CA[_i]) * 2u; } } } while (0)
    Unit cur, nxt; int ui = 0;
    if (!S.next(0, cur)) return;
    typedef typename Epi::acc_t acc_t;
    acc_t acc[2][2][4][2];
#pragma unroll
    for (int a = 0; a < 2; ++a)
#pragma unroll
        for (int b = 0; b < 2; ++b)
#pragma unroll
            for (int m = 0; m < 4; ++m)
#pragma unroll
                for (int n = 0; n < 2; ++n) acc[a][b][m][n] = acc_t{};
    bf16x8 At[4][2], B0[2][2], B1[2][2];
    int mxone = 0x7f7f7f7f; asm volatile("" : "+v"(mxone));
    i32x8 At8[4], B08[2], B18[2];
    PG8_GLOAD(cur, voffA0, voffA1);
    E.stage(cur, lds + STAGE_BYTES, wid, lane);
    const char* cA = (const char*)g.A + (GATHER ? (size_t)0 : (size_t)cur.pm * tstep); const char* cB = (const char*)g.Bt + (size_t)cur.pn * tstep;
    PG8_STAGE(PG8_SB(0, 0), cB, voffB); PG8_STAGE(PG8_SB(0, 1), cB + hstep, voffB); PG8_STAGE(PG8_SA(0, 0), cA, voffA0); PG8_STAGE(PG8_SA(0, 1), cA, voffA1);
    if (wr == 1) PG8_BAR;
    PG8_WAIT_V(2); PG8_BAR;
    PG8_STAGE(PG8_SB(1, 0), cB + kstep, voffB); PG8_STAGE(PG8_SA(1, 0), cA + kstep, voffA0); PG8_STAGE(PG8_SB(1, 1), cB + hstep + kstep, voffB);
    PG8_WAIT_V(6); PG8_BAR;
    for (;;) {
        const bool has_next = S.next(ui + 1, nxt);
        const char* nA = has_next ? (const char*)g.A + (GATHER ? (size_t)0 : (size_t)nxt.pm * tstep) : cA; const char* nB = has_next ? (const char*)g.Bt + (size_t)nxt.pn * tstep : cB;
        for (int t = 0; t < nt; t += 2) {
            const bool last = (t == nt - 2);
            const char* a1 = cA + (size_t)(t + 1) * kstep;
            const char* a2 = last ? nA : cA + (size_t)(t + 2) * kstep; const char* b2 = last ? nB : cB + (size_t)(t + 2) * kstep;
            const char* a3 = a2 + kstep; const char* b3 = b2 + kstep;
            if (last && has_next) { int ln_ = lane; asm volatile("" : "+v"(ln_)); E.stage(nxt, lds + STAGE_BYTES + ((ui + 1) & 1) * 4096, wid, ln_); }
            if constexpr (GATHER) { if (last) { if (has_next) { PG8_GLOAD(nxt, nvA0, nvA1); } else { nvA0[0] = voffA0[0]; nvA0[1] = voffA0[1]; nvA1[0] = voffA1[0]; nvA1[1] = voffA1[1]; } } }
            unsigned x0[2], x1[2];
#pragma unroll
            for (int _i = 0; _i < 2; ++_i) { x0[_i] = (GATHER && last) ? nvA0[_i] : voffA0[_i]; x1[_i] = (GATHER && last) ? nvA1[_i] : voffA1[_i]; }
            PG8_LDB(B0, 0, 0); PG8_LDB(B1, 0, 1); PG8_SCHED; PG8_LDA(At, 0, 0); PG8_STAGE(PG8_SA(1, 1), a1, voffA1);
            PG8_WAIT_V(8); PG8_WAIT_L(0); PG8_BAR; PG8_MMA(0, 0, At, B0); PG8_MMA(0, 1, At, B1); PG8_BAR; PG8_SCHED;
            PG8_LDA(At, 0, 1); PG8_STAGE(PG8_SB(0, 0), b2, voffB); PG8_STAGE(PG8_SB(0, 1), b2 + hstep, voffB); PG8_STAGE(PG8_SA(0, 0), a2, x0);
            PG8_WAIT_V(8); PG8_WAIT_L(0); PG8_BAR; PG8_MMA(1, 0, At, B0); PG8_MMA(1, 1, At, B1); PG8_BAR; PG8_SCHED;
            PG8_LDB(B0, 1, 0); PG8_LDB(B1, 1, 1); PG8_SCHED; PG8_LDA(At, 1, 0); PG8_STAGE(PG8_SA(0, 1), a2, x1);
            PG8_WAIT_V(8); PG8_WAIT_L(0); PG8_BAR; PG8_MMA(0, 0, At, B0); PG8_MMA(0, 1, At, B1); PG8_BAR; PG8_SCHED;
            PG8_LDA(At, 1, 1); PG8_STAGE(PG8_SB(1, 0), b3, voffB); PG8_STAGE(PG8_SB(1, 1), b3 + hstep, voffB); PG8_STAGE(PG8_SA(1, 0), a3, x0);
            PG8_WAIT_V(8); PG8_WAIT_L(0); PG8_BAR; PG8_MMA(1, 0, At, B0); PG8_MMA(1, 1, At, B1); PG8_BAR; PG8_SCHED;
        }
        if (wr == 0) PG8_BAR;
        if constexpr (F8 || I8) asm volatile("s_nop 15\n\ts_nop 15" ::: "memory");
        { int fr_ = fr, fq_ = fq; asm volatile("" : "+v"(fr_), "+v"(fq_));
          E(acc, cur, wr, wc, fr_, fq_, lds + STAGE_BYTES + (ui & 1) * 4096); }
        if (!has_next) break;
#pragma unroll
        for (int a = 0; a < 2; ++a)
#pragma unroll
            for (int b = 0; b < 2; ++b)
#pragma unroll
                for (int m = 0; m < 4; ++m)
#pragma unroll
                    for (int n = 0; n < 2; ++n) acc[a][b][m][n] = acc_t{};
        cur = nxt; cA = nA; cB = nB; ++ui;
        if constexpr (GATHER) { voffA0[0] = nvA0[0]; voffA0[1] = nvA0[1]; voffA1[0] = nvA1[0]; voffA1[1] = nvA1[1]; }
        if (wr == 1) PG8_BAR;
    }
    PG8_WAIT_V(0);
    PG8_BAR;
#undef PG8_SA
#undef PG8_SB
#undef PG8_STAGE
#undef PG8_LDA
#undef PG8_LDB
#undef PG8_MMA
#undef PG8_WAIT_V
#undef PG8_WAIT_L
#undef PG8_BAR
#undef PG8_SCHED
#undef PG8_GLOAD
}
}
namespace pg8 {
struct EpiInProj {
    static constexpr bool PERM = true; typedef f32x4 acc_t;
    bf16_t *QA, *KA, *VA, *QI, *KIW, *QR, *KR, *VR, *GR;
    __device__ __forceinline__ void stage(const Unit&, LAS unsigned char*, int, int) const {}
    __device__ __forceinline__ void operator()(const f32x4 (&acc)[2][2][4][2], const Unit& u, int wr, int wc, int fr, int fq, LAS unsigned char* aux) const {
        const int row0 = u.pm * BM + wr * 64 + fr;
#pragma unroll
        for (int bj = 0; bj < 2; ++bj) {
            const int hb = u.pn * 2 + bj;
            bf16_t* base; int pitch; float sc = 1.f;
            if (hb < 4) { base = QA + hb * 128; pitch = 512; sc = QSCALE; }
            else if (hb == 4) { base = KA; pitch = 128; }
            else if (hb == 5) { base = VA; pitch = 128; }
            else if (hb < 8) { base = QI + (hb - 6) * 128; pitch = 256; sc = 0.125f; }
            else if (hb == 8) { base = KIW; pitch = 128; }
            else if (hb == 9) { continue; }
            else if (hb < 14) { base = QR + (hb - 10) * 128; pitch = 512; }
            else if (hb < 18) { base = KR + (hb - 14) * 128; pitch = 512; }
            else if (hb < 22) { base = VR + (hb - 18) * 128; pitch = 512; }
            else { base = GR + (hb - 22) * 128; pitch = 512; }
            const int col0 = wc * 32 + 8 * fq;
#pragma unroll
            for (int ai = 0; ai < 2; ++ai)
#pragma unroll
                for (int m = 0; m < 4; ++m) {
                    const f32x4 v0 = acc[ai][bj][m][0] * sc, v1 = acc[ai][bj][m][1] * sc;
                    u32x4 w; w.x = cvt_pk_bf16(v0[0], v0[1]); w.y = cvt_pk_bf16(v0[2], v0[3]); w.z = cvt_pk_bf16(v1[0], v1[1]); w.w = cvt_pk_bf16(v1[2], v1[3]);
                    *(u32x4*)(base + (size_t)(row0 + ai * HALF + m * 16) * pitch + col0) = w; }
        }
    }
};
struct EpiInProjI8 {
    static constexpr bool PERM = true; typedef i32x4 acc_t;
    bf16_t *QA, *KA, *VA, *QR, *KR, *VR, *GR; const float* srow; const float* scol;
    __device__ __forceinline__ void stage(const Unit& u, LAS unsigned char* aux, int wid, int lane) const {
        if (wid == 0) { const f32x4 sr = *(const f32x4*)(srow + (size_t)u.pm * BM + lane * 4), sc = *(const f32x4*)(scol + (size_t)u.pn * BM + lane * 4);
            *(LAS f32x4*)(aux + lane * 16) = sr; *(LAS f32x4*)(aux + 1024 + lane * 16) = sc; }
    }
    __device__ __forceinline__ void operator()(const i32x4 (&acc)[2][2][4][2], const Unit& u, int wr, int wc, int fr, int fq, LAS unsigned char* aux) const {
        const int rl0 = wr * 64 + fr;
#pragma unroll
        for (int bj = 0; bj < 2; ++bj) {
            const int hb = u.pn * 2 + bj;
            bf16_t* base; int pitch; float sc = 1.f;
            if (hb < 4) { base = QA + hb * 128; pitch = 512; sc = QSCALE; }
            else if (hb == 4) { base = KA; pitch = 128; }
            else if (hb == 5) { base = VA; pitch = 128; }
            else if (hb < 14) { base = QR + (hb - 10) * 128; pitch = 512; }
            else if (hb < 18) { base = KR + (hb - 14) * 128; pitch = 512; }
            else if (hb < 22) { base = VR + (hb - 18) * 128; pitch = 512; }
            else { base = GR + (hb - 22) * 128; pitch = 512; }
            const int cl0 = wc * 32 + 8 * fq;
#pragma unroll
            for (int ai = 0; ai < 2; ++ai)
#pragma unroll
                for (int m = 0; m < 4; ++m) { const int rl = rl0 + ai * HALF + m * 16; const float sr = *(const LAS float*)(aux + rl * 4) * sc;
                    const f32x4 c0 = *(const LAS f32x4*)(aux + 1024 + (bj * HALF + cl0) * 4), c1 = *(const LAS f32x4*)(aux + 1024 + (bj * HALF + cl0 + 4) * 4);
                    const i32x4 a0 = acc[ai][bj][m][0], a1 = acc[ai][bj][m][1];
                    const f32x4 v0 = (f32x4){(float)a0[0], (float)a0[1], (float)a0[2], (float)a0[3]} * c0 * sr, v1 = (f32x4){(float)a1[0], (float)a1[1], (float)a1[2], (float)a1[3]} * c1 * sr;
                    u32x4 w; w.x = cvt_pk_bf16(v0[0], v0[1]); w.y = cvt_pk_bf16(v0[2], v0[3]); w.z = cvt_pk_bf16(v1[0], v1[1]); w.w = cvt_pk_bf16(v1[2], v1[3]);
                    *(u32x4*)(base + (size_t)(u.pm * BM + rl) * pitch + cl0) = w; asm volatile("" ::: "memory"); }
        }
    }
};
struct EpiOutProj {
    static constexpr bool PERM = true; typedef f32x4 acc_t;
    const float* mod; bf16_t* MIX;
    __device__ __forceinline__ void stage(const Unit&, LAS unsigned char*, int, int) const {}
    __device__ __forceinline__ void operator()(const f32x4 (&acc)[2][2][4][2], const Unit& u, int wr, int wc, int fr, int fq, LAS unsigned char* aux) const {
        const int row0 = u.pm * BM + wr * 64 + fr, col0 = u.pn * BM + wc * 32 + 8 * fq;
        const int b = (u.pm * BM) / SEQ;
        f32x4 gv[2][2];
#pragma unroll
        for (int bj = 0; bj < 2; ++bj)
#pragma unroll
            for (int n = 0; n < 2; ++n) gv[bj][n] = *(const f32x4*)(mod + (size_t)b * 6 * DM + 2 * DM + col0 + bj * HALF + 4 * n) + 1.0f;
#pragma unroll
        for (int ai = 0; ai < 2; ++ai)
#pragma unroll
            for (int m = 0; m < 4; ++m) { bf16_t* rowp = MIX + (size_t)(row0 + ai * HALF + m * 16) * DM + col0;
#pragma unroll
                for (int bj = 0; bj < 2; ++bj) { const f32x4 v0 = acc[ai][bj][m][0] * gv[bj][0], v1 = acc[ai][bj][m][1] * gv[bj][1];
                    u32x4 w; w.x = cvt_pk_bf16(v0[0], v0[1]); w.y = cvt_pk_bf16(v0[2], v0[3]); w.z = cvt_pk_bf16(v1[0], v1[1]); w.w = cvt_pk_bf16(v1[2], v1[3]);
                    *(u32x4*)(rowp + bj * HALF) = w; } }
    }
};
struct EpiGateUp {
    static constexpr bool PERM = true; typedef i32x4 acc_t;
    unsigned char* act; const float* bgu; const float* swgu; const float* rowscale;
    __device__ __forceinline__ void stage(const Unit& u, LAS unsigned char* aux, int wid, int lane) const {
        if (wid == 0) { const int e = u.pn >> 3, pnl = u.pn & 7;
            const f32x4 v = *(const f32x4*)(bgu + (size_t)e * 2048 + (lane >> 5) * 1024 + pnl * 128 + (lane & 31) * 4);
            const f32x4 sc = *(const f32x4*)(swgu + (size_t)e * 2048 + pnl * 256 + lane * 4);
            const f32x4 sr = *(const f32x4*)(rowscale + (size_t)u.pm * BM + lane * 4);
            *(LAS f32x4*)(aux + lane * 16) = v; *(LAS f32x4*)(aux + 1024 + lane * 16) = sc; *(LAS f32x4*)(aux + 2048 + lane * 16) = sr; }
    }
    __device__ __forceinline__ void operator()(const i32x4 (&acc)[2][2][4][2], const Unit& u, int wr, int wc, int fr, int fq, LAS unsigned char* aux) const {
        const int pnl = u.pn & 7;
        const int rl0 = wr * 64 + fr, j0 = wc * 32 + 8 * fq;
#pragma unroll
        for (int ai = 0; ai < 2; ++ai)
#pragma unroll
            for (int m = 0; m < 4; ++m) { const int rl = rl0 + ai * HALF + m * 16; const float sr = *(const LAS float*)(aux + 2048 + rl * 4);
                f32x2 ov[4];
#pragma unroll
                for (int q = 0; q < 4; ++q) { const i32x4 ga = acc[ai][0][m][q >> 1], ua = acc[ai][1][m][q >> 1];
                    f32x2 g2 = (q & 1) ? (f32x2){(float)ga[2], (float)ga[3]} : (f32x2){(float)ga[0], (float)ga[1]}; f32x2 u2 = (q & 1) ? (f32x2){(float)ua[2], (float)ua[3]} : (f32x2){(float)ua[0], (float)ua[1]};
                    g2 = g2 * (*(const LAS f32x2*)(aux + 1024 + (j0 + 2 * q) * 4) * sr) + *(const LAS f32x2*)(aux + (j0 + 2 * q) * 4);
                    u2 = u2 * (*(const LAS f32x2*)(aux + 1536 + (j0 + 2 * q) * 4) * sr) + *(const LAS f32x2*)(aux + 512 + (j0 + 2 * q) * 4);
                    g2.x = fminf(g2.x, 7.0f); g2.y = fminf(g2.y, 7.0f); u2.x = __builtin_amdgcn_fmed3f(u2.x, -7.0f, 7.0f); u2.y = __builtin_amdgcn_fmed3f(u2.y, -7.0f, 7.0f);
                    f32x2 t = g2 * (-1.702f * LOG2E); t.x = __builtin_amdgcn_exp2f(t.x); t.y = __builtin_amdgcn_exp2f(t.y); t = t + 1.0f;
                    f32x2 sg; sg.x = __builtin_amdgcn_rcpf(t.x); sg.y = __builtin_amdgcn_rcpf(t.y);
                    ov[q] = (u2 + 1.0f) * (g2 * sg) * 8.0f; ov[q].x = __builtin_amdgcn_fmed3f(ov[q].x, -448.0f, 448.0f); ov[q].y = __builtin_amdgcn_fmed3f(ov[q].y, -448.0f, 448.0f); }
                int w0 = __builtin_amdgcn_cvt_pk_fp8_f32(ov[0].x, ov[0].y, 0, false); w0 = __builtin_amdgcn_cvt_pk_fp8_f32(ov[1].x, ov[1].y, w0, true);
                int w1 = __builtin_amdgcn_cvt_pk_fp8_f32(ov[2].x, ov[2].y, 0, false); w1 = __builtin_amdgcn_cvt_pk_fp8_f32(ov[3].x, ov[3].y, w1, true);
                u32x2 wv; wv.x = (unsigned)w0; wv.y = (unsigned)w1;
                *(u32x2*)(act + (size_t)(u.pm * BM + rl) * DFF + pnl * 128 + j0) = wv; asm volatile("" ::: "memory"); }
    }
};
struct EpiDown {
    static constexpr bool PERM = true; typedef f32x4 acc_t;
    unsigned char* Y; const float* bd; const float* row_gate; const float* swd;
    __device__ __forceinline__ void stage(const Unit& u, LAS unsigned char* aux, int wid, int lane) const {
        if (wid == 0) { const int e = u.pn >> 2, pnl = u.pn & 3;
            const f32x4 v = *(const f32x4*)(bd + (size_t)e * DM + pnl * BM + lane * 4); const f32x4 g = *(const f32x4*)(row_gate + (size_t)u.pm * BM + lane * 4) * 64.0f;
            const f32x4 cs = *(const f32x4*)(swd + (size_t)e * DM + pnl * BM + lane * 4) * 0.125f;
            *(LAS f32x4*)(aux + lane * 16) = v; *(LAS f32x4*)(aux + 1024 + lane * 16) = g; *(LAS f32x4*)(aux + 2048 + lane * 16) = cs; }
    }
    __device__ __forceinline__ void operator()(const f32x4 (&acc)[2][2][4][2], const Unit& u, int wr, int wc, int fr, int fq, LAS unsigned char* aux) const {
        const int pnl = u.pn & 3;
        const int rl0 = wr * 64 + fr, cl0 = wc * 32 + 8 * fq;
#pragma unroll
        for (int ai = 0; ai < 2; ++ai)
#pragma unroll
            for (int m = 0; m < 4; ++m) { const int rl = rl0 + ai * HALF + m * 16; const float gt = *(const LAS float*)(aux + 1024 + rl * 4);
#pragma unroll
                for (int bj = 0; bj < 2; ++bj) { const f32x4 b0 = *(const LAS f32x4*)(aux + (cl0 + bj * HALF) * 4), b1 = *(const LAS f32x4*)(aux + (cl0 + bj * HALF + 4) * 4);
                    const f32x4 c0 = *(const LAS f32x4*)(aux + 2048 + (cl0 + bj * HALF) * 4), c1 = *(const LAS f32x4*)(aux + 2048 + (cl0 + bj * HALF + 4) * 4);
                    f32x4 v0 = (acc[ai][bj][m][0] * c0 + b0) * gt, v1 = (acc[ai][bj][m][1] * c1 + b1) * gt;
#pragma unroll
                    for (int i = 0; i < 4; ++i) { v0[i] = __builtin_amdgcn_fmed3f(v0[i], -448.0f, 448.0f); v1[i] = __builtin_amdgcn_fmed3f(v1[i], -448.0f, 448.0f); }
                    int w0 = __builtin_amdgcn_cvt_pk_fp8_f32(v0[0], v0[1], 0, false); w0 = __builtin_amdgcn_cvt_pk_fp8_f32(v0[2], v0[3], w0, true);
                    int w1 = __builtin_amdgcn_cvt_pk_fp8_f32(v1[0], v1[1], 0, false); w1 = __builtin_amdgcn_cvt_pk_fp8_f32(v1[2], v1[3], w1, true);
                    u32x2 w; w.x = (unsigned)w0; w.y = (unsigned)w1;
                    *(u32x2*)(Y + (size_t)(u.pm * BM + rl) * DM + pnl * BM + cl0 + bj * HALF) = w; } }
    }
};
}
namespace attn_body {
constexpr int D = 64, QP = 512, KP = 128, VP = 128, OP = 1024;
constexpr int NW = 8, QBLK = 32, QB = QBLK * NW, KVBLK = 64;
__device__ __forceinline__ int crow(int r, int hi) { return (r & 3) + 8 * (r >> 2) + 4 * hi; }
#define SBAR() __builtin_amdgcn_sched_barrier(0)
constexpr int NSLOT = 3, SLOTB = 8192, MSLOT = 2048;
constexpr int LDS_K = 0, LDS_V = NSLOT * SLOTB, LDS_WS = 2 * NSLOT * SLOTB, LDS_OST = LDS_WS + NW * 64 * 4, LDS_M = LDS_OST + NW * 4096, LDS_BT = LDS_M + NSLOT * MSLOT, BT_N = 704, LDS_BYTES = LDS_BT + BT_N * 4;
__device__ __forceinline__ void glds16(const void* gsrc, unsigned lds_dst) { unsigned keep;
    asm volatile("s_mov_b32 %0, m0\n\ts_mov_b32 m0, %2\n\ts_nop 0\n\tglobal_load_lds_dwordx4 %1, off\n\ts_mov_b32 m0, %0" : "=&s"(keep) : "v"(gsrc), "s"(lds_dst) : "memory"); }
__device__ __forceinline__ void glds4(const void* gsrc, unsigned lds_dst) { unsigned keep;
    asm volatile("s_mov_b32 %0, m0\n\ts_mov_b32 m0, %2\n\ts_nop 0\n\tglobal_load_lds_dword %1, off\n\ts_mov_b32 m0, %0" : "=&s"(keep) : "v"(gsrc), "s"(lds_dst) : "memory"); }
__device__ __forceinline__ float max3f(float a, float b, float c) { float r; asm("v_max3_f32 %0, %1, %2, %3" : "=v"(r) : "v"(a), "v"(b), "v"(c)); return r; }
__device__ __forceinline__ float max2f(float a, float b) { float r; asm("v_max_f32_e32 %0, %1, %2" : "=v"(r) : "v"(a), "v"(b)); return r; }
__device__ __forceinline__ float fadd_s(float a, float b) { float r; asm("v_add_f32_e32 %0, %1, %2" : "=v"(r) : "v"(a), "v"(b)); return r; }
__device__ __forceinline__ float fsub_s(float a, float b) { float r; asm("v_sub_f32_e32 %0, %1, %2" : "=v"(r) : "v"(a), "v"(b)); return r; }
typedef __bf16 bf16x2_t __attribute__((ext_vector_type(2)));
__device__ __forceinline__ unsigned cvtpk_s(float lo, float hi) { f32x2 v = {lo, hi}; bf16x2_t b = __builtin_convertvector(v, bf16x2_t); return __builtin_bit_cast(unsigned, b); }
#define WAIT_BAR(N) asm volatile("s_waitcnt vmcnt(" #N ") lgkmcnt(0)\n\ts_barrier" ::: "memory")

__device__ __forceinline__ void qkt(f32x16& p0, f32x16& p1, const char* Kslot, const bf16x8* qr, const f32x16& negm, int r32, int hi) {
    const char* kb = Kslot + hi * 1024 + r32 * 16;
#pragma unroll
    for (int d0 = 0; d0 < 4; ++d0) {
        const bf16x8 b0 = *reinterpret_cast<const bf16x8*>(kb + d0 * 2048);
        const bf16x8 b1 = *reinterpret_cast<const bf16x8*>(kb + d0 * 2048 + 512);
        if (d0 == 0) { p0 = __builtin_amdgcn_mfma_f32_32x32x16_bf16(b0, qr[0], negm, 0, 0, 0); p1 = __builtin_amdgcn_mfma_f32_32x32x16_bf16(b1, qr[0], negm, 0, 0, 0); }
        else { p0 = __builtin_amdgcn_mfma_f32_32x32x16_bf16(b0, qr[d0], p0, 0, 0, 0); p1 = __builtin_amdgcn_mfma_f32_32x32x16_bf16(b1, qr[d0], p1, 0, 0, 0); } }
}
typedef LAS const char* lds_cptr;
typedef short v4i16_t __attribute__((ext_vector_type(4)));
__device__ __forceinline__ void kload8(bf16x8* kf, lds_cptr kp) {
    kf[0] = *(const LAS bf16x8*)(kp);        kf[1] = *(const LAS bf16x8*)(kp + 512);
    kf[2] = *(const LAS bf16x8*)(kp + 2048); kf[3] = *(const LAS bf16x8*)(kp + 2560);
    kf[4] = *(const LAS bf16x8*)(kp + 4096); kf[5] = *(const LAS bf16x8*)(kp + 4608);
    kf[6] = *(const LAS bf16x8*)(kp + 6144); kf[7] = *(const LAS bf16x8*)(kp + 6656);
}
__device__ __forceinline__ void kload2(bf16x8* kf, lds_cptr kp, int j) { kf[2 * j] = *(const LAS bf16x8*)(kp + j * 2048); kf[2 * j + 1] = *(const LAS bf16x8*)(kp + j * 2048 + 512); }
__device__ __forceinline__ s16x4 vtr(lds_cptr p) { return __builtin_bit_cast(s16x4, __builtin_amdgcn_ds_read_tr16_b64_v4i16((LAS v4i16_t*)p)); }
__device__ __forceinline__ float rowmax(const f32x16& p0, const f32x16& p1) {
    float a = max3f(p0[0], p0[1], p1[0]), b = max3f(p0[2], p0[3], p1[1]); a = max3f(a, p1[2], p1[3]);
#pragma unroll
    for (int r = 4; r < 16; r += 4) { a = max3f(a, p0[r], p0[r + 1]); b = max3f(b, p0[r + 2], p0[r + 3]); a = max3f(a, p1[r], p1[r + 1]); b = max3f(b, p1[r + 2], p1[r + 3]); }
    const float m = max2f(a, b);
    auto rr = __builtin_amdgcn_permlane32_swap(__float_as_uint(m), __float_as_uint(m), false, false);
    return max2f(__uint_as_float(rr[0]), __uint_as_float(rr[1]));
}
__device__ __forceinline__ void pv(f32x16* o, int vb, bf16x8 pa0, bf16x8 pa1, bf16x8 pa2, bf16x8 pa3) {
#pragma unroll
    for (int d0 = 0; d0 < 2; ++d0) { s16x4 lo[4], hi[4];
#pragma unroll
        for (int ks = 0; ks < 4; ++ks) {
            asm volatile("ds_read_b64_tr_b16 %0,%1 offset:%c2" : "=&v"(lo[ks]) : "v"(vb), "i"(d0 * 4096 + ks * 1024) : "memory");
            asm volatile("ds_read_b64_tr_b16 %0,%1 offset:%c2" : "=&v"(hi[ks]) : "v"(vb), "i"(d0 * 4096 + ks * 1024 + 512) : "memory"); }
        asm volatile("s_waitcnt lgkmcnt(0)" ::: "memory"); SBAR();
#define PK(k) (bf16x8){lo[k][0], lo[k][1], lo[k][2], lo[k][3], hi[k][0], hi[k][1], hi[k][2], hi[k][3]}
        o[d0] = __builtin_amdgcn_mfma_f32_32x32x16_bf16(pa0, PK(0), o[d0], 0, 0, 0);
        o[d0] = __builtin_amdgcn_mfma_f32_32x32x16_bf16(pa1, PK(1), o[d0], 0, 0, 0);
        o[d0] = __builtin_amdgcn_mfma_f32_32x32x16_bf16(pa2, PK(2), o[d0], 0, 0, 0);
        o[d0] = __builtin_amdgcn_mfma_f32_32x32x16_bf16(pa3, PK(3), o[d0], 0, 0, 0);
#undef PK
    }
}
__device__ __forceinline__ void apply_mask(f32x16& p0, f32x16& p1, unsigned w0, unsigned w1, float mh) {
#pragma unroll
    for (int r = 0; r < 16; ++r) { const int c = (r & 3) + 8 * (r >> 2);
        const unsigned m0 = (unsigned)__builtin_amdgcn_sbfe((int)w0, c, 1), m1 = (unsigned)__builtin_amdgcn_sbfe((int)w1, c, 1);
        p0[r] = __uint_as_float((__float_as_uint(p0[r] - mh) & m0) | (0xff800000u & ~m0));
        p1[r] = __uint_as_float((__float_as_uint(p1[r] - mh) & m1) | (0xff800000u & ~m1)); }
}
__device__ __forceinline__ void apply_bias(f32x16& p0, f32x16& p1, lds_cptr bp) {
#pragma unroll
    for (int r = 0; r < 16; ++r) { const int c = (r & 3) + 8 * (r >> 2);
        p0[r] += *(const LAS float*)(bp + 4 * c); p1[r] += *(const LAS float*)(bp + 4 * c + 128); }
}

#ifdef ABL_NOBIAS
#define ABL_NOBIAS_V 1
#else
#define ABL_NOBIAS_V 0
#endif
#ifndef ATTN_THRL
#define ATTN_THRL 8
#endif
__device__ __forceinline__ void attn_unit(int b, int h, int qb, const bf16_t* Q, const bf16_t* __restrict__ K, const bf16_t* __restrict__ V, bf16_t* O,
                                          const unsigned* __restrict__ mask, const float* __restrict__ rel_bias, char* shm) {
    constexpr int THRL = ATTN_THRL;
    const int tid = threadIdx.x, lane = tid & 63, r32 = lane & 31, hi = lane >> 5; const int wid = __builtin_amdgcn_readfirstlane(tid >> 6);
    const long rowbase = (long)b * SEQ; const int q0 = qb * QB; const int g = h >> 2;
    const bf16_t* Qw = Q + (rowbase + q0 + wid * QBLK) * QP + h * D;
    const bf16_t* Kh = K + rowbase * KP + g * D; const bf16_t* Vh = V + rowbase * VP + g * D;
    const unsigned lds0 = (unsigned)(uintptr_t)shm;
    float* wsf = (float*)(shm + LDS_WS) + wid * 64;
    const bf16_t* ksrc = Kh + (long)lane * KP + wid * 8;
    const bf16_t* vsrc = Vh + (long)(16 * (wid & 3) + (lane >> 2)) * VP + (wid >> 2) * 32 + (lane & 3) * 8;
    const unsigned* msrc = mask + ((size_t)b * 64 * SEQ + q0 + wid * QBLK) * 2 + lane;
    const unsigned kdst = lds0 + LDS_K + wid * 1024, vdst = lds0 + LDS_V + wid * 1024, mdst = lds0 + LDS_M + wid * 256;
#define DMA_K(t, slot) glds16(ksrc + (long)(t) * KVBLK * KP, (unsigned)__builtin_amdgcn_readfirstlane(kdst + (slot)))
#define DMA_V(t, slot) glds16(vsrc + (long)(t) * KVBLK * VP, (unsigned)__builtin_amdgcn_readfirstlane(vdst + (slot)))
#define DMA_M(t, slot) glds4(msrc + (size_t)(t) * SEQ * 2, (unsigned)__builtin_amdgcn_readfirstlane(mdst + ((slot) >> 2)))
    const int vb0 = (int)(lds0 + LDS_V) + ((lane >> 4) & 1) * 32 + (lane & 3) * 8 + (4 * hi + ((lane & 15) >> 2)) * 64;
    const char* Kbase = shm + LDS_K; bf16x8 kf[8];
    const lds_cptr shm3 = (lds_cptr)shm; const lds_cptr kp0 = shm3 + LDS_K + hi * 1024 + r32 * 16; const lds_cptr vp0 = shm3 + LDS_V + ((lane >> 4) & 1) * 32 + (lane & 3) * 8 + (4 * hi + ((lane & 15) >> 2)) * 64;
    const lds_cptr mp0 = shm3 + LDS_M + wid * 256 + r32 * 8;
    const int NT = (q0 + QB) / KVBLK;
    { float* TR = (float*)(shm + LDS_BT); const float cfar = rel_bias[31 * 8 + h];
      for (int j = tid; j < BT_N; j += 512) { const int d = 447 - j; float v = 0.f;
          if (d >= 0 && d < 113) { int bk;
              if (d < 16) bk = d; else { bk = 16 + (d >= 19) + (d >= 21) + (d >= 24) + (d >= 27) + (d >= 31) + (d >= 35) + (d >= 40) + (d >= 46) + (d >= 52) + (d >= 59) + (d >= 67) + (d >= 77) + (d >= 87) + (d >= 99); }
              v = (rel_bias[bk * 8 + h] - cfar) * LOG2E; }
          TR[j] = v; } }
    DMA_K(0, 0); DMA_V(0, 0); DMA_K(1, SLOTB); DMA_M(0, 0); DMA_M(1, SLOTB);
    bf16x8 qr[4];
#pragma unroll
    for (int d0 = 0; d0 < 4; ++d0) qr[d0] = *reinterpret_cast<const bf16x8*>(&Qw[(long)r32 * QP + d0 * 16 + hi * 8]);
    float mhat = 0.f, l_reg = 0.f; f32x16 o[2]; o[0] = f32x16{}; o[1] = f32x16{}; const f32x16 zero16 = f32x16{};
    const int qrel = wid * QBLK + r32;
#define BIASP(t) (shm3 + LDS_BT + 4 * (447 - qrel + 4 * hi - 64 * (NT - 4 - (t))))
    bool resc = false;
#define START(P0, P1) do { const float rm = rowmax(P0, P1); resc = false; \
    { const float dl = __builtin_fmaxf(rm, -256.f); mhat = fadd_s(mhat, dl); \
      _Pragma("unroll") for (int r = 0; r < 16; ++r) { P0[r] = fsub_s(P0[r], dl); P1[r] = fsub_s(P1[r], dl); } \
      } \
    _Pragma("unroll") for (int r = 0; r < 16; ++r) P0[r] = __builtin_amdgcn_exp2f(P0[r]); } while (0)
#define RESC() do { if (resc) { asm volatile("s_waitcnt lgkmcnt(0)" ::: "memory"); \
      _Pragma("unroll") for (int d_ = 0; d_ < 2; ++d_) _Pragma("unroll") for (int r = 0; r < 16; ++r) o[d_][r] *= wsf[crow(r, hi)]; } } while (0)
    f32x16 pA0, pA1, pB0, pB1;
    int sl_prev = 0, sl_cur = 0, sl_next = SLOTB;
#define ROT() do { sl_prev = sl_cur; sl_cur = sl_next; sl_next = (sl_next == (NSLOT - 1) * SLOTB) ? 0 : sl_next + SLOTB; } while (0)
    DMA_K(2, 2 * SLOTB);
    WAIT_BAR(3);
    u32x2 mw = *(const LAS u32x2*)(mp0);
    qkt(pA0, pA1, Kbase, qr, zero16, r32, hi); asm volatile("s_nop 15\n\ts_nop 7" : "+v"(pA0), "+v"(pA1));
    apply_mask(pA0, pA1, mw.x >> (4 * hi), mw.y >> (4 * hi), 0.f);
#ifndef ABL_NOBIAS
    if (NT <= 7) apply_bias(pA0, pA1, BIASP(0));
#endif
    START(pA0, pA1);
    _Pragma("unroll") for (int r = 0; r < 16; ++r) pA1[r] = __builtin_amdgcn_exp2f(pA1[r]);
    WAIT_BAR(0);
    DMA_K(3, 0); DMA_V(1, SLOTB); DMA_M(2, 2 * SLOTB);
    ROT();
    kload8(kf, kp0 + sl_cur);
    WAIT_BAR(3);
    s16x4 vlo[8], vhi[8]; u32x4 pw0, pw1, pw2, pw3;
#define PKW(P, B) cvtpk_s(P[B], P[B + 1])
#define PAF(k) __builtin_bit_cast(bf16x8, pw##k)
#define VFR(i) (bf16x8){vlo[i][0], vlo[i][1], vlo[i][2], vlo[i][3], vhi[i][0], vhi[i][1], vhi[i][2], vhi[i][3]}
#define PIN(x) asm volatile("" : "+v"(x))
#define MX3(a, b, c) __builtin_fmaxf(__builtin_fmaxf((a), (b)), (c))
#define GAPA(MF, A0, A1, A2, A3, W0, W1, PW) do { MF; sacc += A0; sacc += A1; sacc += A2; sacc += A3; PIN(sacc); W0; W1; PIN(PW); SBAR(); } while (0)
#define EX(v) __builtin_amdgcn_exp2f(v)
#define GAPB(MF, X, B) do { MF; X[B] = EX(X[B]); X[B + 1] = EX(X[B + 1]); X[B + 2] = EX(X[B + 2]); X[B + 3] = EX(X[B + 3]); PIN(X); SBAR(); } while (0)
#define VRD(i) do { vlo[i] = vtr(vp_ + (((i) >> 2) * 4096 + ((i) & 3) * 1024)); vhi[i] = vtr(vp_ + (((i) >> 2) * 4096 + ((i) & 3) * 1024 + 512)); } while (0)
#define KRD(G, j) do { if (G) { kload2(kf, kp0 + sl_next, j); SBAR(); } } while (0)
#define STEP(C0, C1, P0, P1, t, GK, GV, GM, GL, GB) do { SBAR(); \
    const lds_cptr vp_ = vp0 + sl_prev; \
    const u32x2 mw_ = *(const LAS u32x2*)(mp0 + (sl_cur >> 2)); \
    VRD(0); SBAR(); float sacc = (P0[0] + P0[1]); \
    GAPA(C0 = __builtin_amdgcn_mfma_f32_32x32x16_bf16(kf[0], qr[0], zero16, 0, 0, 0), P0[2], P0[3], P0[4], P0[5],     pw0[0] = PKW(P0, 0), pw0[1] = PKW(P0, 2), pw0); \
    VRD(4); SBAR(); GAPA(C1 = __builtin_amdgcn_mfma_f32_32x32x16_bf16(kf[1], qr[0], zero16, 0, 0, 0), P0[6], P0[7], P0[8], P0[9],     pw0[2] = PKW(P0, 4), pw0[3] = PKW(P0, 6), pw0); \
    VRD(1); SBAR(); GAPA(C0 = __builtin_amdgcn_mfma_f32_32x32x16_bf16(kf[2], qr[1], C0, 0, 0, 0),   P0[10], P0[11], P0[12], P0[13], pw1[0] = PKW(P0, 8), pw1[1] = PKW(P0, 10), pw1); \
    VRD(5); SBAR(); GAPA(C1 = __builtin_amdgcn_mfma_f32_32x32x16_bf16(kf[3], qr[1], C1, 0, 0, 0),   P0[14], P0[15], P1[0], P1[1],   pw1[2] = PKW(P0, 12), pw1[3] = PKW(P0, 14), pw1); \
    VRD(2); SBAR(); GAPA(C0 = __builtin_amdgcn_mfma_f32_32x32x16_bf16(kf[4], qr[2], C0, 0, 0, 0),   P1[2], P1[3], P1[4], P1[5],     pw2[0] = PKW(P1, 0), pw2[1] = PKW(P1, 2), pw2); \
    VRD(6); SBAR(); GAPA(C1 = __builtin_amdgcn_mfma_f32_32x32x16_bf16(kf[5], qr[2], C1, 0, 0, 0),   P1[6], P1[7], P1[8], P1[9],     pw2[2] = PKW(P1, 4), pw2[3] = PKW(P1, 6), pw2); \
    VRD(3); SBAR(); GAPA(C0 = __builtin_amdgcn_mfma_f32_32x32x16_bf16(kf[6], qr[3], C0, 0, 0, 0),   P1[10], P1[11], P1[12], P1[13], pw3[0] = PKW(P1, 8), pw3[1] = PKW(P1, 10), pw3); \
    VRD(7); SBAR(); GAPA(C1 = __builtin_amdgcn_mfma_f32_32x32x16_bf16(kf[7], qr[3], C1, 0, 0, 0),   P1[14], P1[15], 0.f, 0.f,       pw3[2] = PKW(P1, 12), pw3[3] = PKW(P1, 14), pw3); \
    l_reg += sacc; \
    if (GK) { DMA_K((t) + 3, sl_cur); } if (GV) { DMA_V((t) + 1, sl_next); } if (GM) { DMA_M((t) + 2, sl_prev); } \
    apply_mask(C0, C1, mw_.x >> (4 * hi), mw_.y >> (4 * hi), mhat); \
    if (GB && !ABL_NOBIAS_V) { apply_bias(C0, C1, BIASP(t)); } \
    { float a = MX3(C0[0], C0[1], C1[0]), b = MX3(C0[2], C0[3], C1[1]); a = MX3(a, C1[2], C1[3]); \
      _Pragma("unroll") for (int r = 4; r < 16; r += 4) { a = MX3(a, C0[r], C0[r + 1]); b = MX3(b, C0[r + 2], C0[r + 3]); a = MX3(a, C1[r], C1[r + 1]); b = MX3(b, C1[r + 2], C1[r + 3]); } \
      float rm = __builtin_fmaxf(a, b); { auto rr = __builtin_amdgcn_permlane32_swap(__float_as_uint(rm), __float_as_uint(rm), false, false); rm = __builtin_fmaxf(__uint_as_float(rr[0]), __uint_as_float(rr[1])); } \
      resc = false; \
      if (__builtin_expect(__any(rm > (float)THRL), 0)) { const float dl = __builtin_fmaxf(rm, 0.f); mhat += dl; \
        _Pragma("unroll") for (int r = 0; r < 16; ++r) { C0[r] -= dl; C1[r] -= dl; } \
        const float f = __builtin_amdgcn_exp2f(-dl); l_reg *= f; if (hi == 0) wsf[r32] = f; resc = true; } } \
    SBAR(); \
    GAPB(o[0] = __builtin_amdgcn_mfma_f32_32x32x16_bf16(PAF(0), VFR(0), o[0], 0, 0, 0), C0, 0); \
    GAPB(o[1] = __builtin_amdgcn_mfma_f32_32x32x16_bf16(PAF(0), VFR(4), o[1], 0, 0, 0), C0, 4); \
    KRD(GL, 0); GAPB(o[0] = __builtin_amdgcn_mfma_f32_32x32x16_bf16(PAF(1), VFR(1), o[0], 0, 0, 0), C0, 8); \
    KRD(GL, 1); GAPB(o[1] = __builtin_amdgcn_mfma_f32_32x32x16_bf16(PAF(1), VFR(5), o[1], 0, 0, 0), C0, 12); \
    KRD(GL, 2); GAPB(o[0] = __builtin_amdgcn_mfma_f32_32x32x16_bf16(PAF(2), VFR(2), o[0], 0, 0, 0), C1, 0); \
    KRD(GL, 3); GAPB(o[1] = __builtin_amdgcn_mfma_f32_32x32x16_bf16(PAF(2), VFR(6), o[1], 0, 0, 0), C1, 4); \
    GAPB(o[0] = __builtin_amdgcn_mfma_f32_32x32x16_bf16(PAF(3), VFR(3), o[0], 0, 0, 0), C1, 8); \
    GAPB(o[1] = __builtin_amdgcn_mfma_f32_32x32x16_bf16(PAF(3), VFR(7), o[1], 0, 0, 0), C1, 12); \
    } while (0)
    int t = 1;
    for (; t + 7 < NT; t += 2) {
        STEP(pB0, pB1, pA0, pA1, t, true, true, true, true, false);     WAIT_BAR(3); RESC(); ROT();
        STEP(pA0, pA1, pB0, pB1, t + 1, true, true, true, true, false); WAIT_BAR(3); RESC(); ROT();
    }
#define ENDW(tt) do { if ((tt) + 3 < NT) { WAIT_BAR(3); } else if ((tt) + 2 < NT) { WAIT_BAR(2); } else { WAIT_BAR(0); } } while (0)
    for (; t + 1 < NT; t += 2) {
        STEP(pB0, pB1, pA0, pA1, t, (t + 3 < NT), (t + 1 < NT), (t + 2 < NT), (t + 1 < NT), (t + 7 >= NT));         ENDW(t);     RESC(); ROT();
        STEP(pA0, pA1, pB0, pB1, t + 1, (t + 4 < NT), (t + 2 < NT), (t + 3 < NT), (t + 2 < NT), (t + 8 >= NT));     ENDW(t + 1); RESC(); ROT();
    }
    STEP(pB0, pB1, pA0, pA1, NT - 1, false, false, false, false, true); RESC();
    { float sacc = pB0[0] + pB0[1]; _Pragma("unroll") for (int r = 2; r < 16; ++r) sacc += pB0[r]; _Pragma("unroll") for (int r = 0; r < 16; ++r) sacc += pB1[r]; l_reg += sacc;
      pw0 = (u32x4){PKW(pB0, 0), PKW(pB0, 2), PKW(pB0, 4), PKW(pB0, 6)}; pw1 = (u32x4){PKW(pB0, 8), PKW(pB0, 10), PKW(pB0, 12), PKW(pB0, 14)}; pw2 = (u32x4){PKW(pB1, 0), PKW(pB1, 2), PKW(pB1, 4), PKW(pB1, 6)}; pw3 = (u32x4){PKW(pB1, 8), PKW(pB1, 10), PKW(pB1, 12), PKW(pB1, 14)};
      SBAR(); pv(o, vb0 + sl_cur, PAF(0), PAF(1), PAF(2), PAF(3)); }
#undef PKW
#undef PAF
#undef VFR
#undef PIN
#undef MX3
#undef GAPA
#undef GAPB
#undef EX
#undef VRD
#undef KRD
#undef STEP
#undef ENDW
    { auto rr = __builtin_amdgcn_permlane32_swap(__float_as_uint(l_reg), __float_as_uint(l_reg), false, false); l_reg = __uint_as_float(rr[0]) + __uint_as_float(rr[1]); }
    if (hi == 0) wsf[32 + r32] = l_reg; asm volatile("s_waitcnt lgkmcnt(0)" ::: "memory");
    float rli[16];
#pragma unroll
    for (int r = 0; r < 16; ++r) rli[r] = __builtin_amdgcn_rcpf(wsf[32 + crow(r, hi)]);
    bf16_t* Ow = O + (rowbase + q0 + wid * QBLK) * OP + h * D;
    { bf16_t* stg = (bf16_t*)(shm + LDS_OST) + wid * 2048;
#pragma unroll
      for (int r = 0; r < 16; ++r) { const int orow = crow(r, hi);
#pragma unroll
          for (int d0 = 0; d0 < 2; ++d0) stg[orow * 64 + d0 * 32 + r32] = (bf16_t)f2bf(o[d0][r] * rli[r]
#ifdef ABL_NOATTN
              * 0.f
#endif
              ); }
      asm volatile("s_waitcnt lgkmcnt(0)" ::: "memory");
#pragma unroll
      for (int i = 0; i < 4; ++i) { const int row = i * 8 + (lane >> 3), ch = lane & 7; const u32x4 v = *(const u32x4*)(stg + row * 64 + ch * 8); *(u32x4*)(Ow + (long)row * OP + ch * 8) = v; } }
    asm volatile("s_waitcnt lgkmcnt(0)\n\ts_barrier" ::: "memory");
#undef DMA_K
#undef DMA_V
#undef DMA_M
#undef START
#undef RESC
#undef ROT
#undef BIASP
}
#undef SBAR
#undef WAIT_BAR
}
constexpr size_t MiB = 1u << 20;
constexpr size_t WS_CTL = 0, CTL_ZERO_BYTES = 1 * MiB;
constexpr size_t WS_MOD = 1 * MiB;
constexpr size_t WS_ROT = 2 * MiB;
constexpr size_t WS_TOPE = 4 * MiB;
constexpr size_t WS_GATE = WS_TOPE + 512 * 1024;
constexpr size_t WS_RANK = 5 * MiB;
constexpr size_t WS_POS = WS_RANK + 512 * 1024;
constexpr size_t WS_ROWTOK = 6 * MiB;
constexpr size_t WS_ROWGATE = 7 * MiB;
constexpr size_t WS_BLKEXP = 8 * MiB;
constexpr size_t WS_ROWSCALE = 9 * MiB;
constexpr size_t WS_WIN = 10 * MiB;
constexpr size_t WS_WOUT = 17 * MiB;
constexpr size_t WS_WGU = 20 * MiB;
constexpr size_t WS_SWGU = 100 * MiB;
constexpr size_t WS_WD = 148 * MiB;
constexpr size_t WS_SWD = 101 * MiB;
constexpr size_t WS_WINQ = 102 * MiB;
constexpr size_t WS_SWIN = 106 * MiB;
constexpr size_t WS_SH = 107 * MiB;
constexpr size_t WS_HQ = 108 * MiB;
constexpr size_t WS_X1 = 212 * MiB;
constexpr size_t WS_H2 = 340 * MiB;
constexpr size_t WS_STOK = 380 * MiB;
constexpr size_t WS_ACT = 404 * MiB;
constexpr size_t WS_Y = 676 * MiB;
constexpr size_t WS_END = 948 * MiB;
constexpr size_t WS_H = 404 * MiB;
constexpr size_t WS_QA = 468 * MiB, WS_KA = 500 * MiB, WS_VA = 508 * MiB, WS_QI = 516 * MiB, WS_KIW = 532 * MiB;
constexpr size_t WS_QR = 540 * MiB, WS_KR = 572 * MiB, WS_VR = 604 * MiB, WS_GR = 636 * MiB;
constexpr size_t WS_MIX = 468 * MiB;
constexpr size_t WS_MASK = 668 * MiB;
constexpr size_t WS_U = 684 * MiB;
constexpr size_t WS_S = 748 * MiB;
static_assert(WS_S + 32 * MiB <= WS_END, "ws map");
constexpr int CW_BAR = 4096;
constexpr int CW_QUEUE = 2048;
constexpr int CW_CNT = 1024;
constexpr int CW_AMAXIN = 240000;
constexpr int CW_AMAXD = 196608;
constexpr int CW_AMAX = 131072;

constexpr int NWAVES = 8;
constexpr int LDS_BYTES = 160 * 1024;

#define XB_TMO      128
#define XB_XCNT(j)  (256  + 64 * (j))
#define XB_XSUB(j)  (1280 + 64 * (j))
#define XB_XGEN(j)  (2304 + 64 * (j))
#define XB_TOP      3328
#define XB_TOPGEN   3392
#define XCD_BAR_WORDS 3456
#define XB_SPIN_CAP (1u << 22)
__device__ __forceinline__ unsigned xb_ld(unsigned* p)              { return __hip_atomic_load(p, __ATOMIC_RELAXED, __HIP_MEMORY_SCOPE_AGENT); }
__device__ __forceinline__ unsigned xb_add(unsigned* p, unsigned v) { return __hip_atomic_fetch_add(p, v, __ATOMIC_RELAXED, __HIP_MEMORY_SCOPE_AGENT); }
__device__ __forceinline__ unsigned xb_xcc_id() { return (unsigned)__builtin_amdgcn_s_getreg((3 << 11) | 20) & 0xFu; }
#define XB_SPIN(cond, bar) do { unsigned _sp = 0; while (cond) { __builtin_amdgcn_s_sleep(1); \
    if ((++_sp & 255u) == 0u) { if (xb_ld(&(bar)[XB_TMO])) break; if (_sp > XB_SPIN_CAP) { atomicAdd(&(bar)[XB_TMO], 1u); break; } } } } while (0)
struct XcdBarrier { unsigned* bar; unsigned x; volatile LAS unsigned* st; };
__device__ __forceinline__ XcdBarrier xcd_barrier_post(unsigned* bar, volatile LAS unsigned* st) {
    XcdBarrier b; b.bar = bar; b.x = xb_xcc_id(); b.st = st;
    if (threadIdx.x == 0) (void)xb_add(&bar[XB_XCNT(b.x)], 1u);
    return b;
}
__device__ __forceinline__ void xcd_barrier_complete(unsigned* bar, unsigned x, unsigned& nloc, unsigned& nx) {
    const unsigned G = gridDim.x * gridDim.y * gridDim.z;
    unsigned sum, cnt, mine, sp = 0u;
    for (;;) {
        sum = 0u; cnt = 0u; mine = 0u;
#pragma unroll
        for (unsigned j = 0; j < 16; ++j) { const unsigned c = xb_ld(&bar[XB_XCNT(j)]); sum += c; cnt += (c > 0u) ? 1u : 0u; mine = (j == x) ? c : mine; }
        if (sum == G) break;
        __builtin_amdgcn_s_sleep(1);
        if ((++sp & 255u) == 0u) { if (xb_ld(&bar[XB_TMO])) break; if (sp > XB_SPIN_CAP) { atomicAdd(&bar[XB_TMO], 1u); break; } }
    }
    nloc = mine > 0u ? mine : 1u; nx = cnt > 0u ? cnt : 1u;
}
__device__ __forceinline__ void xcd_barrier(const XcdBarrier& b) {
    asm volatile("s_waitcnt vmcnt(0)" ::: "memory");
    __syncthreads();
    if (threadIdx.x == 0) {
        unsigned* bar = b.bar;
        __builtin_amdgcn_s_waitcnt(0);
        unsigned nloc = b.st[0], nx = b.st[1];
        if (nloc == 0u) { xcd_barrier_complete(bar, b.x, nloc, nx); b.st[0] = nloc; b.st[1] = nx; }
        const unsigned old = xb_add(&bar[XB_XSUB(b.x)], 1u);
        const unsigned gen = old / nloc;
        if (old + 1u == (gen + 1u) * nloc) {
            __builtin_amdgcn_fence(__ATOMIC_RELEASE, "agent");
            asm volatile("s_waitcnt vmcnt(0)" ::: "memory");
            const unsigned og = xb_add(&bar[XB_TOP], 1u);
            const unsigned tg = og / nx;
            if (og + 1u == (tg + 1u) * nx) xb_add(&bar[XB_TOPGEN], 1u);
            else XB_SPIN(xb_ld(&bar[XB_TOPGEN]) == tg, bar);
            __builtin_amdgcn_fence(__ATOMIC_ACQUIRE, "agent");
            xb_add(&bar[XB_XGEN(b.x)], 1u);
            asm volatile("s_waitcnt vmcnt(0)" ::: "memory");
        } else {
            XB_SPIN(xb_ld(&bar[XB_XGEN(b.x)]) == gen, bar);
            __builtin_amdgcn_fence(__ATOMIC_ACQUIRE, "agent");
            asm volatile("s_waitcnt vmcnt(0)" ::: "memory");
        }
    }
    __syncthreads();
}

struct Frame {
    unsigned char* ws; int tid, lane, wave, vcu, G;
    const float *x, *c, *rel_bias, *w_ada, *b_ada, *w_in, *ret_g, *w_out, *ln1_g, *ln1_b, *w_router, *b_router, *w_gu, *b_gu, *w_d, *b_d, *ln2_g, *ln2_b;
    float* out;
};
__device__ __forceinline__ float wave_sum(float v) {
#pragma unroll
    for (int o = 1; o < 64; o <<= 1) v += __shfl_xor(v, o);
    return v;
}
__device__ __forceinline__ float wave_max(float v) {
#pragma unroll
    for (int o = 1; o < 64; o <<= 1) v = fmaxf(v, __shfl_xor(v, o));
    return v;
}
#define LDS_WAIT() asm volatile("s_waitcnt lgkmcnt(0)" ::: "memory")
__device__ __forceinline__ void p0_transpose_item(const float* W, int K, int N, int src_col0, bf16_t* WT, int dest_row0, int k0, LAS float* scr, int lane) {
#pragma unroll 8
    for (int i = 0; i < 32; ++i) { const int kk = 2 * i + (lane >> 5); scr[kk * 33 + (lane & 31)] = W[(size_t)(k0 + kk) * N + src_col0 + (lane & 31)]; }
    LDS_WAIT(); asm volatile("" ::: "memory");
    const int c = lane & 7;
#pragma unroll
    for (int j = 0; j < 4; ++j) { const int n = (lane >> 3) + 8 * j; const LAS float* s = scr + (8 * c) * 33 + n;
        u32x4 o; o.x = pk2(s[0 * 33], s[1 * 33]); o.y = pk2(s[2 * 33], s[3 * 33]); o.z = pk2(s[4 * 33], s[5 * 33]); o.w = pk2(s[6 * 33], s[7 * 33]);
        *(u32x4*)(WT + (size_t)(dest_row0 + n) * K + k0 + 8 * c) = o; }
    LDS_WAIT(); asm volatile("" ::: "memory");
}
__device__ __forceinline__ void p0_absmax_item(const float* W  , int N, int n0, int k0, unsigned* amax  , int lane) {
    const float* wp = W + (size_t)(k0 + (lane >> 5)) * N + n0 + (lane & 31);
    float m = 0.f;
#pragma unroll
    for (int i = 0; i < 32; ++i) m = fmaxf(m, fabsf(wp[(size_t)i * 2 * N]));
    { const unsigned u = __float_as_uint(m); auto r = __builtin_amdgcn_permlane32_swap(u, u, false, false); m = fmaxf(__uint_as_float(r[0]), __uint_as_float(r[1])); }
    if (lane < 32) atomicMax(amax + lane, __float_as_uint(m));
}
__device__ __forceinline__ void p1_quant_item(const float* W, int N, float widen, int n0, int k0, signed char* WQ  , const unsigned* amax, float* SW, LAS float* scr, int lane) {
    const float mx = widen * __uint_as_float(amax[lane & 31]); const float inv = mx > 0.f ? 127.0f / mx : 0.f;
    if (k0 == 0 && lane < 32) SW[lane] = mx > 0.f ? mx * (1.0f / 127.0f) : 1.0f;
    const float* wp = W + (size_t)(k0 + (lane >> 5)) * N + n0 + (lane & 31);
#pragma unroll
    for (int i = 0; i < 32; ++i) { const int kk = 2 * i + (lane >> 5); scr[kk * 33 + (lane & 31)] = wp[(size_t)i * 2 * N] * inv; }
    LDS_WAIT(); asm volatile("" ::: "memory");
    const int c = lane & 7;
#pragma unroll
    for (int j = 0; j < 4; ++j) { const int n = (lane >> 3) + 8 * j; const LAS float* sp = scr + (8 * c) * 33 + n;
        int q[8];
#pragma unroll
        for (int t = 0; t < 8; ++t) q[t] = (int)rintf(fminf(fmaxf(sp[t * 33], -127.0f), 127.0f)) & 0xff;
        u32x2 o; o.x = (unsigned)(q[0] | (q[1] << 8) | (q[2] << 16) | (q[3] << 24)); o.y = (unsigned)(q[4] | (q[5] << 8) | (q[6] << 16) | (q[7] << 24));
        *(u32x2*)(WQ + (size_t)n * 1024 + k0 + 8 * c) = o; }
    LDS_WAIT(); asm volatile("" ::: "memory");
}
__device__ __forceinline__ void p1_fp8_item(const float* W  , int n0, int k0, unsigned char* WQ  , const unsigned* amax, float* SW, LAS float* scr, int lane) {
    const float mx = 1.25f * __uint_as_float(amax[lane & 31]); const float inv = mx > 0.f ? 224.0f / mx : 0.f;
    if (k0 == 0 && lane < 32) SW[lane] = mx > 0.f ? mx * (1.0f / 224.0f) : 1.0f;
    const float* wp = W + (size_t)(k0 + (lane >> 5)) * 1024 + n0 + (lane & 31);
#pragma unroll
    for (int i = 0; i < 32; ++i) { const int kk = 2 * i + (lane >> 5); scr[kk * 33 + (lane & 31)] = __builtin_amdgcn_fmed3f(wp[(size_t)i * 2048] * inv, -448.0f, 448.0f); }
    LDS_WAIT(); asm volatile("" ::: "memory");
    const int c = lane & 7;
#pragma unroll
    for (int j = 0; j < 4; ++j) { const int n = (lane >> 3) + 8 * j; const LAS float* sp = scr + (8 * c) * 33 + n;
        int w0 = __builtin_amdgcn_cvt_pk_fp8_f32(sp[0 * 33], sp[1 * 33], 0, false); w0 = __builtin_amdgcn_cvt_pk_fp8_f32(sp[2 * 33], sp[3 * 33], w0, true);
        int w1 = __builtin_amdgcn_cvt_pk_fp8_f32(sp[4 * 33], sp[5 * 33], 0, false); w1 = __builtin_amdgcn_cvt_pk_fp8_f32(sp[6 * 33], sp[7 * 33], w1, true);
        u32x2 o; o.x = (unsigned)w0; o.y = (unsigned)w1;
        *(u32x2*)(WQ + (size_t)n * 1024 + k0 + 8 * c) = o; }
    LDS_WAIT(); asm volatile("" ::: "memory");
}
__device__ __forceinline__ void p0_prologue(Frame& F, LAS unsigned char* lds) {
    LAS float* scr = (LAS float*)(lds + F.wave * 16384);
    const int gw = F.vcu * NWAVES + F.wave, NGW = F.G * NWAVES;
    bf16_t* WinT = (bf16_t*)(F.ws + WS_WIN); bf16_t* WoutT = (bf16_t*)(F.ws + WS_WOUT); unsigned* amaxgu = (unsigned*)(F.ws + WS_CTL) + CW_AMAX; unsigned* amaxd = (unsigned*)(F.ws + WS_CTL) + CW_AMAXD; unsigned* amaxin = (unsigned*)(F.ws + WS_CTL) + CW_AMAXIN;
    if (F.vcu < 96) {
        LAS float* red = (LAS float*)(lds + 32768);
        LAS float* sil = (LAS float*)(lds);
        for (int i = F.tid; i < 8 * DM; i += 512) { const float cv = F.c[i]; sil[i] = cv / (1.f + __expf(-cv)); }
        __syncthreads();
        for (int it = F.vcu; it < 96; it += F.G) {
            const int n = it * 64 + F.lane; float a[8];
#pragma unroll
            for (int b = 0; b < 8; ++b) a[b] = 0.f;
            const float* wp = F.w_ada + (size_t)(F.wave * 128) * 6144 + n;
#pragma unroll 8
            for (int kk = 0; kk < 128; ++kk) {
                const float w = wp[(size_t)kk * 6144];
#pragma unroll
                for (int b = 0; b < 8; ++b) a[b] = fmaf(sil[b * DM + F.wave * 128 + kk], w, a[b]);
            }
#pragma unroll
            for (int b = 0; b < 8; ++b) red[(F.wave * 8 + b) * 64 + F.lane] = a[b];
            __syncthreads();
            { const int b = F.wave; float s = F.b_ada[n];
#pragma unroll
              for (int w = 0; w < 8; ++w) s += red[(w * 8 + b) * 64 + F.lane];
              ((float*)(F.ws + WS_MOD))[b * 6144 + n] = s; }
            __syncthreads();
        }
    }
    {
        float* rc = (float*)(F.ws + WS_ROT); float* rs = rc + SEQ * 64;
        for (int i = (F.vcu * 512 + F.tid); i < SEQ * 64; i += F.G * 512) { const int t = i >> 6, j = i & 63;
            const float inv = 1.0f / powf(10000.0f, (float)(2 * j) / 128.0f); const float ang = (float)t * inv;
            rc[i] = (float)cos((double)ang); rs[i] = (float)sin((double)ang); }
    }
    constexpr int I_IN_A = 34 * 16, I_IN_B = 64 * 16, I_OUT = 32 * 16, I_GU = 32 * 64 * 4, I_D = 32 * 32 * 4, I_PAD = 192;
    constexpr int I_INQ = (24 + 64) * 16;
    constexpr int NITEMS = I_IN_A + I_IN_B + I_OUT + I_GU + I_D + I_PAD + I_INQ;
    for (int it = gw; it < NITEMS; it += NGW) {
        int r = it;
        if (r < I_GU) { const int e = r >> 8, q = r & 255, nb = q >> 2, kb = (q & 3) * 4; const int n0 = 32 * nb;
            const int half = n0 >> 10, nn = n0 & 1023; const int drow = (nn >> 7) * 256 + half * 128 + (nn & 127);
            p0_absmax_item(F.w_gu + (size_t)e * DM * 2048, 2048, n0, 64 * kb, amaxgu + e * 2048 + drow, F.lane); continue; } r -= I_GU;
        if (r < I_IN_A) { const int nb = r >> 4, kb = r & 15; p0_transpose_item(F.w_in, DM, DIN_SRC, 32 * nb, WinT, 32 * nb, 64 * kb, scr, F.lane); continue; } r -= I_IN_A;
        if (r < I_IN_B) { const int nb = r >> 4, kb = r & 15; p0_transpose_item(F.w_in, DM, DIN_SRC, 1092 + 32 * nb, WinT, 1280 + 32 * nb, 64 * kb, scr, F.lane); continue; } r -= I_IN_B;
        if (r < I_OUT) { const int nb = r >> 4, kb = r & 15; p0_transpose_item(F.w_out, DM, DM, 32 * nb, WoutT, 32 * nb, 64 * kb, scr, F.lane); continue; } r -= I_OUT;
        if (r < I_D) { const int e = r >> 7, q = r & 127, nb = q >> 2, kb = (q & 3) * 4;
            p0_absmax_item(F.w_d + (size_t)e * DFF * DM, DM, 32 * nb, 64 * kb, amaxd + e * 1024 + 32 * nb, F.lane); continue; } r -= I_D;
        if (r >= I_PAD) { r -= I_PAD; const int nb = r >> 4, kb = r & 15; const int src = nb < 24 ? 32 * nb : 1092 + 32 * (nb - 24), dst = nb < 24 ? 32 * nb : 1280 + 32 * (nb - 24);
            p0_absmax_item(F.w_in, DIN_SRC, src, 64 * kb, amaxin + dst, F.lane); continue; }
        { const int row = 1088 + r;
          for (int k = F.lane; k < DM; k += 64) WinT[(size_t)row * DM + k] = (row < 1092) ? (bf16_t)f2bf(F.w_in[(size_t)k * DIN_SRC + row]) : (bf16_t)0; }
    }
}
__device__ __forceinline__ void p1_modulate(Frame& F, LAS unsigned char* lds) {
    const int gw = F.vcu * NWAVES + F.wave, NGW = F.G * NWAVES;
    { LAS float* scr = (LAS float*)(lds + F.wave * 16384); signed char* WguQ = (signed char*)(F.ws + WS_WGU); float* SWgu = (float*)(F.ws + WS_SWGU); const unsigned* amaxgu = (const unsigned*)(F.ws + WS_CTL) + CW_AMAX;
      for (int r = gw; r < 32 * 64 * 16; r += NGW) { const int e = r >> 10, q = r & 1023, nb = q >> 4, kb = q & 15; const int n0 = 32 * nb;
          const int half = n0 >> 10, nn = n0 & 1023; const int drow = (nn >> 7) * 256 + half * 128 + (nn & 127);
          p1_quant_item(F.w_gu + (size_t)e * DM * 2048, 2048, 1.25f, n0, 64 * kb, WguQ + ((size_t)e * 2048 + drow) * 1024, amaxgu + e * 2048 + drow, SWgu + e * 2048 + drow, scr, F.lane); }
      { signed char* WinQ = (signed char*)(F.ws + WS_WINQ); float* SWin = (float*)(F.ws + WS_SWIN); const unsigned* amaxin = (const unsigned*)(F.ws + WS_CTL) + CW_AMAXIN;
        for (int r = gw; r < (24 + 64) * 16; r += NGW) { const int nb = r >> 4, kb = r & 15; const int src = nb < 24 ? 32 * nb : 1092 + 32 * (nb - 24), dst = nb < 24 ? 32 * nb : 1280 + 32 * (nb - 24);
            p1_quant_item(F.w_in, DIN_SRC, 1.0f, src, 64 * kb, WinQ + (size_t)dst * 1024, amaxin + dst, SWin + dst, scr, F.lane); } }
      unsigned char* WdQ = (unsigned char*)(F.ws + WS_WD); float* SWd = (float*)(F.ws + WS_SWD); const unsigned* amaxd = (const unsigned*)(F.ws + WS_CTL) + CW_AMAXD;
      for (int r = gw; r < 32 * 32 * 16; r += NGW) { const int e = r >> 9, q = r & 511, nb = q >> 4, kb = q & 15;
          p1_fp8_item(F.w_d + (size_t)e * DFF * DM, 32 * nb, 64 * kb, WdQ + ((size_t)e * 1024 + 32 * nb) * 1024, amaxd + e * 1024 + 32 * nb, SWd + e * 1024 + 32 * nb, scr, F.lane); } }
    const float* mod = (const float*)(F.ws + WS_MOD); bf16_t* H = (bf16_t*)(F.ws + WS_H);
    unsigned* HQ = (unsigned*)(F.ws + WS_HQ); float* SH = (float*)(F.ws + WS_SH);
    for (int m = gw; m < NTOK; m += NGW) {
        const int b = m / SEQ; const f32x4* xr = (const f32x4*)(F.x + (size_t)m * DM) + F.lane;
        const f32x4* sh = (const f32x4*)(mod + (size_t)b * 6144) + F.lane; const f32x4* sc = (const f32x4*)(mod + (size_t)b * 6144 + DM) + F.lane;
        unsigned long long* o8 = (unsigned long long*)(H + (size_t)m * DM) + F.lane;
        f32x4 v[4]; float amx = 0.f;
#pragma unroll
        for (int j = 0; j < 4; ++j) { v[j] = xr[64 * j] * (sc[64 * j] + 1.0f) + sh[64 * j];
            o8[64 * j] = (unsigned long long)pk2(v[j].x, v[j].y) | ((unsigned long long)pk2(v[j].z, v[j].w) << 32);
            amx = fmaxf(fmaxf(amx, fmaxf(fabsf(v[j].x), fabsf(v[j].y))), fmaxf(fabsf(v[j].z), fabsf(v[j].w))); }
        amx = wave_max(amx);
        const float inv = amx > 0.f ? 127.0f / amx : 0.f; unsigned* q8 = HQ + (size_t)m * (DM / 4) + F.lane;
#pragma unroll
        for (int j = 0; j < 4; ++j) q8[64 * j] = (unsigned)(((int)rintf(v[j].x * inv) & 0xff) | (((int)rintf(v[j].y * inv) & 0xff) << 8) | (((int)rintf(v[j].z * inv) & 0xff) << 16) | (((int)rintf(v[j].w * inv) & 0xff) << 24));
        if (F.lane == 0) SH[m] = amx > 0.f ? amx * (1.0f / 127.0f) : 1.0f;
    }
}
__device__ __forceinline__ unsigned sortable(float s) { s = s + 0.0f; const unsigned u = __float_as_uint(s); return (u & 0x80000000u) ? ~u : (u | 0x80000000u); }

__device__ __forceinline__ unsigned wave_max_u32(unsigned v, int lane) {
    v = max(v, (unsigned)__builtin_amdgcn_update_dpp(0, (int)v, 0xB1, 0xF, 0xF, false)); v = max(v, (unsigned)__builtin_amdgcn_update_dpp(0, (int)v, 0x4E, 0xF, 0xF, false));
    v = max(v, (unsigned)__builtin_amdgcn_update_dpp(0, (int)v, 0x141, 0xF, 0xF, false)); v = max(v, (unsigned)__builtin_amdgcn_update_dpp(0, (int)v, 0x140, 0xF, 0xF, false));
    { auto r = __builtin_amdgcn_permlane16_swap(v, v, false, false); v = max(r[0], r[1]); } { auto r = __builtin_amdgcn_permlane32_swap(v, v, false, false); v = max(r[0], r[1]); }
    return v; }
__device__ __forceinline__ unsigned wave_sum_u32(unsigned v, int lane) {
    v += (unsigned)__builtin_amdgcn_update_dpp(0, (int)v, 0xB1, 0xF, 0xF, false); v += (unsigned)__builtin_amdgcn_update_dpp(0, (int)v, 0x4E, 0xF, 0xF, false);
    v += (unsigned)__builtin_amdgcn_update_dpp(0, (int)v, 0x141, 0xF, 0xF, false); v += (unsigned)__builtin_amdgcn_update_dpp(0, (int)v, 0x140, 0xF, 0xF, false);
    { auto r = __builtin_amdgcn_permlane16_swap(v, v, false, false); v = r[0] + r[1]; } { auto r = __builtin_amdgcn_permlane32_swap(v, v, false, false); v = r[0] + r[1]; }
    return v; }
#define CNT_OP(OP, c, a, b) asm volatile("v_cmp_" OP "_u32 vcc, %1, %2\n\tv_addc_co_u32 %0, vcc, 0, %0, vcc" : "+v"(c) : "v"(a), "v"(b) : "vcc")
__device__ __forceinline__ void sel_search(const unsigned (&kk)[64], const int tqw, const int qw, const int nblk, const int lane, LAS unsigned* lmask, const int flags) {
        unsigned lo = 1u, hi = 0xfffffff0u; int clo = tqw + 1, chi = 0;
        if (!(flags & 64))
        { unsigned m = 0, mn = 0xffffffffu;
#pragma unroll
          for (int j = 0; j < 64; ++j) { m = max(m, kk[j]); mn = min(mn, kk[j] - 1u); }
          m = wave_max_u32(m, lane); mn = ~wave_max_u32(~mn, lane);
          hi = __builtin_amdgcn_readfirstlane(m) + 1u; lo = __builtin_amdgcn_readfirstlane(mn) + 1u; }
        int diag_it = 0;
        bool done = (clo <= 256);
        float wlo = 1.0f, whi = 1.0f; int side = 0;
        for (int it = 0; it < ((flags & 8) ? 0 : (flags & 128) ? 4 : (flags & 256) ? 12 : (flags & 512) ? 24 : 128) && (!done || (flags & 128)); ++it) {
            const unsigned width = hi - lo;
            unsigned cand;
            if (it == 0) cand = 0x80001000u;
            else if (it == 1 && hi <= 0x80001000u && lo < 0x80000000u) cand = 0x80000000u;
            else { const float flo = (__logf((float)clo + 0.5f) - 5.545177444f) * wlo, fhi = (__logf((float)chi + 0.5f) - 5.545177444f) * whi; const float fr = flo * __builtin_amdgcn_rcpf(flo - fhi);
                if (width <= 8192u) cand = lo + (unsigned)(fr * (float)width);
                else { const unsigned ul = (lo & 0x80000000u) ? (lo ^ 0x80000000u) : ~lo, uh = (hi & 0x80000000u) ? (hi ^ 0x80000000u) : ~hi;
                    const float fl = __uint_as_float(ul), fh = __uint_as_float(uh); const float fc = fl + fr * (fh - fl);
                    cand = sortable(fc); } }
            cand = max(lo + 1u, min(cand, hi - 1u));
            const unsigned cs = __builtin_amdgcn_readfirstlane(cand);
            unsigned c0_ = 0, c1_ = 0, c2_ = 0, c3_ = 0; int scnt = 0;
#pragma unroll
            for (int j = 0; j < 64; j += 8) { if (j < nblk) {
                unsigned long long m0, m1, m2, m3, m4, m5, m6, m7;
                if ((j & 8) == 0) {
                asm volatile("v_cmp_le_u32_e64 %[m0], %[cs], %[k0]\n\tv_cmp_le_u32_e64 %[m1], %[cs], %[k1]\n\tv_cmp_le_u32_e64 %[m2], %[cs], %[k2]\n\tv_cmp_le_u32_e64 %[m3], %[cs], %[k3]\n\t"
                             "v_cmp_le_u32_e64 %[m4], %[cs], %[k4]\n\tv_cmp_le_u32_e64 %[m5], %[cs], %[k5]\n\tv_cmp_le_u32_e64 %[m6], %[cs], %[k6]\n\tv_cmp_le_u32_e64 %[m7], %[cs], %[k7]\n\t"
                             "v_addc_co_u32_e64 %[c0], %[m0], 0, %[c0], %[m0]\n\tv_addc_co_u32_e64 %[c1], %[m1], 0, %[c1], %[m1]\n\tv_addc_co_u32_e64 %[c2], %[m2], 0, %[c2], %[m2]\n\tv_addc_co_u32_e64 %[c3], %[m3], 0, %[c3], %[m3]\n\t"
                             "v_addc_co_u32_e64 %[c0], %[m4], 0, %[c0], %[m4]\n\tv_addc_co_u32_e64 %[c1], %[m5], 0, %[c1], %[m5]\n\tv_addc_co_u32_e64 %[c2], %[m6], 0, %[c2], %[m6]\n\tv_addc_co_u32_e64 %[c3], %[m7], 0, %[c3], %[m7]"
                             : [c0] "+v"(c0_), [c1] "+v"(c1_), [c2] "+v"(c2_), [c3] "+v"(c3_), [m0] "=&s"(m0), [m1] "=&s"(m1), [m2] "=&s"(m2), [m3] "=&s"(m3), [m4] "=&s"(m4), [m5] "=&s"(m5), [m6] "=&s"(m6), [m7] "=&s"(m7)
                             : [cs] "s"(cs), [k0] "v"(kk[j]), [k1] "v"(kk[j + 1]), [k2] "v"(kk[j + 2]), [k3] "v"(kk[j + 3]), [k4] "v"(kk[j + 4]), [k5] "v"(kk[j + 5]), [k6] "v"(kk[j + 6]), [k7] "v"(kk[j + 7]));
                } else {
                int t0_, t1_, t2_, t3_, t4_, t5_, t6_, t7_;
                asm volatile("v_cmp_le_u32_e64 %[m0], %[cs], %[k0]\n\tv_cmp_le_u32_e64 %[m1], %[cs], %[k1]\n\tv_cmp_le_u32_e64 %[m2], %[cs], %[k2]\n\tv_cmp_le_u32_e64 %[m3], %[cs], %[k3]\n\t"
                             "v_cmp_le_u32_e64 %[m4], %[cs], %[k4]\n\tv_cmp_le_u32_e64 %[m5], %[cs], %[k5]\n\tv_cmp_le_u32_e64 %[m6], %[cs], %[k6]\n\tv_cmp_le_u32_e64 %[m7], %[cs], %[k7]\n\t"
                             "s_bcnt1_i32_b64 %[t0], %[m0]\n\ts_bcnt1_i32_b64 %[t1], %[m1]\n\ts_bcnt1_i32_b64 %[t2], %[m2]\n\ts_bcnt1_i32_b64 %[t3], %[m3]\n\t"
                             "s_bcnt1_i32_b64 %[t4], %[m4]\n\ts_bcnt1_i32_b64 %[t5], %[m5]\n\ts_bcnt1_i32_b64 %[t6], %[m6]\n\ts_bcnt1_i32_b64 %[t7], %[m7]\n\t"
                             "s_add_u32 %[t0], %[t0], %[t1]\n\ts_add_u32 %[t2], %[t2], %[t3]\n\ts_add_u32 %[t4], %[t4], %[t5]\n\ts_add_u32 %[t6], %[t6], %[t7]\n\t"
                             "s_add_u32 %[t0], %[t0], %[t2]\n\ts_add_u32 %[t4], %[t4], %[t6]\n\ts_add_u32 %[t0], %[t0], %[t4]\n\ts_add_u32 %[cnt], %[cnt], %[t0]"
                             : [cnt] "+s"(scnt), [m0] "=&s"(m0), [m1] "=&s"(m1), [m2] "=&s"(m2), [m3] "=&s"(m3), [m4] "=&s"(m4), [m5] "=&s"(m5), [m6] "=&s"(m6), [m7] "=&s"(m7),
                               [t0] "=&s"(t0_), [t1] "=&s"(t1_), [t2] "=&s"(t2_), [t3] "=&s"(t3_), [t4] "=&s"(t4_), [t5] "=&s"(t5_), [t6] "=&s"(t6_), [t7] "=&s"(t7_)
                             : [cs] "s"(cs), [k0] "v"(kk[j]), [k1] "v"(kk[j + 1]), [k2] "v"(kk[j + 2]), [k3] "v"(kk[j + 3]), [k4] "v"(kk[j + 4]), [k5] "v"(kk[j + 5]), [k6] "v"(kk[j + 6]), [k7] "v"(kk[j + 7])
                             : "scc"); } } }
            const int cnt = scnt + (int)__builtin_amdgcn_readfirstlane(wave_sum_u32((c0_ + c1_) + (c2_ + c3_), lane));
            if (cnt >= 256) { lo = cs; clo = cnt; wlo = 1.0f; if (side == 1) whi *= 0.5f; side = 1; }
            else { hi = cs; chi = cnt; whi = 1.0f; if (side == 2) wlo *= 0.5f; side = 2; }
            done = (clo == 256) || (hi - lo <= 1u); ++diag_it;
        }
        if (!(flags & 32)) {
#ifdef ABL_SELALL
          const unsigned thr = 1u;
#else
          const unsigned thr = __builtin_amdgcn_readfirstlane(lo);
#endif
          unsigned mlo = 0u, mhi = 0u;
#pragma unroll
          for (int j = 0; j < 64; ++j) { if (j < nblk) asm volatile("v_cmp_le_u32 vcc, %2, %3\n\ts_nop 1\n\tv_writelane_b32 %0, vcc_lo, %4\n\tv_writelane_b32 %1, vcc_hi, %4" : "+v"(mlo), "+v"(mhi) : "s"(thr), "v"(kk[j]), "i"(j) : "vcc"); }
          int ln = lane; asm volatile("" : "+v"(ln));
          u32x2 w; w.x = mlo; w.y = mhi; *(LAS u32x2*)((LAS unsigned char*)lmask + qw * 512 + ln * 8) = w; }
}
__device__ __forceinline__ int select_item(Frame& F, LAS unsigned char* lds, const int k, bool& staged, unsigned* qctr, volatile LAS unsigned* qslot, int flags, const int qoff) {
    const int b = k >> 8, qblk = 255 - (k & 255);
    unsigned kn_v = 0u; if (F.tid == 0) kn_v = __hip_atomic_fetch_add(qctr, 1u, __ATOMIC_RELAXED, __HIP_MEMORY_SCOPE_AGENT);
    const int lane = F.lane, wid = F.wave, qn = lane & 15, kq = lane >> 4;
    const int t0 = qblk * 16, ntile = qblk + 1;
    const bf16_t* QI = (const bf16_t*)(F.ws + WS_QI); const bf16_t* KIW = (const bf16_t*)(F.ws + WS_KIW);
    LAS unsigned char* kst = lds;
    LAS unsigned* lmask = (LAS unsigned*)(lds + 8 * 16400);
    const size_t rowq = (size_t)b * SEQ + t0 + qn;
    bf16x8 bq[4][2]; float wv[4];
#pragma unroll
    for (int h = 0; h < 4; ++h) {
#pragma unroll
        for (int s = 0; s < 2; ++s) bq[h][s] = *(const bf16x8*)(QI + rowq * 256 + h * 64 + s * 32 + kq * 8);
        wv[h] = 0.5f * bf2f(KIW[rowq * 128 + 64 + h]); }
    unsigned key[32][4];
    int ibase_i = 16 * wid + 4 * kq; asm volatile("" : "+v"(ibase_i));
    const unsigned ibase = (unsigned)ibase_i;
    const int dq = t0 + qn - ibase_i;
    const int dqmin = __builtin_amdgcn_readfirstlane(t0 - (16 * wid + 12));
    const unsigned nidx = 4095u - ibase;
    int fragoff0 = (16 * wid + qn) * 128 + ((kq ^ (qn & 7)) << 4), fragoff1 = (16 * wid + qn) * 128 + (((4 + kq) ^ (qn & 7)) << 4); asm volatile("" : "+v"(fragoff0), "+v"(fragoff1));
    { u32x4 tmp[8];
      int srow = F.tid >> 3; asm volatile("" : "+v"(srow));
      const int spc = F.tid & 7;
      const bf16_t* gsrc0 = KIW + ((size_t)b * SEQ + srow) * 128 + spc * 8;
      LAS unsigned char* ldst0 = kst + srow * 128 + ((spc ^ (srow & 7)) << 4);
      const int nsub = (t0 + 16 + 511) >> 9;
      if (!staged) {
          if (!(flags & 1024))
#pragma unroll
          for (int j = 0; j < 8; ++j) tmp[j] = *(const u32x4*)(gsrc0 + (size_t)j * 64 * 128);
          __syncthreads();
#pragma unroll
          for (int j = 0; j < 8; ++j) *(LAS u32x4*)(ldst0 + j * 8192) = tmp[j];
          __syncthreads();
      }
#pragma unroll
      for (int sb = 0; sb < 8; ++sb) {
          if (sb < nsub) {
              const bool more = (sb + 1 < nsub) && !(flags & 1024);
              if (more) {
#pragma unroll
                  for (int j = 0; j < 8; ++j) tmp[j] = *(const u32x4*)(gsrc0 + (size_t)((sb + 1) * 512 + j * 64) * 128); }
              const LAS unsigned char* kb = kst + (sb & 1) * 65536;
              if (flags & 2048) {
#pragma unroll
                  for (int ii = 0; ii < 4; ++ii)
#pragma unroll
                      for (int r = 0; r < 4; ++r) key[sb * 4 + ii][r] = 0u;
              } else
#pragma unroll
              for (int ii = 0; ii < 4; ++ii) {
                  const int i = sb * 4 + ii;
                  const bf16x8 a0 = *(const LAS bf16x8*)(kb + fragoff0 + 16384 * ii), a1 = *(const LAS bf16x8*)(kb + fragoff1 + 16384 * ii);
                  f32x4 sc = {0.f, 0.f, 0.f, 0.f};
#pragma unroll
                  for (int h = 0; h < 4; ++h) { f32x4 c = {0.f, 0.f, 0.f, 0.f};
                      c = __builtin_amdgcn_mfma_f32_16x16x32_bf16(a0, bq[h][0], c, 0, 0, 0); c = __builtin_amdgcn_mfma_f32_16x16x32_bf16(a1, bq[h][1], c, 0, 0, 0);
#pragma unroll
                      for (int r = 0; r < 4; ++r) sc[r] = fmaf(wv[h], fmaxf(c[r], 0.f), sc[r]); }
#pragma unroll
                  for (int r = 0; r < 4; ++r) { const unsigned u = __float_as_uint(sc[r]);
                      const unsigned sk = u ^ ((unsigned)((int)u >> 31) | 0x80000000u);
                      key[i][r] = (sk & 0xfffff000u) | (nidx - (128u * i + r)); }
                  if (128 * i + 3 > dqmin) {
#pragma unroll
                      for (int r = 0; r < 4; ++r) key[i][r] = (128 * i + r <= dq) ? key[i][r] : 0u; }
              }
              if (more) {
#pragma unroll
                  for (int j = 0; j < 8; ++j) *(LAS u32x4*)(ldst0 + ((sb + 1) & 1) * 65536 + j * 8192) = tmp[j]; }
              __syncthreads();
          } else {
#pragma unroll
              for (int ii = 0; ii < 4; ++ii)
#pragma unroll
                  for (int r = 0; r < 4; ++r) key[sb * 4 + ii][r] = 0u;
          }
      } }
    int knext = 0; u32x4 tmp2[8];
    constexpr int QPITCH = 16384 + 16;
    if (!(flags & 4096)) {
        unsigned kkA[64], kkB[64];
        int lo_ = lane; asm volatile("" : "+v"(lo_)); const LAS unsigned char* src = lds + wid * QPITCH + lo_ * 4;
        int qo = qn; asm volatile("" : "+v"(qo)); const int dsto = (qo & 7) * QPITCH + ibase_i * 4;
        if (F.tid == 0) qslot[0] = kn_v;
        __syncthreads();
        if ((qo >> 3) == 0) { LAS unsigned char* dst = lds + dsto;
#pragma unroll
            for (int i = 0; i < 32; ++i) { u32x4 v; v.x = key[i][0]; v.y = key[i][1]; v.z = key[i][2]; v.w = key[i][3]; *(LAS u32x4*)(dst + 512 * i) = v; } }
        __syncthreads();
#pragma unroll
        for (int j = 0; j < 64; ++j) kkA[j] = *(const LAS unsigned*)(src + 256 * j);
        __syncthreads();
        if ((qo >> 3) == 1) { LAS unsigned char* dst = lds + dsto;
#pragma unroll
            for (int i = 0; i < 32; ++i) { u32x4 v; v.x = key[i][0]; v.y = key[i][1]; v.z = key[i][2]; v.w = key[i][3]; *(LAS u32x4*)(dst + 512 * i) = v; } }
        __syncthreads();
#pragma unroll
        for (int j = 0; j < 64; ++j) kkB[j] = *(const LAS unsigned*)(src + 256 * j);
        knext = (int)qslot[0] - qoff;
        sel_search(kkA, t0 + wid, wid, ((t0 + wid) >> 6) + 1, lane, lmask, flags);
        if (knext < BATCH * 256) { int srow = F.tid; asm volatile("" : "+v"(srow)); const int spc = srow & 7; srow >>= 3;
            const bf16_t* gn = KIW + ((size_t)(knext >> 8) * SEQ + srow) * 128 + spc * 8;
#pragma unroll
            for (int j = 0; j < 8; ++j) tmp2[j] = *(const u32x4*)(gn + (size_t)j * 64 * 128); }
        sel_search(kkB, t0 + 8 + wid, 8 + wid, ((t0 + 8 + wid) >> 6) + 1, lane, lmask, flags);
    }
    __syncthreads();
    staged = false;
    if (!(flags & 4096) && knext < BATCH * 256) { staged = true;
        int srow = F.tid; asm volatile("" : "+v"(srow)); const int spc = srow & 7; srow >>= 3;
        LAS unsigned char* ld0 = kst + srow * 128 + ((spc ^ (srow & 7)) << 4);
#pragma unroll
        for (int j = 0; j < 8; ++j) *(LAS u32x4*)(ld0 + j * 8192) = tmp2[j]; }
    { unsigned* mask = (unsigned*)(F.ws + ((flags & 4) ? WS_END : WS_MASK)); const int ntile64 = 4 * (t0 / 256 + 1);
      int tw = F.tid; asm volatile("" : "+v"(tw)); const int tl0 = tw >> 5, q = (tw >> 1) & 15, w = tw & 1;
      unsigned* mp = mask + (((size_t)b * 64 + tl0) * SEQ + t0 + q) * 2 + w; const LAS unsigned* lp = lmask + q * 128 + tl0 * 2 + w;
#pragma unroll 1
      for (int tl = tl0; tl < ntile64; tl += 16) { *mp = *lp; mp += (size_t)16 * SEQ * 2; lp += 32; } }
    if ((flags & 4096) && F.tid == 0) qslot[0] = kn_v;
    __syncthreads();
    if (flags & 4096) { knext = (int)qslot[0] - qoff; __syncthreads(); }
    return knext;
#undef CNT_OP
}
constexpr int RP = 272;
constexpr int RT = 128 * RP;
__device__ __forceinline__ void block_gemm128(f32x16 (&acc)[2], const LAS unsigned char* A, const LAS unsigned char* Bt, int wr, int wc, int r32, int hi) {
#pragma unroll
    for (int ks = 0; ks < 8; ++ks) {
        const bf16x8 a = *(const LAS bf16x8*)(A + (32 * wr + r32) * RP + ks * 32 + hi * 16);
#pragma unroll
        for (int n = 0; n < 2; ++n) { const bf16x8 bf = *(const LAS bf16x8*)(Bt + (64 * wc + 32 * n + r32) * RP + ks * 32 + hi * 16);
            acc[n] = __builtin_amdgcn_mfma_f32_32x32x16_bf16(bf, a, acc[n], 0, 0, 0); }
    }
}
__device__ __forceinline__ float ret_gamma_log2(int h) { return log2f(1.0f - exp2f(-5.0f - (float)h)); }

struct RetRaw { bf16x8 x1[2], x2[2]; };
struct RetRot { f32x4 c0[2], c1[2], s0[2], s1[2]; };
__device__ __forceinline__ void ret_ld(Frame& F, RetRaw& r, const bf16_t* src, int b, int h, int c) {
    const int i = F.tid >> 2, q = F.tid & 3; const bf16_t* row = src + ((size_t)b * SEQ + c * 128 + i) * 512 + h * 128;
#pragma unroll
    for (int m = 0; m < 2; ++m) { const int d0 = 8 * q + 32 * m; r.x1[m] = *(const bf16x8*)(row + d0); r.x2[m] = *(const bf16x8*)(row + d0 + 64); }
}
__device__ __forceinline__ void ret_ld_rot(Frame& F, RetRot& r, int c) {
    const float* rc = (const float*)(F.ws + WS_ROT); const float* rs = rc + SEQ * 64;
    const int i = F.tid >> 2, q = F.tid & 3; const size_t t = (size_t)(c * 128 + i);
#pragma unroll
    for (int m = 0; m < 2; ++m) { const int d0 = 8 * q + 32 * m;
        r.c0[m] = *(const f32x4*)(rc + t * 64 + d0); r.c1[m] = *(const f32x4*)(rc + t * 64 + d0 + 4); r.s0[m] = *(const f32x4*)(rs + t * 64 + d0); r.s1[m] = *(const f32x4*)(rs + t * 64 + d0 + 4); }
}
template <bool ROT, bool TR>
__device__ __forceinline__ void ret_st(Frame& F, LAS unsigned char* dst, const RetRaw& r, const RetRot& rr, float sc, float rowdecay_l2  ) {
    const int i = F.tid >> 2, q = F.tid & 3;
    const float rsc = sc * ((rowdecay_l2 != 0.f) ? exp2f(rowdecay_l2 * (float)(127 - i)) : 1.0f);
#pragma unroll
    for (int m = 0; m < 2; ++m) {
        const int d0 = 8 * q + 32 * m;
        float o1[8], o2[8];
        if (ROT) {
#pragma unroll
            for (int j = 0; j < 8; ++j) { const float a = bf2f((unsigned short)r.x1[m][j]), bb = bf2f((unsigned short)r.x2[m][j]); const float cs = j < 4 ? rr.c0[m][j] : rr.c1[m][j - 4], sn = j < 4 ? rr.s0[m][j] : rr.s1[m][j - 4];
                o1[j] = (a * cs - bb * sn) * rsc; o2[j] = (a * sn + bb * cs) * rsc; }
        } else {
#pragma unroll
            for (int j = 0; j < 8; ++j) { o1[j] = bf2f((unsigned short)r.x1[m][j]) * rsc; o2[j] = bf2f((unsigned short)r.x2[m][j]) * rsc; }
        }
        if (!TR) {
            u32x4 w1, w2; w1.x = pk2(o1[0], o1[1]); w1.y = pk2(o1[2], o1[3]); w1.z = pk2(o1[4], o1[5]); w1.w = pk2(o1[6], o1[7]);
            w2.x = pk2(o2[0], o2[1]); w2.y = pk2(o2[2], o2[3]); w2.z = pk2(o2[4], o2[5]); w2.w = pk2(o2[6], o2[7]);
            *(LAS u32x4*)(dst + i * RP + d0 * 2) = w1; *(LAS u32x4*)(dst + i * RP + (d0 + 64) * 2) = w2;
        } else {
#pragma unroll
            for (int j = 0; j < 8; ++j) { *(LAS bf16_t*)(dst + (d0 + j) * RP + i * 2) = (bf16_t)f2bf(o1[j]); *(LAS bf16_t*)(dst + (d0 + 64 + j) * RP + i * 2) = (bf16_t)f2bf(o2[j]); }
        }
    }
}
__device__ __forceinline__ void ret_state_item(Frame& F, LAS unsigned char* lds, int unit) {
    const int b = unit >> 7, h = (unit >> 5) & 3, c = unit & 31;
    const int lane = F.lane, wid = F.wave, wr = wid >> 1, wc = wid & 1, r32 = lane & 31, hi = lane >> 5;
    LAS unsigned char* Vt = lds; LAS unsigned char* Kt = lds + RT;
    const float lg = ret_gamma_log2(h);
    { RetRaw rv, rk; RetRot rr; ret_ld(F, rv, (const bf16_t*)(F.ws + WS_VR), b, h, c); ret_ld(F, rk, (const bf16_t*)(F.ws + WS_KR), b, h, c); ret_ld_rot(F, rr, c);
      ret_st<false, true>(F, Vt, rv, rr, 1.0f, 0.f); ret_st<true, true>(F, Kt, rk, rr, 0.08838834764831845f, lg); }
    __syncthreads();
    f32x16 acc[2]; acc[0] = f32x16{}; acc[1] = f32x16{};
    block_gemm128(acc, Vt, Kt, wr, wc, r32, hi);
    bf16_t* U = (bf16_t*)(F.ws + WS_U) + (size_t)unit * 16384;
#pragma unroll
    for (int n = 0; n < 2; ++n)
#pragma unroll
        for (int gq = 0; gq < 4; ++gq) { u32x2 w; w.x = pk2(acc[n][4 * gq], acc[n][4 * gq + 1]); w.y = pk2(acc[n][4 * gq + 2], acc[n][4 * gq + 3]);
            *(u32x2*)(U + (size_t)(32 * wr + r32) * 128 + 64 * wc + 32 * n + 8 * gq + 4 * hi) = w; }
    __syncthreads();
}
__device__ __forceinline__ void ret_scan(Frame& F) {
    const bf16_t* U = (const bf16_t*)(F.ws + WS_U); bf16_t* S = (bf16_t*)(F.ws + WS_S);
    const int nthr = F.G * 512;
    for (int idx = F.vcu * 512 + F.tid; idx < 32 * 4096; idx += nthr) {
        const int bh = idx >> 12, e4 = (idx & 4095) * 4, h = bh & 3;
        const float cd = exp2f(128.0f * ret_gamma_log2(h));
        f32x4 s = {0.f, 0.f, 0.f, 0.f};
        for (int c = 0; c < 31; ++c) {
            const u32x2 uw = *(const u32x2*)(U + ((size_t)(bh * 32 + c)) * 16384 + e4);
            f32x4 u; u.x = __uint_as_float(uw.x << 16); u.y = __uint_as_float(uw.x & 0xffff0000u); u.z = __uint_as_float(uw.y << 16); u.w = __uint_as_float(uw.y & 0xffff0000u);
            s = s * cd + u;
            u32x2 w; w.x = pk2(s.x, s.y); w.y = pk2(s.z, s.w);
            *(u32x2*)(S + ((size_t)(bh * 32 + c + 1)) * 16384 + e4) = w;
        }
    }
}
__device__ __forceinline__ void ret_out_item(Frame& F, LAS unsigned char* lds, int unit) {
    const int b = unit >> 7, h = (unit >> 5) & 3, c = unit & 31;
    const int lane = F.lane, wid = F.wave, wr = wid >> 1, wc = wid & 1, r32 = lane & 31, hi = lane >> 5;
    LAS unsigned char* Qs = lds; LAS unsigned char* Ks = lds + RT; LAS unsigned char* Vt = lds + 2 * RT; LAS unsigned char* St = lds + 3 * RT;
    LAS float* red = (LAS float*)(lds + 4 * RT);
    const float lg = ret_gamma_log2(h);
    { RetRaw rq, rk, rv; RetRot rr; u32x4 sv[4];
      ret_ld(F, rq, (const bf16_t*)(F.ws + WS_QR), b, h, c); ret_ld(F, rk, (const bf16_t*)(F.ws + WS_KR), b, h, c); ret_ld_rot(F, rr, c); ret_ld(F, rv, (const bf16_t*)(F.ws + WS_VR), b, h, c);
      const bf16_t* S = (const bf16_t*)(F.ws + WS_S) + (size_t)unit * 16384;
      if (c > 0) {
#pragma unroll
          for (int k = 0; k < 4; ++k) { const int i = F.tid + 512 * k; sv[k] = *(const u32x4*)(S + (i >> 4) * 128 + (i & 15) * 8); } }
      ret_st<true, false>(F, Qs, rq, rr, 1.0f, 0.f); ret_st<true, false>(F, Ks, rk, rr, 0.08838834764831845f, 0.f); ret_st<false, true>(F, Vt, rv, rr, 1.0f, 0.f);
      if (c > 0) {
#pragma unroll
          for (int k = 0; k < 4; ++k) { const int i = F.tid + 512 * k; *(LAS u32x4*)(St + (i >> 4) * RP + (i & 15) * 16) = sv[k]; } } }
    __syncthreads();
    f32x16 p[2]; p[0] = f32x16{}; p[1] = f32x16{};
    block_gemm128(p, Ks, Qs, wr, wc, r32, hi);
    __syncthreads();
    LAS unsigned char* Ps = Ks;
    { const int j = 32 * wr + r32;
#pragma unroll
      for (int n = 0; n < 2; ++n)
#pragma unroll
          for (int rg = 0; rg < 16; ++rg) { const int i = 64 * wc + 32 * n + (rg & 3) + 8 * (rg >> 2) + 4 * hi;
              const float v = (i >= j) ? p[n][rg] * exp2f(lg * (float)(i - j)) : 0.f;
              *(LAS bf16_t*)(Ps + i * RP + j * 2) = (bf16_t)f2bf(v); } }
    __syncthreads();
    f32x16 acc[2], cr[2]; acc[0] = f32x16{}; acc[1] = f32x16{}; cr[0] = f32x16{}; cr[1] = f32x16{};
    block_gemm128(acc, Ps, Vt, wr, wc, r32, hi);
    if (c > 0) block_gemm128(cr, Qs, St, wr, wc, r32, hi);
    const int i = 32 * wr + r32; const float qd = exp2f(lg * (float)(i + 1));
    float s1 = 0.f, s2 = 0.f;
#pragma unroll
    for (int n = 0; n < 2; ++n)
#pragma unroll
        for (int rg = 0; rg < 16; ++rg) { const float v = acc[n][rg] + qd * cr[n][rg]; acc[n][rg] = v; s1 += v; s2 += v * v; }
    s1 += __shfl_xor(s1, 32); s2 += __shfl_xor(s2, 32);
    if (hi == 0) { red[(wc * 128 + i) * 2] = s1; red[(wc * 128 + i) * 2 + 1] = s2; }
    __syncthreads();
    const float t1 = red[i * 2] + red[(128 + i) * 2], t2 = red[i * 2 + 1] + red[(128 + i) * 2 + 1];
    const float mean = t1 * (1.0f / 128.0f); const float var = fmaxf(t2 * (1.0f / 128.0f) - mean * mean, 0.f); const float rstd = 1.0f / sqrtf(var + LN_EPS);
    const size_t tok = (size_t)b * SEQ + c * 128 + i;
    const bf16_t* GR = (const bf16_t*)(F.ws + WS_GR) + tok * 512 + h * 128; bf16_t* CC = (bf16_t*)(F.ws + WS_H) + tok * 1024 + 512 + h * 128;
#pragma unroll
    for (int n = 0; n < 2; ++n)
#pragma unroll
        for (int gq = 0; gq < 4; ++gq) { const int col = 64 * wc + 32 * n + 8 * gq + 4 * hi;
            const u32x2 gw = *(const u32x2*)(GR + col); const f32x4 ng = *(const f32x4*)(F.ret_g + h * 128 + col);
            float o[4];
#pragma unroll
            for (int k = 0; k < 4; ++k) { const unsigned short gb = (unsigned short)((k < 2 ? gw.x : gw.y) >> (16 * (k & 1))); const float gg = bf2f(gb);
                const float sl = gg / (1.0f + __expf(-gg)); o[k] = (acc[n][4 * gq + k] - mean) * rstd * ng[k] * sl
#ifdef ABL_NORET
                    * 0.f
#endif
                    ; }
            u32x2 w; w.x = pk2(o[0], o[1]); w.y = pk2(o[2], o[3]);
            *(u32x2*)(CC + col) = w; }
    __syncthreads();
}
constexpr int WRP = 1028;
__device__ __forceinline__ float dpp_f(float v, int ctrl_sel) {
    const int u = __float_as_int(v);
    switch (ctrl_sel) {
        case 0: return __int_as_float(__builtin_amdgcn_update_dpp(0, u, 0xB1, 0xF, 0xF, false));
        case 1: return __int_as_float(__builtin_amdgcn_update_dpp(0, u, 0x4E, 0xF, 0xF, false));
        case 2: return __int_as_float(__builtin_amdgcn_update_dpp(0, u, 0x141, 0xF, 0xF, false));
        default: return __int_as_float(__builtin_amdgcn_update_dpp(0, u, 0x140, 0xF, 0xF, false));
    }
}
__device__ __forceinline__ float part16(float v, int lane) { const unsigned u = __float_as_uint(v); auto r = __builtin_amdgcn_permlane16_swap(u, u, false, false); return __uint_as_float((lane & 16) ? r[0] : r[1]); }
__device__ __forceinline__ float part32(float v, int lane) { const unsigned u = __float_as_uint(v); auto r = __builtin_amdgcn_permlane32_swap(u, u, false, false); return __uint_as_float((lane & 32) ? r[0] : r[1]); }
__device__ __forceinline__ float wsum(float v, int lane) { v += dpp_f(v, 0); v += dpp_f(v, 1); v += dpp_f(v, 2); v += dpp_f(v, 3); v += part16(v, lane); v += part32(v, lane); return v; }
__device__ __forceinline__ float wmax(float v, int lane) { v = fmaxf(v, dpp_f(v, 0)); v = fmaxf(v, dpp_f(v, 1)); v = fmaxf(v, dpp_f(v, 2)); v = fmaxf(v, dpp_f(v, 3)); v = fmaxf(v, part16(v, lane)); v = fmaxf(v, part32(v, lane)); return v; }
__device__ __forceinline__ float rs32(float (&a)[32], int lane) {
#pragma unroll
    for (int e = 0; e < 16; ++e) { const bool up = (lane & 32) != 0; const float send = up ? a[e] : a[e + 16], keep = up ? a[e + 16] : a[e]; a[e] = keep + part32(send, lane); }
#pragma unroll
    for (int e = 0; e < 8; ++e) { const bool up = (lane & 16) != 0; const float send = up ? a[e] : a[e + 8], keep = up ? a[e + 8] : a[e]; a[e] = keep + part16(send, lane); }
#pragma unroll
    for (int e = 0; e < 4; ++e) { const bool up = (lane & 8) != 0; const float send = up ? a[e] : a[e + 4], keep = up ? a[e + 4] : a[e]; a[e] = keep + dpp_f(send, 3); }
#pragma unroll
    for (int e = 0; e < 2; ++e) { const bool up = (lane & 4) != 0; const float send = up ? a[e] : a[e + 2], keep = up ? a[e + 2] : a[e]; a[e] = keep + dpp_f(send, 2); }
    { const bool up = (lane & 2) != 0; const float send = up ? a[0] : a[1], keep = up ? a[1] : a[0]; a[0] = keep + dpp_f(send, 1); }
    return a[0] + dpp_f(a[0], 0);
}
__device__ __forceinline__ f32x4 ld_v1(const float* x, const bf16_t* mix, int tok, int lane, int j) {
    const f32x4 xv = ((const f32x4*)(x + (size_t)tok * DM) + lane)[64 * j]; const u32x2 w = ((const u32x2*)(mix + (size_t)tok * DM) + lane)[64 * j];
    f32x4 m; m.x = __uint_as_float(w.x << 16); m.y = __uint_as_float(w.x & 0xffff0000u); m.z = __uint_as_float(w.y << 16); m.w = __uint_as_float(w.y & 0xffff0000u);
    return xv * DN_ALPHA + m; }
__device__ __forceinline__ void p6_rows(Frame& F, LAS unsigned char* lds) {
    LAS float* wrt = (LAS float*)lds;
    LAS unsigned* lcnt = (LAS unsigned*)(lds + 32 * WRP * 4);
    LAS unsigned* lbase = lcnt + 32;
    for (int i = F.tid; i < DM * NEXP; i += 512) { const int k = i >> 5, e = i & 31; wrt[e * WRP + k] = F.w_router[i]; }
    const float* mod = (const float*)(F.ws + WS_MOD);
    bf16_t* X1 = (bf16_t*)(F.ws + WS_X1); unsigned* H2Q = (unsigned*)(F.ws + WS_H2); float* STOK = (float*)(F.ws + WS_STOK); const bf16_t* MIXp = (const bf16_t*)(F.ws + WS_MIX);
    int* tope = (int*)(F.ws + WS_TOPE); float* gate = (float*)(F.ws + WS_GATE); int* rank = (int*)(F.ws + WS_RANK);
    unsigned* gcnt = (unsigned*)(F.ws + WS_CTL) + CW_CNT;
    const int lane = F.lane;
    const float br = F.b_router[(lane >> 1) & 31];
    for (int chunk = F.vcu; chunk < NTOK / 128; chunk += F.G) {
        if (F.tid < 32) lcnt[F.tid] = 0u;
        __syncthreads();
        const int b = (chunk * 128) / SEQ;
        const f32x4* shf = (const f32x4*)(mod + (size_t)b * 6144 + 3 * DM) + lane; const f32x4* scf = (const f32x4*)(mod + (size_t)b * 6144 + 4 * DM) + lane;
        const int tok0 = chunk * 128 + F.wave * 16;
        f32x4 na[4], nb[4];
#pragma unroll
        for (int j = 0; j < 4; ++j) { na[j] = ld_v1(F.x, MIXp, tok0, lane, j); nb[j] = ld_v1(F.x, MIXp, tok0 + 1, lane, j); }
        for (int pp = 0; pp < 8; ++pp) {
            const int tok = tok0 + 2 * pp;
            f32x4 va[4], vb[4];
#pragma unroll
            for (int j = 0; j < 4; ++j) { va[j] = na[j]; vb[j] = nb[j]; }
            if (pp < 7) {
#pragma unroll
                for (int j = 0; j < 4; ++j) { na[j] = ld_v1(F.x, MIXp, tok + 2, lane, j); nb[j] = ld_v1(F.x, MIXp, tok + 3, lane, j); } }
            float sa = 0.f, sb = 0.f;
#pragma unroll
            for (int j = 0; j < 4; ++j) { sa += (va[j].x + va[j].y) + (va[j].z + va[j].w); sb += (vb[j].x + vb[j].y) + (vb[j].z + vb[j].w); }
            const float ma = wsum(sa, lane) * (1.f / DM), mb = wsum(sb, lane) * (1.f / DM); float qa = 0.f, qb = 0.f;
#pragma unroll
            for (int j = 0; j < 4; ++j) { va[j] = va[j] - ma; vb[j] = vb[j] - mb; qa += (va[j].x * va[j].x + va[j].y * va[j].y) + (va[j].z * va[j].z + va[j].w * va[j].w); qb += (vb[j].x * vb[j].x + vb[j].y * vb[j].y) + (vb[j].z * vb[j].z + vb[j].w * vb[j].w); }
            const float ra = 1.f / sqrtf(wsum(qa, lane) * (1.f / DM) + LN_EPS), rb = 1.f / sqrtf(wsum(qb, lane) * (1.f / DM) + LN_EPS);
            unsigned long long* xa = (unsigned long long*)(X1 + (size_t)tok * DM) + lane; unsigned long long* xb = (unsigned long long*)(X1 + (size_t)(tok + 1) * DM) + lane;
            unsigned* oa = H2Q + (size_t)tok * (DM / 4) + lane; unsigned* ob = H2Q + (size_t)(tok + 1) * (DM / 4) + lane;
            float amxa = 0.f, amxb = 0.f;
#pragma unroll
            for (int j = 0; j < 4; ++j) { const f32x4 sc1 = scf[64 * j] + 1.0f, sh1 = shf[64 * j]; const f32x4 g1j = ((const f32x4*)F.ln1_g)[lane + 64 * j], b1j = ((const f32x4*)F.ln1_b)[lane + 64 * j];
                const f32x4 x1a = va[j] * ra * g1j + b1j, x1b = vb[j] * rb * g1j + b1j;
                xa[64 * j] = (unsigned long long)pk2(x1a.x, x1a.y) | ((unsigned long long)pk2(x1a.z, x1a.w) << 32); xb[64 * j] = (unsigned long long)pk2(x1b.x, x1b.y) | ((unsigned long long)pk2(x1b.z, x1b.w) << 32);
                va[j] = x1a * sc1 + sh1; vb[j] = x1b * sc1 + sh1;
                amxa = fmaxf(fmaxf(amxa, fmaxf(fabsf(va[j].x), fabsf(va[j].y))), fmaxf(fabsf(va[j].z), fabsf(va[j].w)));
                amxb = fmaxf(fmaxf(amxb, fmaxf(fabsf(vb[j].x), fabsf(vb[j].y))), fmaxf(fabsf(vb[j].z), fabsf(vb[j].w))); }
            amxa = wmax(amxa, lane); amxb = wmax(amxb, lane);
            { const float ia = amxa > 0.f ? 127.0f / amxa : 0.f, ib = amxb > 0.f ? 127.0f / amxb : 0.f;
#pragma unroll
              for (int j = 0; j < 4; ++j) {
                  oa[64 * j] = (unsigned)(((int)rintf(va[j].x * ia) & 0xff) | (((int)rintf(va[j].y * ia) & 0xff) << 8) | (((int)rintf(va[j].z * ia) & 0xff) << 16) | (((int)rintf(va[j].w * ia) & 0xff) << 24));
                  ob[64 * j] = (unsigned)(((int)rintf(vb[j].x * ib) & 0xff) | (((int)rintf(vb[j].y * ib) & 0xff) << 8) | (((int)rintf(vb[j].z * ib) & 0xff) << 16) | (((int)rintf(vb[j].w * ib) & 0xff) << 24)); }
              if (lane == 0) { STOK[tok] = amxa > 0.f ? amxa * (1.0f / 127.0f) : 1.0f; STOK[tok + 1] = amxb > 0.f ? amxb * (1.0f / 127.0f) : 1.0f; } }
            float a[32], c[32];
            f32x2 vp[4][4];
#pragma unroll
            for (int j = 0; j < 4; ++j) { vp[j][0] = (f32x2){va[j].x, vb[j].x}; vp[j][1] = (f32x2){va[j].y, vb[j].y}; vp[j][2] = (f32x2){va[j].z, vb[j].z}; vp[j][3] = (f32x2){va[j].w, vb[j].w}; }
#pragma unroll
            for (int e = 0; e < 32; ++e) { f32x2 acc2 = {0.f, 0.f};
#pragma unroll
                for (int j = 0; j < 4; ++j) { const f32x4 w = *(const LAS f32x4*)(wrt + e * WRP + 4 * lane + 256 * j);
                    acc2 = vp[j][0] * w.x + acc2; acc2 = vp[j][1] * w.y + acc2; acc2 = vp[j][2] * w.z + acc2; acc2 = vp[j][3] * w.w + acc2; }
                a[e] = acc2.x; c[e] = acc2.y; }
            float lga = rs32(a, lane) + br, lgb = rs32(c, lane) + br;
            int ea[4], eb[4]; float xa4[4], xb4[4];
#pragma unroll
            for (int k = 0; k < 4; ++k) {
                const float m1 = wmax(lga, lane), m2 = wmax(lgb, lane);
                const unsigned long long b1_ = __ballot(lga == m1), b2_ = __ballot(lgb == m2);
                ea[k] = (__ffsll((long long)b1_) - 1) >> 1; eb[k] = (__ffsll((long long)b2_) - 1) >> 1; xa4[k] = m1; xb4[k] = m2;
                if ((lane >> 1) == ea[k]) lga = -INFINITY; if ((lane >> 1) == eb[k]) lgb = -INFINITY; }
            { const float e1 = __expf(xa4[1] - xa4[0]), e2 = __expf(xa4[2] - xa4[0]), e3 = __expf(xa4[3] - xa4[0]); const float inv = 1.f / (1.f + e1 + e2 + e3);
              const float f1 = __expf(xb4[1] - xb4[0]), f2 = __expf(xb4[2] - xb4[0]), f3 = __expf(xb4[3] - xb4[0]); const float jnv = 1.f / (1.f + f1 + f2 + f3);
              if (lane < 8) { const int k = lane & 3; const bool second = lane >= 4;
                  const int e = second ? (k == 0 ? eb[0] : k == 1 ? eb[1] : k == 2 ? eb[2] : eb[3]) : (k == 0 ? ea[0] : k == 1 ? ea[1] : k == 2 ? ea[2] : ea[3]);
                  const float gv = second ? (k == 0 ? 1.f : k == 1 ? f1 : k == 2 ? f2 : f3) * jnv : (k == 0 ? 1.f : k == 1 ? e1 : k == 2 ? e2 : e3) * inv;
                  const unsigned r = atomicAdd((unsigned*)&lcnt[e], 1u); const int tk = tok + (second ? 1 : 0);
                  tope[tk * 4 + k] = e; gate[tk * 4 + k] = gv; rank[tk * 4 + k] = (int)r; } }
        }
        __syncthreads();
        if (F.tid < 32) lbase[F.tid] = __hip_atomic_fetch_add(gcnt + F.tid, lcnt[F.tid], __ATOMIC_RELAXED, __HIP_MEMORY_SCOPE_AGENT);
        __syncthreads();
        { const int i = F.tid; const int tok = chunk * 128 + (i >> 2); rank[tok * 4 + (i & 3)] += (int)lbase[tope[tok * 4 + (i & 3)]]; }
        __syncthreads();
    }
}
__device__ __forceinline__ void p6b_scatter(Frame& F, LAS unsigned char* lds) {
    LAS int* pst = (LAS int*)lds; LAS int* cnts = pst + 32;
    unsigned* gcnt = (unsigned*)(F.ws + WS_CTL) + CW_CNT;
    if (F.tid == 0) { int acc = 0; for (int e = 0; e < 32; ++e) { const int c = (int)__hip_atomic_load(gcnt + e, __ATOMIC_RELAXED, __HIP_MEMORY_SCOPE_AGENT); cnts[e] = c; pst[e] = acc; acc += (c + 255) / 256 * 256; }
        pst[64] = acc; }
    __syncthreads();
    const int* tope = (const int*)(F.ws + WS_TOPE); const float* gate = (const float*)(F.ws + WS_GATE); const int* rank = (const int*)(F.ws + WS_RANK);
    int* pos = (int*)(F.ws + WS_POS); int* rowtok = (int*)(F.ws + WS_ROWTOK); float* rowgate = (float*)(F.ws + WS_ROWGATE); int* blkexp = (int*)(F.ws + WS_BLKEXP);
    const float* stok = (const float*)(F.ws + WS_STOK); float* rowscale = (float*)(F.ws + WS_ROWSCALE);
    for (int i = F.vcu * 512 + F.tid; i < NTOK * 4; i += F.G * 512) { const int e = tope[i]; const int d = pst[e] + rank[i]; pos[i] = d; rowtok[d] = i >> 2; rowgate[d] = gate[i]; rowscale[d] = stok[i >> 2]; }
    for (int i = F.vcu * 512 + F.tid; i < 32 * 256; i += F.G * 512) { const int e = i >> 8, r = cnts[e] + (i & 255); if (r < (cnts[e] + 255) / 256 * 256) { rowtok[pst[e] + r] = 0; rowgate[pst[e] + r] = 0.f; rowscale[pst[e] + r] = 0.f; } }
    if (F.vcu == 0) { const int nblk = pst[64] / 256;
        for (int rb = F.tid; rb < nblk; rb += 512) { int e = 0; for (int q = 1; q < 32; ++q) if (pst[q] <= rb * 256) e = q; blkexp[rb] = e; }
        if (F.tid == 0) blkexp[MAXBLK] = nblk;
        if (F.tid < 33) blkexp[600 + F.tid] = (F.tid < 32 ? pst[F.tid] : pst[64]) / 256; }
}
__device__ __forceinline__ void p9_final(Frame& F) {
    const int gw = F.vcu * NWAVES + F.wave, NGW = F.G * NWAVES, lane = F.lane;
    const float* mod = (const float*)(F.ws + WS_MOD); const bf16_t* X1 = (const bf16_t*)(F.ws + WS_X1); const unsigned char* Y = (const unsigned char*)(F.ws + WS_Y); const int* pos = (const int*)(F.ws + WS_POS);
    f32x4 g2[4], b2[4];
#pragma unroll
    for (int j = 0; j < 4; ++j) { g2[j] = ((const f32x4*)F.ln2_g)[lane + 64 * j]; b2[j] = ((const f32x4*)F.ln2_b)[lane + 64 * j]; }
    for (int tok = gw; tok < NTOK; tok += NGW) {
        const int b = tok / SEQ; const f32x4* gf = (const f32x4*)(mod + (size_t)b * 6144 + 5 * DM) + lane;
        const u32x2* xr = (const u32x2*)(X1 + (size_t)tok * DM) + lane;
        int p[4];
#pragma unroll
        for (int k = 0; k < 4; ++k) p[k] = pos[tok * 4 + k];
        f32x4 v[4]; float s = 0.f;
#pragma unroll
        for (int j = 0; j < 4; ++j) { f32x4 ff = {0.f, 0.f, 0.f, 0.f};
#pragma unroll
            for (int k = 0; k < 4; ++k) { const int w = (int)*((const unsigned*)(Y + (size_t)p[k] * DM) + lane + 64 * j);
                const f32x2 lo = __builtin_amdgcn_cvt_pk_f32_fp8(w, false), hi = __builtin_amdgcn_cvt_pk_f32_fp8(w, true);
                ff.x += lo.x; ff.y += lo.y; ff.z += hi.x; ff.w += hi.y; }
            ff = ff * (1.0f / 64.0f);
            { const u32x2 xw = xr[64 * j]; f32x4 x1v; x1v.x = __uint_as_float(xw.x << 16); x1v.y = __uint_as_float(xw.x & 0xffff0000u); x1v.z = __uint_as_float(xw.y << 16); x1v.w = __uint_as_float(xw.y & 0xffff0000u);
              v[j] = x1v * DN_ALPHA + (gf[64 * j] + 1.0f) * ff; } s += (v[j].x + v[j].y) + (v[j].z + v[j].w); }
        const float mean = wave_sum(s) * (1.f / DM); float s2 = 0.f;
#pragma unroll
        for (int j = 0; j < 4; ++j) { v[j] = v[j] - mean; s2 += (v[j].x * v[j].x + v[j].y * v[j].y) + (v[j].z * v[j].z + v[j].w * v[j].w); }
        const float rstd = 1.f / sqrtf(wave_sum(s2) * (1.f / DM) + LN_EPS);
        f32x4* orow = (f32x4*)(F.out + (size_t)tok * DM) + lane;
#pragma unroll
        for (int j = 0; j < 4; ++j) orow[64 * j] = (v[j] * rstd * g2[j] + b2[j])
#ifdef DIAG_ITERS
            * (1.0f + 1e-3f * (DIAG_ITERS == 1 ? (float)((const unsigned*)(F.ws + WS_CTL))[2048] / (float)((const unsigned*)(F.ws + WS_CTL))[2050] : (float)((const unsigned*)(F.ws + WS_CTL))[2049]))
#endif
            ;
    }
}
#ifndef MK_N_LAUNCHES
#define MK_N_LAUNCHES 1
#endif
constexpr int PER_PHASE = 12;
constexpr int N_LAUNCHES = MK_N_LAUNCHES;
struct Args { const float* in[18]; float* out; unsigned char* ws; int ph_lo, ph_hi, sub, pad; };
static_assert(sizeof(Args) == 18 * 8 + 8 + 8 + 16, "Args has no padding");

__global__ void __launch_bounds__(NWAVES * 64, 2) dsa_fwd(Args args) {
    extern __shared__ __attribute__((aligned(16))) unsigned char lds[];
    LAS unsigned char* L = (LAS unsigned char*)lds;
    Frame F;
    F.ws = args.ws; F.tid = threadIdx.x; F.lane = F.tid & 63; F.wave = __builtin_amdgcn_readfirstlane(F.tid >> 6);
    F.G = gridDim.x; { const int bx = blockIdx.x; F.vcu = (F.G % 8 == 0) ? (bx % 8) * (F.G / 8) + bx / 8 : bx; }
    F.x = args.in[0]; F.c = args.in[1]; F.rel_bias = args.in[2]; F.w_ada = args.in[3]; F.b_ada = args.in[4]; F.w_in = args.in[5]; F.ret_g = args.in[6]; F.w_out = args.in[7];
    F.ln1_g = args.in[8]; F.ln1_b = args.in[9]; F.w_router = args.in[10]; F.b_router = args.in[11]; F.w_gu = args.in[12]; F.b_gu = args.in[13]; F.w_d = args.in[14]; F.b_d = args.in[15];
    F.ln2_g = args.in[16]; F.ln2_b = args.in[17]; F.out = args.out;
    unsigned* ctl = (unsigned*)(F.ws + WS_CTL);
    volatile LAS unsigned* MISC = (volatile LAS unsigned*)(L + LDS_BYTES - 64);
    if (F.tid < 16) MISC[F.tid] = 0u;
    __syncthreads();
    XcdBarrier bar; bar.bar = ctl + CW_BAR; bar.x = 0; bar.st = nullptr;
    if (N_LAUNCHES == 1) bar = xcd_barrier_post(ctl + CW_BAR, MISC + 8);
    const int lo = args.ph_lo, hi = args.ph_hi;
#ifndef PHASE_MASK
#define PHASE_MASK 0xfff
#endif
#define IN(k) (((PHASE_MASK >> (k)) & 1) && lo <= (k) && (k) < hi)
#define REFRESH() do { int t_ = threadIdx.x; asm volatile("" : "+v"(t_)); F.tid = t_; F.lane = t_ & 63; } while (0)
#ifdef PROBE_BAR3
#define SEAM(k) do { if (IN(k) && IN((k) + 1)) { xcd_barrier(bar); xcd_barrier(bar); xcd_barrier(bar); } } while (0)
#else
#define SEAM(k) do { if (IN(k) && IN((k) + 1)) xcd_barrier(bar); } while (0)
#endif

    if (IN(0)) { REFRESH(); p0_prologue(F, L); } SEAM(0);
    if (IN(1)) { REFRESH(); p1_modulate(F, L); } SEAM(1);
    if (IN(2)) { REFRESH();
        {
            pg8::Gemm g{(const bf16_t*)(F.ws + WS_H), (const bf16_t*)(F.ws + WS_WIN), DM, nullptr}; pg8::RemapOrder S; S.base.init(NTOK, 512, F.G, (int)blockIdx.x); S.from = 0; S.off = 3; S.off0 = 0;
            pg8::EpiInProj E{(bf16_t*)(F.ws + WS_QA), (bf16_t*)(F.ws + WS_KA), (bf16_t*)(F.ws + WS_VA), (bf16_t*)(F.ws + WS_QI), (bf16_t*)(F.ws + WS_KIW),
                             (bf16_t*)(F.ws + WS_QR), (bf16_t*)(F.ws + WS_KR), (bf16_t*)(F.ws + WS_VR), (bf16_t*)(F.ws + WS_GR)};
            pg8::gemm_phase<pg8::EpiInProj, pg8::RemapOrder, false>(L, g, S, E); }
        {
            pg8::Gemm g{(const bf16_t*)(F.ws + WS_HQ), (const bf16_t*)(F.ws + WS_WINQ), DM / 2, nullptr}; pg8::RemapOrder S; S.base.init(NTOK, 10 * 256, F.G, (int)blockIdx.x); S.from = 2; S.off = 3; S.off0 = 1;
            pg8::EpiInProjI8 E{(bf16_t*)(F.ws + WS_QA), (bf16_t*)(F.ws + WS_KA), (bf16_t*)(F.ws + WS_VA), (bf16_t*)(F.ws + WS_QR), (bf16_t*)(F.ws + WS_KR), (bf16_t*)(F.ws + WS_VR), (bf16_t*)(F.ws + WS_GR),
                               (const float*)(F.ws + WS_SH), (const float*)(F.ws + WS_SWIN)};
            pg8::gemm_phase<pg8::EpiInProjI8, pg8::RemapOrder, false, true>(L, g, S, E); }
    } SEAM(2);
    if (IN(3)) { REFRESH();
        unsigned* qctr = ctl + CW_QUEUE; volatile LAS unsigned* qslot = MISC;
        int k; bool staged = false;
        constexpr int QOFF = NTOK / 256;
        if (F.tid == 0) qslot[0] = __hip_atomic_fetch_add(qctr, 1u, __ATOMIC_RELAXED, __HIP_MEMORY_SCOPE_AGENT);
        __syncthreads(); k = (int)qslot[0]; __syncthreads();
        for (;;) {
            if (k >= QOFF + BATCH * 256 + 1024) break;
            if (k >= QOFF && k < QOFF + BATCH * 256 && (args.sub & 1)) { k = QOFF + select_item(F, L, k - QOFF, staged, qctr, qslot, args.sub, QOFF); continue; }
            if (k < QOFF) {
                pg8::Gemm g{(const bf16_t*)(F.ws + WS_HQ), (const bf16_t*)(F.ws + WS_WINQ), DM / 2, nullptr}; pg8::SingleOrder S{k, 0};
                pg8::EpiInProjI8 E{(bf16_t*)(F.ws + WS_QA), (bf16_t*)(F.ws + WS_KA), (bf16_t*)(F.ws + WS_VA), (bf16_t*)(F.ws + WS_QR), (bf16_t*)(F.ws + WS_KR), (bf16_t*)(F.ws + WS_VR), (bf16_t*)(F.ws + WS_GR),
                                   (const float*)(F.ws + WS_SH), (const float*)(F.ws + WS_SWIN)};
                pg8::gemm_phase<pg8::EpiInProjI8, pg8::SingleOrder, false, true>(L, g, S, E); REFRESH(); __syncthreads(); }
            else if (k >= QOFF + BATCH * 256 && (args.sub & 2)) ret_state_item(F, L, k - QOFF - BATCH * 256);
            if (F.tid == 0) qslot[0] = __hip_atomic_fetch_add(qctr, 1u, __ATOMIC_RELAXED, __HIP_MEMORY_SCOPE_AGENT);
            __syncthreads(); k = (int)qslot[0]; __syncthreads();
        }
    } SEAM(3);
    if (IN(4)) { REFRESH(); ret_scan(F); } SEAM(4);
    if (IN(5)) { REFRESH();
        if (args.sub & 1)
        for (int i = 0;; ++i) { const int Lx = i * F.G + F.vcu; if (Lx >= 1024) break;
            int bh, qb;
            if (F.G == 256) { const int s = F.vcu & 3; bh = F.vcu >> 2; qb = (i == 0) ? 15 - s : (i == 1) ? 8 + s : (i == 2) ? 7 - s : s; }
            else { bh = Lx >> 4; qb = Lx & 15; }
            attn_body::attn_unit(bh >> 3, bh & 7, qb, (const bf16_t*)(F.ws + WS_QA), (const bf16_t*)(F.ws + WS_KA), (const bf16_t*)(F.ws + WS_VA), (bf16_t*)(F.ws + WS_H),
                                 (const unsigned*)(F.ws + WS_MASK), F.rel_bias, (char*)lds); }
        __syncthreads();
        if (args.sub & 2)
        for (int u = F.vcu; u < 1024; u += F.G) ret_out_item(F, L, u);
    } SEAM(5);
    if (IN(6)) { REFRESH();
        pg8::Gemm g{(const bf16_t*)(F.ws + WS_H), (const bf16_t*)(F.ws + WS_WOUT), DM, nullptr}; pg8::StaticOrder S; S.init(NTOK, DM, F.G, (int)blockIdx.x);
        pg8::EpiOutProj E{(const float*)(F.ws + WS_MOD), (bf16_t*)(F.ws + WS_MIX)};
        pg8::gemm_phase<pg8::EpiOutProj, pg8::StaticOrder, false>(L, g, S, E);
    } SEAM(6);
    if (IN(7)) { REFRESH(); p6_rows(F, L); } SEAM(7);
    if (IN(8)) { REFRESH(); p6b_scatter(F, L); } SEAM(8);
    if (IN(9)) { REFRESH();
        const int* blkexp = (const int*)(F.ws + WS_BLKEXP); const int nblk = __hip_atomic_load(blkexp + MAXBLK, __ATOMIC_RELAXED, __HIP_MEMORY_SCOPE_AGENT);
        pg8::Gemm g{(const bf16_t*)(F.ws + WS_H2), (const bf16_t*)(F.ws + WS_WGU), DM / 2, (const int*)(F.ws + WS_ROWTOK)}; pg8::MoeOrder S{blkexp, nblk, 8, F.G, F.vcu};
        pg8::EpiGateUp E{(unsigned char*)(F.ws + WS_ACT), F.b_gu, (const float*)(F.ws + WS_SWGU), (const float*)(F.ws + WS_ROWSCALE)};
        pg8::gemm_phase<pg8::EpiGateUp, pg8::MoeOrder, true, true>(L, g, S, E);
    } SEAM(9);
    if (IN(10)) { REFRESH();
        const int* blkexp = (const int*)(F.ws + WS_BLKEXP); const int nblk = __hip_atomic_load(blkexp + MAXBLK, __ATOMIC_RELAXED, __HIP_MEMORY_SCOPE_AGENT);
        pg8::Gemm g{(const bf16_t*)(F.ws + WS_ACT), (const bf16_t*)(F.ws + WS_WD), DFF / 2, nullptr}; pg8::MoeOrder S{blkexp, nblk, 4, F.G, F.vcu};
        pg8::EpiDown E{(unsigned char*)(F.ws + WS_Y), F.b_d, (const float*)(F.ws + WS_ROWGATE), (const float*)(F.ws + WS_SWD)};
        pg8::gemm_phase<pg8::EpiDown, pg8::MoeOrder, false, false, true>(L, g, S, E);
    } SEAM(10);
    if (IN(11)) { REFRESH(); p9_final(F); }
#undef IN
#undef SEAM
}

extern "C" void kernel_launch(void* const* d_in, const int* in_sizes, int n_in, void* d_out, int out_size, void* d_ws, size_t ws_size, hipStream_t stream) {
    static int grid = 0;
    if (grid == 0) {
        if (n_in != 18 || out_size != NTOK * DM || ws_size < WS_END) { fprintf(stderr, "kernel_launch: unexpected shapes (n_in %d out %d ws %zu)\n", n_in, out_size, ws_size); grid = -1; return; }
        int dev = 0, cus = 0, per_cu = 0;
        if (hipGetDevice(&dev) != hipSuccess || hipDeviceGetAttribute(&cus, hipDeviceAttributeMultiprocessorCount, dev) != hipSuccess) { grid = -1; return; }
        if (hipFuncSetAttribute((const void*)dsa_fwd, hipFuncAttributeMaxDynamicSharedMemorySize, LDS_BYTES) != hipSuccess) { fprintf(stderr, "kernel_launch: hipFuncSetAttribute failed\n"); grid = -1; return; }
        if (hipOccupancyMaxActiveBlocksPerMultiprocessor(&per_cu, (const void*)dsa_fwd, NWAVES * 64, LDS_BYTES) != hipSuccess || per_cu < 1) { fprintf(stderr, "kernel_launch: occupancy query says %d blocks per CU\n", per_cu); (void)hipGetLastError(); per_cu = 1; }
        grid = cus;
    }
    if (grid < 0) return;
    (void)hipMemsetAsync((char*)d_ws + WS_CTL, 0, CTL_ZERO_BYTES, stream);
    Args a{};
    for (int i = 0; i < 18; ++i) a.in[i] = (const float*)d_in[i];
    a.out = (float*)d_out; a.ws = (unsigned char*)d_ws; a.sub = 3;
    if (N_LAUNCHES == 1) {
        a.ph_lo = 0; a.ph_hi = PER_PHASE;
        void* kargs[] = {&a};
        hipError_t e = hipLaunchCooperativeKernel((const void*)dsa_fwd, dim3(grid), dim3(NWAVES * 64), kargs, LDS_BYTES, stream);
        if (e != hipSuccess) { fprintf(stderr, "kernel_launch: cooperative launch failed: %s (grid %d)\n", hipGetErrorString(e), grid); }
#ifdef PROBE_PHASE
        a.ph_lo = PROBE_PHASE; a.ph_hi = PROBE_PHASE + 1;
#ifdef PROBE_SUB
        a.sub = PROBE_SUB;
#endif
        (void)hipMemsetAsync((char*)d_ws + WS_CTL + 4 * CW_QUEUE, 0, 64, stream);
        hipLaunchKernelGGL(dsa_fwd, dim3(grid), dim3(NWAVES * 64), LDS_BYTES, stream, a);
#endif
    } else {
        for (int li = 0; li < PER_PHASE; ++li) { a.ph_lo = li; a.ph_hi = li + 1; hipLaunchKernelGGL(dsa_fwd, dim3(grid), dim3(NWAVES * 64), LDS_BYTES, stream, a); }
    }
}
```

```cpp
#include <hip/hip_runtime.h>
#include <hip/hip_bf16.h>
#include <cstdio>
#include <cstdint>
#include <cmath>

#define LAS __attribute__((address_space(3)))
#define GAS __attribute__((address_space(1)))
typedef unsigned short bf16_t;
typedef short bf16x8 __attribute__((ext_vector_type(8)));
typedef short s16x4 __attribute__((ext_vector_type(4)));
typedef float f32x2 __attribute__((ext_vector_type(2)));
typedef float f32x4 __attribute__((ext_vector_type(4)));
typedef float f32x16 __attribute__((ext_vector_type(16)));
typedef unsigned u32x2 __attribute__((ext_vector_type(2)));
typedef unsigned u32x4 __attribute__((ext_vector_type(4)));
typedef int i32x4 __attribute__((ext_vector_type(4)));
typedef int i32x8 __attribute__((ext_vector_type(8)));

constexpr int BATCH = 8, SEQ = 4096, DM = 1024, NTOK = BATCH * SEQ;
constexpr int NIN = 3328;
constexpr int DIN_SRC = 3140;
constexpr int NEXP = 32, DFF = 1024, TOPK = 4, MOE_BLK = 256, MAXBLK = 544, PROWS = MAXBLK * 256;
constexpr float LN_EPS = 1e-5f;
constexpr float DN_ALPHA = 1.189207115002721f;
constexpr float LOG2E = 1.4426950408889634f;
constexpr float QSCALE = 0.125f * LOG2E;

__device__ __forceinline__ unsigned f2bf(float f) { unsigned u = __builtin_bit_cast(unsigned, f); return (u + 0x7fffu + ((u >> 16) & 1u)) >> 16; }
__device__ __forceinline__ unsigned pk2(float lo, float hi) { return f2bf(lo) | (f2bf(hi) << 16); }
__device__ __forceinline__ float bf2f(unsigned short b) { return __uint_as_float(((unsigned)b) << 16); }
__device__ __forceinline__ unsigned cvt_pk_bf16(float lo, float hi) { unsigned r; asm volatile("v_cvt_pk_bf16_f32 %0, %1, %2" : "=v"(r) : "v"(lo), "v"(hi)); return r; }

namespace pg8 {
constexpr int BM = 256, BK = 64, HALF = 128, HTB = HALF * BK * 2, STAGE_BYTES = 8 * HTB, NXCD = 8, WGM = 8;
__host__ __device__ __forceinline__ int lds_byte(int r, int c) { const int st = (r >> 4) * 2 + (c >> 5), rr = r & 15, cc = c & 31, ob = rr * 64 + cc * 2; return st * 1024 + (ob ^ (((ob >> 9) & 1) << 5)); }
__host__ __device__ __forceinline__ void stage_rc(int b, int& R, int& C) { const int st = b / 1024, sb = b % 1024, swz = sb ^ (((sb >> 9) & 1) << 5); R = (st >> 1) * 16 + swz / 64; C = (st & 1) * 32 + (swz % 64) / 2; }
__host__ __device__ __forceinline__ int perm32(int rho) { const int n = rho >> 4, i = rho & 15; return 8 * (i >> 2) + 4 * n + (i & 3); }

struct Unit { int pm, pn; };
struct Gemm { const bf16_t* A; const bf16_t* Bt; int K; const int* rowidx; };

struct StaticOrder {
    int nM, nN, nwg, G, c;
    __device__ void init(int M, int N, int G_, int c_) { nM = M / BM; nN = N / BM; nwg = nM * nN; G = G_; c = c_; }
    __device__ bool next(int i, Unit& u) const {
        const long L = (long)i * G + c; if (L >= nwg) return false;
        int wgid = (int)L; { const int q = nwg / NXCD, r = nwg % NXCD, xcd = wgid % NXCD, off = wgid / NXCD; wgid = (xcd < r ? xcd * (q + 1) : r * (q + 1) + (xcd - r) * q) + off; }
        const int nig = WGM * nN, gid = wgid / nig, fm = gid * WGM, gsz = (nM - fm) < WGM ? (nM - fm) : WGM;
        u.pm = fm + ((wgid % nig) % gsz); u.pn = (wgid % nig) / gsz; return true;
    }
};
struct RemapOrder {
    StaticOrder base; int from, off;
    __device__ bool next(int i, Unit& u) const { if (!base.next(i, u)) return false; if (u.pn >= from) u.pn += off; return true; }
};
struct MoeOrder {
    const LAS int* block_exp; int nblk, nN, G, c;
    __device__ bool next(int i, Unit& u) const {
        if (false && G == 256) {
            const int x = c >> 5, j = c & 31; int q = i * 32 + j;
#pragma unroll 1
            for (int k = 0; k < 4; ++k) { const int e = x + 8 * k; const int b0 = block_exp[600 + e], nb = block_exp[601 + e] - b0;
                if (q < nb * nN) { u.pm = b0 + q / nN; u.pn = e * nN + q % nN; return true; }
                q -= nb * nN; }
            return false;
        }
        if (G == 256) {
            const int x = c >> 5, j = c & 31, r0 = (x * nblk) >> 3, r1 = ((x + 1) * nblk) >> 3, q = i * 32 + j;
            const int rb = r0 + q / nN; if (rb >= r1) return false;
            u.pm = rb; u.pn = block_exp[rb] * nN + q % nN; return true; }
        const long L = (long)i * G + c; if (L >= (long)nblk * nN) return false;
        const int rb = (int)(L / nN), pnl = (int)(L % nN);
        u.pm = rb; u.pn = block_exp[rb] * nN + pnl; return true;
    }
};

template <class Epi, class Sched, bool GATHER, bool I8 = false, bool F8 = false>
__device__ __forceinline__ void gemm_phase(LAS unsigned char* lds, const Gemm g, const Sched& S, const Epi& E) {
    int tid = threadIdx.x; asm volatile("" : "+v"(tid));
    const int wid = __builtin_amdgcn_readfirstlane(tid >> 6), lane = tid & 63, wr = wid >> 2, wc = wid & 3, fr = lane & 15, fq = lane >> 4;
    const int K = g.K, nt = K / BK;
    unsigned voffA0[2], voffA1[2], voffB[2], nvA0[2], nvA1[2]; int RA[2], CA[2];
    const size_t hstep = (size_t)HALF * K * 2;
    const size_t tstep = 2 * hstep;
#pragma unroll
    for (int i = 0; i < 2; ++i) { int R, C; stage_rc(tid * 16 + i * 8192, R, C); const int Rb = Epi::PERM ? ((R & ~31) + perm32(R & 31)) : R;
        RA[i] = R; CA[i] = C;
        voffA0[i] = (unsigned)(R * K + C) * 2u; voffA1[i] = voffA0[i] + (unsigned)hstep; voffB[i] = (unsigned)(Rb * K + C) * 2u; nvA0[i] = voffA0[i]; nvA1[i] = voffA1[i]; }
    const size_t kstep = (size_t)(BK * 2);
    const unsigned ldsw = (unsigned)wid * 1024u;
    const int aoff = lds_byte(wr * 64 + fr, fq * 8), boff = lds_byte(wc * 32 + fr, fq * 8);
#define PG8_SA(b, h) (((b) * 2 + (h)) * HTB)
#define PG8_SB(b, h) ((4 + (b) * 2 + (h)) * HTB)
#define PG8_STAGE(bufoff, gbase, voff) do { _Pragma("unroll") for (int _i = 0; _i < 2; ++_i) \
        __builtin_amdgcn_global_load_lds((const unsigned*)((const char*)(gbase) + (voff)[_i]), (LAS unsigned*)(lds + (bufoff) + ldsw + _i * 8192), 16, 0, 0); } while (0)
#define PG8_LDA(dst, b, h) do { if constexpr (F8) { _Pragma("unroll") for (int m = 0; m < 4; ++m) { const i32x4 lo_ = *(const LAS i32x4*)(lds + PG8_SA(b, h) + aoff + m * 2048), hi_ = *(const LAS i32x4*)(lds + PG8_SA(b, h) + aoff + m * 2048 + 1024); dst##8[m] = __builtin_shufflevector(lo_, hi_, 0, 1, 2, 3, 4, 5, 6, 7); } } \
        else { _Pragma("unroll") for (int m = 0; m < 4; ++m) _Pragma("unroll") for (int k = 0; k < 2; ++k) dst[m][k] = *(const LAS bf16x8*)(lds + PG8_SA(b, h) + aoff + m * 2048 + k * 1024); } } while (0)
#define PG8_LDB(dst, b, h) do { if constexpr (F8) { _Pragma("unroll") for (int n = 0; n < 2; ++n) { const i32x4 lo_ = *(const LAS i32x4*)(lds + PG8_SB(b, h) + boff + n * 2048), hi_ = *(const LAS i32x4*)(lds + PG8_SB(b, h) + boff + n * 2048 + 1024); dst##8[n] = __builtin_shufflevector(lo_, hi_, 0, 1, 2, 3, 4, 5, 6, 7); } } \
        else { _Pragma("unroll") for (int n = 0; n < 2; ++n) _Pragma("unroll") for (int k = 0; k < 2; ++k) dst[n][k] = *(const LAS bf16x8*)(lds + PG8_SB(b, h) + boff + n * 2048 + k * 1024); } } while (0)
#define PG8_MMA(ai, bj, At, Bt) do { __builtin_amdgcn_s_setprio(1); _Pragma("unroll") for (int m = 0; m < 4; ++m) _Pragma("unroll") for (int n = 0; n < 2; ++n) { \
        if constexpr (F8) { asm volatile("v_mfma_scale_f32_16x16x128_f8f6f4 %0, %1, %2, %0, %3, %3 op_sel_hi:[0,0,0]" : "+v"(acc[ai][bj][m][n]) : "v"(Bt##8[n]), "v"(At##8[m]), "v"(mxone)); } \
        else { _Pragma("unroll") for (int k = 0; k < 2; ++k) { \
          if constexpr (I8) { asm volatile("v_mfma_i32_16x16x64_i8 %0, %1, %2, %0" : "+v"(acc[ai][bj][m][n]) : "v"(Bt[n][k]), "v"(At[m][k])); } \
          else acc[ai][bj][m][n] = __builtin_bit_cast(acc_t, __builtin_amdgcn_mfma_f32_16x16x32_bf16(Bt[n][k], At[m][k], __builtin_bit_cast(f32x4, acc[ai][bj][m][n]), 0, 0, 0)); } } } __builtin_amdgcn_s_setprio(0); } while (0)
#define PG8_WAIT_V(n) asm volatile("s_waitcnt vmcnt(" #n ")" ::: "memory")
#define PG8_WAIT_L(n) asm volatile("s_waitcnt lgkmcnt(" #n ")" ::: "memory")
#define PG8_BAR __builtin_amdgcn_s_barrier()
#define PG8_SCHED __builtin_amdgcn_sched_barrier(0)
#define PG8_GLOAD(u, o0, o1) do { if constexpr (GATHER) { _Pragma("unroll") for (int _i = 0; _i < 2; ++_i) { \
        const int r0_ = g.rowidx[(u).pm * BM + RA[_i]], r1_ = g.rowidx[(u).pm * BM + HALF + RA[_i]]; \
        o0[_i] = (unsigned)(r0_ * K + CA[_i]) * 2u; o1[_i] = (unsigned)(r1_ * K + CA[_i]) * 2u; } } } while (0)
    LAS unsigned char* idxl = lds + STAGE_BYTES + 8192 + wid * 1024;
#define PG8_IDX_ISSUE(u, par) do { if constexpr (GATHER) { _Pragma("unroll") for (int _i = 0; _i < 2; ++_i) { const int* p0_ = g.rowidx + (u).pm * BM + RA[_i]; \
        __builtin_amdgcn_global_load_lds((const unsigned*)p0_, (LAS unsigned*)(idxl + (par) * 8192 + (2 * _i) * 256), 4, 0, 0); \
        __builtin_amdgcn_global_load_lds((const unsigned*)(p0_ + HALF), (LAS unsigned*)(idxl + (par) * 8192 + (2 * _i + 1) * 256), 4, 0, 0); } } } while (0)
    Unit cur, nxt, nn2; int ui = 0;
    if (!S.next(0, cur)) return;
    typedef typename Epi::acc_t acc_t;
    acc_t acc[2][2][4][2];
#pragma unroll
    for (int a = 0; a < 2; ++a)
#pragma unroll
        for (int b = 0; b < 2; ++b)
#pragma unroll
            for (int m = 0; m < 4; ++m)
#pragma unroll
                for (int n = 0; n < 2; ++n) acc[a][b][m][n] = acc_t{};
    bf16x8 At[4][2], B0[2][2], B1[2][2];
    int mxone = 0x7f7f7f7f; asm volatile("" : "+v"(mxone));
    i32x8 At8[4], B08[2], B18[2];
    PG8_GLOAD(cur, voffA0, voffA1);
    if constexpr (GATHER) { if (S.next(1, nn2)) PG8_IDX_ISSUE(nn2, 1); }
    E.stage(cur, lds + STAGE_BYTES, wid, lane);
    const char* cA = (const char*)g.A + (GATHER ? (size_t)0 : (size_t)cur.pm * tstep); const char* cB = (const char*)g.Bt + (size_t)cur.pn * tstep;
    PG8_STAGE(PG8_SB(0, 0), cB, voffB); PG8_STAGE(PG8_SB(0, 1), cB + hstep, voffB); PG8_STAGE(PG8_SA(0, 0), cA, voffA0); PG8_STAGE(PG8_SA(0, 1), cA, voffA1);
    if (wr == 1) PG8_BAR;
    PG8_WAIT_V(2); PG8_BAR;
    PG8_STAGE(PG8_SB(1, 0), cB + kstep, voffB); PG8_STAGE(PG8_SA(1, 0), cA + kstep, voffA0); PG8_STAGE(PG8_SB(1, 1), cB + hstep + kstep, voffB);
    PG8_WAIT_V(6); PG8_BAR;
    for (;;) {
        const bool has_next = S.next(ui + 1, nxt);
        const char* nA = has_next ? (const char*)g.A + (GATHER ? (size_t)0 : (size_t)nxt.pm * tstep) : cA; const char* nB = has_next ? (const char*)g.Bt + (size_t)nxt.pn * tstep : cB;
        for (int t = 0; t < nt; t += 2) {
            const bool last = (t == nt - 2);
            const char* a1 = cA + (size_t)(t + 1) * kstep;
            const char* a2 = last ? nA : cA + (size_t)(t + 2) * kstep; const char* b2 = last ? nB : cB + (size_t)(t + 2) * kstep;
            const char* a3 = a2 + kstep; const char* b3 = b2 + kstep;
            if (last && has_next) { int ln_ = lane; asm volatile("" : "+v"(ln_)); E.stage(nxt, lds + STAGE_BYTES + ((ui + 1) & 1) * 4096, wid, ln_); }
            if constexpr (GATHER) { if (last) { if (has_next) {
#pragma unroll
                    for (int _i = 0; _i < 2; ++_i) { const int r0_ = *(const LAS int*)(idxl + ((ui + 1) & 1) * 8192 + (2 * _i) * 256 + lane * 4), r1_ = *(const LAS int*)(idxl + ((ui + 1) & 1) * 8192 + (2 * _i + 1) * 256 + lane * 4);
                        nvA0[_i] = (unsigned)(r0_ * K + CA[_i]) * 2u; nvA1[_i] = (unsigned)(r1_ * K + CA[_i]) * 2u; }
                    if (S.next(ui + 2, nn2)) PG8_IDX_ISSUE(nn2, ui & 1);
                } else { nvA0[0] = voffA0[0]; nvA0[1] = voffA0[1]; nvA1[0] = voffA1[0]; nvA1[1] = voffA1[1]; } } }
            unsigned x0[2], x1[2];
#pragma unroll
            for (int _i = 0; _i < 2; ++_i) { x0[_i] = (GATHER && last) ? nvA0[_i] : voffA0[_i]; x1[_i] = (GATHER && last) ? nvA1[_i] : voffA1[_i]; }
            PG8_LDB(B0, 0, 0); PG8_LDB(B1, 0, 1); PG8_SCHED; PG8_LDA(At, 0, 0); PG8_STAGE(PG8_SA(1, 1), a1, voffA1);
            PG8_WAIT_V(8); PG8_WAIT_L(0); PG8_BAR; PG8_MMA(0, 0, At, B0); PG8_MMA(0, 1, At, B1); PG8_BAR; PG8_SCHED;
            PG8_LDA(At, 0, 1); PG8_STAGE(PG8_SB(0, 0), b2, voffB); PG8_STAGE(PG8_SB(0, 1), b2 + hstep, voffB); PG8_STAGE(PG8_SA(0, 0), a2, x0);
            PG8_WAIT_V(8); PG8_WAIT_L(0); PG8_BAR; PG8_MMA(1, 0, At, B0); PG8_MMA(1, 1, At, B1); PG8_BAR; PG8_SCHED;
            PG8_LDB(B0, 1, 0); PG8_LDB(B1, 1, 1); PG8_SCHED; PG8_LDA(At, 1, 0); PG8_STAGE(PG8_SA(0, 1), a2, x1);
            PG8_WAIT_V(8); PG8_WAIT_L(0); PG8_BAR; PG8_MMA(0, 0, At, B0); PG8_MMA(0, 1, At, B1); PG8_BAR; PG8_SCHED;
            PG8_LDA(At, 1, 1); PG8_STAGE(PG8_SB(1, 0), b3, voffB); PG8_STAGE(PG8_SB(1, 1), b3 + hstep, voffB); PG8_STAGE(PG8_SA(1, 0), a3, x0);
            PG8_WAIT_V(8); PG8_WAIT_L(0); PG8_BAR; PG8_MMA(1, 0, At, B0); PG8_MMA(1, 1, At, B1); PG8_BAR; PG8_SCHED;
        }
        if (wr == 0) PG8_BAR;
        if constexpr (F8 || I8) asm volatile("s_nop 15\n\ts_nop 15" ::: "memory");
        { int fr_ = fr, fq_ = fq; asm volatile("" : "+v"(fr_), "+v"(fq_));
          E(acc, cur, wr, wc, fr_, fq_, lds + STAGE_BYTES + (ui & 1) * 4096); }
        if (!has_next) break;
#pragma unroll
        for (int a = 0; a < 2; ++a)
#pragma unroll
            for (int b = 0; b < 2; ++b)
#pragma unroll
                for (int m = 0; m < 4; ++m)
#pragma unroll
                    for (int n = 0; n < 2; ++n) acc[a][b][m][n] = acc_t{};
        cur = nxt; cA = nA; cB = nB; ++ui;
        if constexpr (GATHER) { voffA0[0] = nvA0[0]; voffA0[1] = nvA0[1]; voffA1[0] = nvA1[0]; voffA1[1] = nvA1[1]; }
        if (wr == 1) PG8_BAR;
    }
    PG8_WAIT_V(0);
    PG8_BAR;
#undef PG8_IDX_ISSUE
#undef PG8_SA
#undef PG8_SB
#undef PG8_STAGE
#undef PG8_LDA
#undef PG8_LDB
#undef PG8_MMA
#undef PG8_WAIT_V
#undef PG8_WAIT_L
#undef PG8_BAR
#undef PG8_SCHED
#undef PG8_GLOAD
}
}
namespace pg8 {
struct EpiInProj {
    static constexpr bool PERM = true; typedef f32x4 acc_t;
    bf16_t *QA, *KA, *VA, *QI, *KIW, *QR, *KR, *VR, *GR;
    __device__ __forceinline__ void stage(const Unit&, LAS unsigned char*, int, int) const {}
    __device__ __forceinline__ void operator()(const f32x4 (&acc)[2][2][4][2], const Unit& u, int wr, int wc, int fr, int fq, LAS unsigned char* aux) const {
        const int row0 = u.pm * BM + wr * 64 + fr;
#pragma unroll
        for (int bj = 0; bj < 2; ++bj) {
            const int hb = u.pn * 2 + bj;
            bf16_t* base; int pitch; float sc = 1.f;
            if (hb < 4) { base = QA + hb * 128; pitch = 512; sc = QSCALE; }
            else if (hb == 4) { base = KA; pitch = 128; }
            else if (hb == 5) { base = VA; pitch = 128; }
            else if (hb < 8) { base = QI + (hb - 6) * 128; pitch = 256; sc = 0.125f; }
            else if (hb == 8) { base = KIW; pitch = 128; }
            else if (hb == 9) { continue; }
            else if (hb < 14) { base = QR + (hb - 10) * 128; pitch = 512; }
            else if (hb < 18) { base = KR + (hb - 14) * 128; pitch = 512; }
            else if (hb < 22) { base = VR + (hb - 18) * 128; pitch = 512; }
            else { base = GR + (hb - 22) * 128; pitch = 512; }
            const int col0 = wc * 32 + 8 * fq;
#pragma unroll
            for (int ai = 0; ai < 2; ++ai)
#pragma unroll
                for (int m = 0; m < 4; ++m) {
                    const f32x4 v0 = acc[ai][bj][m][0] * sc, v1 = acc[ai][bj][m][1] * sc;
                    u32x4 w; w.x = cvt_pk_bf16(v0[0], v0[1]); w.y = cvt_pk_bf16(v0[2], v0[3]); w.z = cvt_pk_bf16(v1[0], v1[1]); w.w = cvt_pk_bf16(v1[2], v1[3]);
                    *(u32x4*)(base + (size_t)(row0 + ai * HALF + m * 16) * pitch + col0) = w; }
        }
    }
};
struct EpiInProjI8 {
    static constexpr bool PERM = true; typedef i32x4 acc_t;
    bf16_t *QA, *KA, *VA, *QR, *KR, *VR, *GR; const float* srow; const float* scol;
    __device__ __forceinline__ void stage(const Unit& u, LAS unsigned char* aux, int wid, int lane) const {
        if (wid == 0) {
            __builtin_amdgcn_global_load_lds((const unsigned*)(srow + (size_t)u.pm * BM + lane * 4), (LAS unsigned*)(aux), 16, 0, 0);
            __builtin_amdgcn_global_load_lds((const unsigned*)(scol + (size_t)u.pn * BM + lane * 4), (LAS unsigned*)(aux + 1024), 16, 0, 0); }
    }
    __device__ __forceinline__ void operator()(const i32x4 (&acc)[2][2][4][2], const Unit& u, int wr, int wc, int fr, int fq, LAS unsigned char* aux) const {
        const int rl0 = wr * 64 + fr;
#pragma unroll
        for (int bj = 0; bj < 2; ++bj) {
            const int hb = u.pn * 2 + bj;
            bf16_t* base; int pitch; float sc = 1.f;
            if (hb < 4) { base = QA + hb * 128; pitch = 512; sc = QSCALE; }
            else if (hb == 4) { base = KA; pitch = 128; }
            else if (hb == 5) { base = VA; pitch = 128; }
            else if (hb < 14) { base = QR + (hb - 10) * 128; pitch = 512; }
            else if (hb < 18) { base = KR + (hb - 14) * 128; pitch = 512; }
            else if (hb < 22) { base = VR + (hb - 18) * 128; pitch = 512; }
            else { base = GR + (hb - 22) * 128; pitch = 512; }
            const int cl0 = wc * 32 + 8 * fq;
#pragma unroll
            for (int ai = 0; ai < 2; ++ai)
#pragma unroll
                for (int m = 0; m < 4; ++m) { const int rl = rl0 + ai * HALF + m * 16; const float sr = *(const LAS float*)(aux + rl * 4) * sc;
                    const f32x4 c0 = *(const LAS f32x4*)(aux + 1024 + (bj * HALF + cl0) * 4), c1 = *(const LAS f32x4*)(aux + 1024 + (bj * HALF + cl0 + 4) * 4);
                    const i32x4 a0 = acc[ai][bj][m][0], a1 = acc[ai][bj][m][1];
                    const f32x4 v0 = (f32x4){(float)a0[0], (float)a0[1], (float)a0[2], (float)a0[3]} * c0 * sr, v1 = (f32x4){(float)a1[0], (float)a1[1], (float)a1[2], (float)a1[3]} * c1 * sr;
                    u32x4 w; w.x = cvt_pk_bf16(v0[0], v0[1]); w.y = cvt_pk_bf16(v0[2], v0[3]); w.z = cvt_pk_bf16(v1[0], v1[1]); w.w = cvt_pk_bf16(v1[2], v1[3]);
                    *(u32x4*)(base + (size_t)(u.pm * BM + rl) * pitch + cl0) = w; asm volatile("" ::: "memory"); }
        }
    }
};
struct EpiOutProj {
    static constexpr bool PERM = true; typedef f32x4 acc_t;
    const float* mod; bf16_t* MIX;
    __device__ __forceinline__ void stage(const Unit&, LAS unsigned char*, int, int) const {}
    __device__ __forceinline__ void operator()(const f32x4 (&acc)[2][2][4][2], const Unit& u, int wr, int wc, int fr, int fq, LAS unsigned char* aux) const {
        const int row0 = u.pm * BM + wr * 64 + fr, col0 = u.pn * BM + wc * 32 + 8 * fq;
        const int b = (u.pm * BM) / SEQ;
        f32x4 gv[2][2];
#pragma unroll
        for (int bj = 0; bj < 2; ++bj)
#pragma unroll
            for (int n = 0; n < 2; ++n) gv[bj][n] = *(const f32x4*)(mod + (size_t)b * 6 * DM + 2 * DM + col0 + bj * HALF + 4 * n) + *(const f32x4*)(mod + 8 * 6 * DM + (size_t)b * 6 * DM + 2 * DM + col0 + bj * HALF + 4 * n) + 1.0f;
#pragma unroll
        for (int ai = 0; ai < 2; ++ai)
#pragma unroll
            for (int m = 0; m < 4; ++m) { bf16_t* rowp = MIX + (size_t)(row0 + ai * HALF + m * 16) * DM + col0;
#pragma unroll
                for (int bj = 0; bj < 2; ++bj) { const f32x4 v0 = acc[ai][bj][m][0] * gv[bj][0], v1 = acc[ai][bj][m][1] * gv[bj][1];
                    u32x4 w; w.x = cvt_pk_bf16(v0[0], v0[1]); w.y = cvt_pk_bf16(v0[2], v0[3]); w.z = cvt_pk_bf16(v1[0], v1[1]); w.w = cvt_pk_bf16(v1[2], v1[3]);
                    *(u32x4*)(rowp + bj * HALF) = w; } }
    }
};
struct EpiGateUp {
    static constexpr bool PERM = true; typedef i32x4 acc_t;
    unsigned char* act; const float* bgu; const float* swgu; const float* rowscale;
    __device__ __forceinline__ void stage(const Unit& u, LAS unsigned char* aux, int wid, int lane) const {
        if (wid == 0) { const int e = u.pn >> 3, pnl = u.pn & 7;
            __builtin_amdgcn_global_load_lds((const unsigned*)(bgu + (size_t)e * 2048 + (lane >> 5) * 1024 + pnl * 128 + (lane & 31) * 4), (LAS unsigned*)(aux), 16, 0, 0);
            __builtin_amdgcn_global_load_lds((const unsigned*)(swgu + (size_t)e * 2048 + pnl * 256 + lane * 4), (LAS unsigned*)(aux + 1024), 16, 0, 0);
            __builtin_amdgcn_global_load_lds((const unsigned*)(rowscale + (size_t)u.pm * BM + lane * 4), (LAS unsigned*)(aux + 2048), 16, 0, 0); }
    }
    __device__ __forceinline__ void operator()(const i32x4 (&acc)[2][2][4][2], const Unit& u, int wr, int wc, int fr, int fq, LAS unsigned char* aux) const {
        const int pnl = u.pn & 7;
        const int rl0 = wr * 64 + fr, j0 = wc * 32 + 8 * fq;
#pragma unroll
        for (int ai = 0; ai < 2; ++ai)
#pragma unroll
            for (int m = 0; m < 4; ++m) { const int rl = rl0 + ai * HALF + m * 16; const float sr = *(const LAS float*)(aux + 2048 + rl * 4);
                f32x2 ov[4];
#pragma unroll
                for (int q = 0; q < 4; ++q) { const i32x4 ga = acc[ai][0][m][q >> 1], ua = acc[ai][1][m][q >> 1];
                    f32x2 g2 = (q & 1) ? (f32x2){(float)ga[2], (float)ga[3]} : (f32x2){(float)ga[0], (float)ga[1]}; f32x2 u2 = (q & 1) ? (f32x2){(float)ua[2], (float)ua[3]} : (f32x2){(float)ua[0], (float)ua[1]};
                    g2 = g2 * (*(const LAS f32x2*)(aux + 1024 + (j0 + 2 * q) * 4) * sr) + *(const LAS f32x2*)(aux + (j0 + 2 * q) * 4);
                    u2 = u2 * (*(const LAS f32x2*)(aux + 1536 + (j0 + 2 * q) * 4) * sr) + *(const LAS f32x2*)(aux + 512 + (j0 + 2 * q) * 4);
                    g2.x = fminf(g2.x, 7.0f); g2.y = fminf(g2.y, 7.0f); u2.x = __builtin_amdgcn_fmed3f(u2.x, -7.0f, 7.0f); u2.y = __builtin_amdgcn_fmed3f(u2.y, -7.0f, 7.0f);
                    f32x2 t = g2 * (-1.702f * LOG2E); t.x = __builtin_amdgcn_exp2f(t.x); t.y = __builtin_amdgcn_exp2f(t.y); t = t + 1.0f;
                    f32x2 sg; sg.x = __builtin_amdgcn_rcpf(t.x); sg.y = __builtin_amdgcn_rcpf(t.y);
                    ov[q] = (u2 + 1.0f) * (g2 * sg) * 8.0f; ov[q].x = __builtin_amdgcn_fmed3f(ov[q].x, -448.0f, 448.0f); ov[q].y = __builtin_amdgcn_fmed3f(ov[q].y, -448.0f, 448.0f); }
                int w0 = __builtin_amdgcn_cvt_pk_fp8_f32(ov[0].x, ov[0].y, 0, false); w0 = __builtin_amdgcn_cvt_pk_fp8_f32(ov[1].x, ov[1].y, w0, true);
                int w1 = __builtin_amdgcn_cvt_pk_fp8_f32(ov[2].x, ov[2].y, 0, false); w1 = __builtin_amdgcn_cvt_pk_fp8_f32(ov[3].x, ov[3].y, w1, true);
                u32x2 wv; wv.x = (unsigned)w0; wv.y = (unsigned)w1;
                { u32x2* ap_ = (u32x2*)(act + (size_t)(u.pm * BM + rl) * DFF + pnl * 128 + j0); asm volatile("global_store_dwordx2 %0, %1, off sc1" :: "v"(ap_), "v"(wv) : "memory"); } }
    }
};
struct EpiDown {
    static constexpr bool PERM = true; typedef f32x4 acc_t;
    unsigned char* Y; const float* bd; const float* row_gate; const float* swd;
    __device__ __forceinline__ void stage(const Unit& u, LAS unsigned char* aux, int wid, int lane) const {
        if (wid == 0) { const int e = u.pn >> 2, pnl = u.pn & 3;
            __builtin_amdgcn_global_load_lds((const unsigned*)(bd + (size_t)e * DM + pnl * BM + lane * 4), (LAS unsigned*)(aux), 16, 0, 0);
            __builtin_amdgcn_global_load_lds((const unsigned*)(row_gate + (size_t)u.pm * BM + lane * 4), (LAS unsigned*)(aux + 1024), 16, 0, 0);
            __builtin_amdgcn_global_load_lds((const unsigned*)(swd + (size_t)e * DM + pnl * BM + lane * 4), (LAS unsigned*)(aux + 2048), 16, 0, 0); }
    }
    __device__ __forceinline__ void operator()(const f32x4 (&acc)[2][2][4][2], const Unit& u, int wr, int wc, int fr, int fq, LAS unsigned char* aux) const {
        const int pnl = u.pn & 3;
        const int rl0 = wr * 64 + fr, cl0 = wc * 32 + 8 * fq;
#pragma unroll
        for (int ai = 0; ai < 2; ++ai)
#pragma unroll
            for (int m = 0; m < 4; ++m) { const int rl = rl0 + ai * HALF + m * 16; const float gt = *(const LAS float*)(aux + 1024 + rl * 4);
#pragma unroll
                for (int bj = 0; bj < 2; ++bj) { const f32x4 b0 = *(const LAS f32x4*)(aux + (cl0 + bj * HALF) * 4), b1 = *(const LAS f32x4*)(aux + (cl0 + bj * HALF + 4) * 4);
                    const f32x4 c0 = *(const LAS f32x4*)(aux + 2048 + (cl0 + bj * HALF) * 4), c1 = *(const LAS f32x4*)(aux + 2048 + (cl0 + bj * HALF + 4) * 4);
                    f32x4 v0 = (acc[ai][bj][m][0] * c0 + b0) * gt, v1 = (acc[ai][bj][m][1] * c1 + b1) * gt;
#pragma unroll
                    for (int i = 0; i < 4; ++i) { v0[i] = __builtin_amdgcn_fmed3f(v0[i], -448.0f, 448.0f); v1[i] = __builtin_amdgcn_fmed3f(v1[i], -448.0f, 448.0f); }
                    int w0 = __builtin_amdgcn_cvt_pk_fp8_f32(v0[0], v0[1], 0, false); w0 = __builtin_amdgcn_cvt_pk_fp8_f32(v0[2], v0[3], w0, true);
                    int w1 = __builtin_amdgcn_cvt_pk_fp8_f32(v1[0], v1[1], 0, false); w1 = __builtin_amdgcn_cvt_pk_fp8_f32(v1[2], v1[3], w1, true);
                    u32x2 w; w.x = (unsigned)w0; w.y = (unsigned)w1;
                    *(u32x2*)(Y + (size_t)(u.pm * BM + rl) * DM + pnl * BM + cl0 + bj * HALF) = w; } }
    }
};
}
namespace attn_body {
constexpr int D = 64, QP = 512, KP = 128, VP = 128, OP = 1024;
constexpr int NW = 8, QBLK = 32, QB = QBLK * NW, KVBLK = 64;
__device__ __forceinline__ int crow(int r, int hi) { return (r & 3) + 8 * (r >> 2) + 4 * hi; }
#define SBAR() __builtin_amdgcn_sched_barrier(0)
constexpr int NSLOT = 3, SLOTB = 8192, MSLOT = 2048;
constexpr int LDS_K = 0, LDS_V = NSLOT * SLOTB, LDS_WS = 2 * NSLOT * SLOTB, LDS_OST = LDS_WS + NW * 64 * 4, LDS_M = LDS_OST + NW * 4096, LDS_BT = LDS_M + NSLOT * MSLOT, BT_N = 704, LDS_BYTES = LDS_BT + BT_N * 4;
__device__ __forceinline__ void glds16(const void* gsrc, unsigned lds_dst) { unsigned keep;
    asm volatile("s_mov_b32 %0, m0\n\ts_mov_b32 m0, %2\n\ts_nop 0\n\tglobal_load_lds_dwordx4 %1, off\n\ts_mov_b32 m0, %0" : "=&s"(keep) : "v"(gsrc), "s"(lds_dst) : "memory"); }
__device__ __forceinline__ void glds4(const void* gsrc, unsigned lds_dst) { unsigned keep;
    asm volatile("s_mov_b32 %0, m0\n\ts_mov_b32 m0, %2\n\ts_nop 0\n\tglobal_load_lds_dword %1, off\n\ts_mov_b32 m0, %0" : "=&s"(keep) : "v"(gsrc), "s"(lds_dst) : "memory"); }
__device__ __forceinline__ float max3f(float a, float b, float c) { float r; asm("v_max3_f32 %0, %1, %2, %3" : "=v"(r) : "v"(a), "v"(b), "v"(c)); return r; }
__device__ __forceinline__ float max2f(float a, float b) { float r; asm("v_max_f32_e32 %0, %1, %2" : "=v"(r) : "v"(a), "v"(b)); return r; }
__device__ __forceinline__ float fadd_s(float a, float b) { float r; asm("v_add_f32_e32 %0, %1, %2" : "=v"(r) : "v"(a), "v"(b)); return r; }
__device__ __forceinline__ float fsub_s(float a, float b) { float r; asm("v_sub_f32_e32 %0, %1, %2" : "=v"(r) : "v"(a), "v"(b)); return r; }
typedef __bf16 bf16x2_t __attribute__((ext_vector_type(2)));
__device__ __forceinline__ unsigned cvtpk_s(float lo, float hi) { f32x2 v = {lo, hi}; bf16x2_t b = __builtin_convertvector(v, bf16x2_t); return __builtin_bit_cast(unsigned, b); }
#define WAIT_BAR(N) asm volatile("s_waitcnt vmcnt(" #N ") lgkmcnt(0)\n\ts_barrier" ::: "memory")

__device__ __forceinline__ void qkt(f32x16& p0, f32x16& p1, const char* Kslot, const bf16x8* qr, const f32x16& negm, int r32, int hi) {
    const char* kb = Kslot + hi * 1024 + r32 * 16;
#pragma unroll
    for (int d0 = 0; d0 < 4; ++d0) {
        const bf16x8 b0 = *reinterpret_cast<const bf16x8*>(kb + d0 * 2048);
        const bf16x8 b1 = *reinterpret_cast<const bf16x8*>(kb + d0 * 2048 + 512);
        if (d0 == 0) { p0 = __builtin_amdgcn_mfma_f32_32x32x16_bf16(b0, qr[0], negm, 0, 0, 0); p1 = __builtin_amdgcn_mfma_f32_32x32x16_bf16(b1, qr[0], negm, 0, 0, 0); }
        else { p0 = __builtin_amdgcn_mfma_f32_32x32x16_bf16(b0, qr[d0], p0, 0, 0, 0); p1 = __builtin_amdgcn_mfma_f32_32x32x16_bf16(b1, qr[d0], p1, 0, 0, 0); } }
}
typedef LAS const char* lds_cptr;
typedef short v4i16_t __attribute__((ext_vector_type(4)));
__device__ __forceinline__ void kload8(bf16x8* kf, lds_cptr kp) {
    kf[0] = *(const LAS bf16x8*)(kp);        kf[1] = *(const LAS bf16x8*)(kp + 512);
    kf[2] = *(const LAS bf16x8*)(kp + 2048); kf[3] = *(const LAS bf16x8*)(kp + 2560);
    kf[4] = *(const LAS bf16x8*)(kp + 4096); kf[5] = *(const LAS bf16x8*)(kp + 4608);
    kf[6] = *(const LAS bf16x8*)(kp + 6144); kf[7] = *(const LAS bf16x8*)(kp + 6656);
}
__device__ __forceinline__ void kload2(bf16x8* kf, lds_cptr kp, int j) { kf[2 * j] = *(const LAS bf16x8*)(kp + j * 2048); kf[2 * j + 1] = *(const LAS bf16x8*)(kp + j * 2048 + 512); }
__device__ __forceinline__ s16x4 vtr(lds_cptr p) { return __builtin_bit_cast(s16x4, __builtin_amdgcn_ds_read_tr16_b64_v4i16((LAS v4i16_t*)p)); }
__device__ __forceinline__ float rowmax(const f32x16& p0, const f32x16& p1) {
    float a = max3f(p0[0], p0[1], p1[0]), b = max3f(p0[2], p0[3], p1[1]); a = max3f(a, p1[2], p1[3]);
#pragma unroll
    for (int r = 4; r < 16; r += 4) { a = max3f(a, p0[r], p0[r + 1]); b = max3f(b, p0[r + 2], p0[r + 3]); a = max3f(a, p1[r], p1[r + 1]); b = max3f(b, p1[r + 2], p1[r + 3]); }
    const float m = max2f(a, b);
    auto rr = __builtin_amdgcn_permlane32_swap(__float_as_uint(m), __float_as_uint(m), false, false);
    return max2f(__uint_as_float(rr[0]), __uint_as_float(rr[1]));
}
__device__ __forceinline__ void pv(f32x16* o, int vb, bf16x8 pa0, bf16x8 pa1, bf16x8 pa2, bf16x8 pa3) {
#pragma unroll
    for (int d0 = 0; d0 < 2; ++d0) { s16x4 lo[4], hi[4];
#pragma unroll
        for (int ks = 0; ks < 4; ++ks) {
            asm volatile("ds_read_b64_tr_b16 %0,%1 offset:%c2" : "=&v"(lo[ks]) : "v"(vb), "i"(d0 * 4096 + ks * 1024) : "memory");
            asm volatile("ds_read_b64_tr_b16 %0,%1 offset:%c2" : "=&v"(hi[ks]) : "v"(vb), "i"(d0 * 4096 + ks * 1024 + 512) : "memory"); }
        asm volatile("s_waitcnt lgkmcnt(0)" ::: "memory"); SBAR();
#define PK(k) (bf16x8){lo[k][0], lo[k][1], lo[k][2], lo[k][3], hi[k][0], hi[k][1], hi[k][2], hi[k][3]}
        o[d0] = __builtin_amdgcn_mfma_f32_32x32x16_bf16(pa0, PK(0), o[d0], 0, 0, 0);
        o[d0] = __builtin_amdgcn_mfma_f32_32x32x16_bf16(pa1, PK(1), o[d0], 0, 0, 0);
        o[d0] = __builtin_amdgcn_mfma_f32_32x32x16_bf16(pa2, PK(2), o[d0], 0, 0, 0);
        o[d0] = __builtin_amdgcn_mfma_f32_32x32x16_bf16(pa3, PK(3), o[d0], 0, 0, 0);
#undef PK
    }
}
__device__ __forceinline__ void apply_mask(f32x16& p0, f32x16& p1, unsigned w0, unsigned w1, float mh) {
#pragma unroll
    for (int r = 0; r < 16; ++r) { const int c = (r & 3) + 8 * (r >> 2);
        const unsigned m0 = (unsigned)__builtin_amdgcn_sbfe((int)w0, c, 1), m1 = (unsigned)__builtin_amdgcn_sbfe((int)w1, c, 1);
        p0[r] = __uint_as_float((__float_as_uint(p0[r] - mh) & m0) | (0xff800000u & ~m0));
        p1[r] = __uint_as_float((__float_as_uint(p1[r] - mh) & m1) | (0xff800000u & ~m1)); }
}
__device__ __forceinline__ void mask_init(f32x16& p0, f32x16& p1, unsigned w0, unsigned w1, float mh) {
    const unsigned nm = __float_as_uint(-mh);
#pragma unroll
    for (int r = 0; r < 16; ++r) { const int c = (r & 3) + 8 * (r >> 2);
        const unsigned m0 = (unsigned)__builtin_amdgcn_sbfe((int)w0, c, 1), m1 = (unsigned)__builtin_amdgcn_sbfe((int)w1, c, 1);
        p0[r] = __uint_as_float((nm & m0) | (0xff800000u & ~m0));
        p1[r] = __uint_as_float((nm & m1) | (0xff800000u & ~m1)); }
}
__device__ __forceinline__ void apply_bias(f32x16& p0, f32x16& p1, lds_cptr bp) {
#pragma unroll
    for (int r = 0; r < 16; ++r) { const int c = (r & 3) + 8 * (r >> 2);
        p0[r] += *(const LAS float*)(bp + 4 * c); p1[r] += *(const LAS float*)(bp + 4 * c + 128); }
}

#ifdef ABL_NOBIAS
#define ABL_NOBIAS_V 1
#else
#define ABL_NOBIAS_V 0
#endif
#ifndef ATTN_THRL
#define ATTN_THRL 8
#endif
__device__ __forceinline__ void attn_unit(int b, int h, int qb, const bf16_t* Q, const bf16_t* __restrict__ K, const bf16_t* __restrict__ V, bf16_t* O,
                                          const unsigned* __restrict__ mask, const float* __restrict__ rel_bias, char* shm, const bool build_bias = true) {
    constexpr int THRL = ATTN_THRL;
    const int tid = threadIdx.x, lane = tid & 63, r32 = lane & 31, hi = lane >> 5; const int wid = __builtin_amdgcn_readfirstlane(tid >> 6);
    const long rowbase = (long)b * SEQ; const int q0 = qb * QB; const int g = h >> 2;
    const bf16_t* Qw = Q + (rowbase + q0 + wid * QBLK) * QP + h * D;
    const bf16_t* Kh = K + rowbase * KP + g * D; const bf16_t* Vh = V + rowbase * VP + g * D;
    const unsigned lds0 = (unsigned)(uintptr_t)shm;
    float* wsf = (float*)(shm + LDS_WS) + wid * 64;
    const bf16_t* ksrc = Kh + (long)lane * KP + wid * 8;
    const bf16_t* vsrc = Vh + (long)(16 * (wid & 3) + (lane >> 2)) * VP + (wid >> 2) * 32 + (lane & 3) * 8;
    const unsigned* msrc = mask + ((size_t)b * 64 * SEQ + q0 + wid * QBLK) * 2 + lane;
    const unsigned kdst = lds0 + LDS_K + wid * 1024, vdst = lds0 + LDS_V + wid * 1024, mdst = lds0 + LDS_M + wid * 256;
#define DMA_K(t, slot) glds16(ksrc + (long)(t) * KVBLK * KP, (unsigned)__builtin_amdgcn_readfirstlane(kdst + (slot)))
#define DMA_V(t, slot) glds16(vsrc + (long)(t) * KVBLK * VP, (unsigned)__builtin_amdgcn_readfirstlane(vdst + (slot)))
#define DMA_M(t, slot) glds4(msrc + (size_t)(t) * SEQ * 2, (unsigned)__builtin_amdgcn_readfirstlane(mdst + ((slot) >> 2)))
    const int vb0 = (int)(lds0 + LDS_V) + ((lane >> 4) & 1) * 32 + (lane & 3) * 8 + (4 * hi + ((lane & 15) >> 2)) * 64;
    const char* Kbase = shm + LDS_K; bf16x8 kf[8];
    const lds_cptr shm3 = (lds_cptr)shm; const lds_cptr kp0 = shm3 + LDS_K + hi * 1024 + r32 * 16; const lds_cptr vp0 = shm3 + LDS_V + ((lane >> 4) & 1) * 32 + (lane & 3) * 8 + (4 * hi + ((lane & 15) >> 2)) * 64;
    const lds_cptr mp0 = shm3 + LDS_M + wid * 256 + r32 * 8;
    const int NT = (q0 + QB) / KVBLK;
    if (build_bias)
    { float* TR = (float*)(shm + LDS_BT); const float cfar = rel_bias[31 * 8 + h];
      for (int j = tid; j < BT_N; j += 512) { const int d = 447 - j; float v = 0.f;
          if (d >= 0 && d < 113) { int bk;
              if (d < 16) bk = d; else { bk = 16 + (d >= 19) + (d >= 21) + (d >= 24) + (d >= 27) + (d >= 31) + (d >= 35) + (d >= 40) + (d >= 46) + (d >= 52) + (d >= 59) + (d >= 67) + (d >= 77) + (d >= 87) + (d >= 99); }
              v = (rel_bias[bk * 8 + h] - cfar) * LOG2E; }
          TR[j] = v; } }
    DMA_K(0, 0); DMA_V(0, 0); DMA_K(1, SLOTB); DMA_M(0, 0); DMA_M(1, SLOTB);
    bf16x8 qr[4];
#pragma unroll
    for (int d0 = 0; d0 < 4; ++d0) qr[d0] = *reinterpret_cast<const bf16x8*>(&Qw[(long)r32 * QP + d0 * 16 + hi * 8]);
    float mhat = 0.f, l_reg = 0.f; f32x16 o[2]; o[0] = f32x16{}; o[1] = f32x16{}; const f32x16 zero16 = f32x16{};
    const int qrel = wid * QBLK + r32;
#define BIASP(t) (shm3 + LDS_BT + 4 * (447 - qrel + 4 * hi - 64 * (NT - 4 - (t))))
    bool resc = false;
#define START(P0, P1) do { const float rm = rowmax(P0, P1); resc = false; \
    { const float dl = __builtin_fmaxf(rm, -256.f); mhat = fadd_s(mhat, dl); \
      _Pragma("unroll") for (int r = 0; r < 16; ++r) { P0[r] = fsub_s(P0[r], dl); P1[r] = fsub_s(P1[r], dl); } \
      } \
    _Pragma("unroll") for (int r = 0; r < 16; ++r) P0[r] = __builtin_amdgcn_exp2f(P0[r]); } while (0)
#define RESC() do { if (resc) { asm volatile("s_waitcnt lgkmcnt(0)" ::: "memory"); \
      _Pragma("unroll") for (int d_ = 0; d_ < 2; ++d_) _Pragma("unroll") for (int r = 0; r < 16; ++r) o[d_][r] *= wsf[crow(r, hi)]; } } while (0)
    f32x16 pA0, pA1, pB0, pB1;
    int sl_prev = 0, sl_cur = 0, sl_next = SLOTB;
#define ROT() do { sl_prev = sl_cur; sl_cur = sl_next; sl_next = (sl_next == (NSLOT - 1) * SLOTB) ? 0 : sl_next + SLOTB; } while (0)
    DMA_K(2, 2 * SLOTB);
    WAIT_BAR(3);
    u32x2 mw = *(const LAS u32x2*)(mp0);
    qkt(pA0, pA1, Kbase, qr, zero16, r32, hi); asm volatile("s_nop 15\n\ts_nop 7" : "+v"(pA0), "+v"(pA1));
    apply_mask(pA0, pA1, mw.x >> (4 * hi), mw.y >> (4 * hi), 0.f);
#ifndef ABL_NOBIAS
    if (NT <= 7) apply_bias(pA0, pA1, BIASP(0));
#endif
    START(pA0, pA1);
    _Pragma("unroll") for (int r = 0; r < 16; ++r) pA1[r] = __builtin_amdgcn_exp2f(pA1[r]);
    WAIT_BAR(0);
    DMA_K(3, 0); DMA_V(1, SLOTB); DMA_M(2, 2 * SLOTB);
    ROT();
    kload8(kf, kp0 + sl_cur);
    WAIT_BAR(3);
    s16x4 vlo[8], vhi[8]; u32x4 pw0, pw1, pw2, pw3;
#define PKW(P, B) cvtpk_s(P[B], P[B + 1])
#define PAF(k) __builtin_bit_cast(bf16x8, pw##k)
#define VFR(i) (bf16x8){vlo[i][0], vlo[i][1], vlo[i][2], vlo[i][3], vhi[i][0], vhi[i][1], vhi[i][2], vhi[i][3]}
#define PIN(x) asm volatile("" : "+v"(x))
#define MX3(a, b, c) __builtin_fmaxf(__builtin_fmaxf((a), (b)), (c))
#define GAPA(MF, A0, A1, A2, A3, W0, W1, PW) do { MF; sacc += A0; sacc += A1; sacc += A2; sacc += A3; PIN(sacc); W0; W1; PIN(PW); SBAR(); } while (0)
#define EX(v) __builtin_amdgcn_exp2f(v)
#define GAPB(MF, X, B) do { MF; X[B] = EX(X[B]); X[B + 1] = EX(X[B + 1]); X[B + 2] = EX(X[B + 2]); X[B + 3] = EX(X[B + 3]); PIN(X); SBAR(); } while (0)
#define VRD(i) do { vlo[i] = vtr(vp_ + (((i) >> 2) * 4096 + ((i) & 3) * 1024)); vhi[i] = vtr(vp_ + (((i) >> 2) * 4096 + ((i) & 3) * 1024 + 512)); } while (0)
#define KRD(G, j) do { if (G) { kload2(kf, kp0 + sl_next, j); SBAR(); } } while (0)
#define STEP(C0, C1, P0, P1, t, GK, GV, GM, GL, GB) do { SBAR(); \
    const lds_cptr vp_ = vp0 + sl_prev; \
    const u32x2 mw_ = *(const LAS u32x2*)(mp0 + (sl_cur >> 2)); \
    mask_init(C0, C1, mw_.x >> (4 * hi), mw_.y >> (4 * hi), mhat); \
    VRD(0); SBAR(); float sacc = (P0[0] + P0[1]); \
    GAPA(C0 = __builtin_amdgcn_mfma_f32_32x32x16_bf16(kf[0], qr[0], C0, 0, 0, 0), P0[2], P0[3], P0[4], P0[5],     pw0[0] = PKW(P0, 0), pw0[1] = PKW(P0, 2), pw0); \
    VRD(4); SBAR(); GAPA(C1 = __builtin_amdgcn_mfma_f32_32x32x16_bf16(kf[1], qr[0], C1, 0, 0, 0), P0[6], P0[7], P0[8], P0[9],     pw0[2] = PKW(P0, 4), pw0[3] = PKW(P0, 6), pw0); \
    VRD(1); SBAR(); GAPA(C0 = __builtin_amdgcn_mfma_f32_32x32x16_bf16(kf[2], qr[1], C0, 0, 0, 0),   P0[10], P0[11], P0[12], P0[13], pw1[0] = PKW(P0, 8), pw1[1] = PKW(P0, 10), pw1); \
    VRD(5); SBAR(); GAPA(C1 = __builtin_amdgcn_mfma_f32_32x32x16_bf16(kf[3], qr[1], C1, 0, 0, 0),   P0[14], P0[15], P1[0], P1[1],   pw1[2] = PKW(P0, 12), pw1[3] = PKW(P0, 14), pw1); \
    VRD(2); SBAR(); GAPA(C0 = __builtin_amdgcn_mfma_f32_32x32x16_bf16(kf[4], qr[2], C0, 0, 0, 0),   P1[2], P1[3], P1[4], P1[5],     pw2[0] = PKW(P1, 0), pw2[1] = PKW(P1, 2), pw2); \
    VRD(6); SBAR(); GAPA(C1 = __builtin_amdgcn_mfma_f32_32x32x16_bf16(kf[5], qr[2], C1, 0, 0, 0),   P1[6], P1[7], P1[8], P1[9],     pw2[2] = PKW(P1, 4), pw2[3] = PKW(P1, 6), pw2); \
    VRD(3); SBAR(); GAPA(C0 = __builtin_amdgcn_mfma_f32_32x32x16_bf16(kf[6], qr[3], C0, 0, 0, 0),   P1[10], P1[11], P1[12], P1[13], pw3[0] = PKW(P1, 8), pw3[1] = PKW(P1, 10), pw3); \
    VRD(7); SBAR(); GAPA(C1 = __builtin_amdgcn_mfma_f32_32x32x16_bf16(kf[7], qr[3], C1, 0, 0, 0),   P1[14], P1[15], 0.f, 0.f,       pw3[2] = PKW(P1, 12), pw3[3] = PKW(P1, 14), pw3); \
    l_reg += sacc; \
    if (GK) { DMA_K((t) + 3, sl_cur); } if (GV) { DMA_V((t) + 1, sl_next); } if (GM) { DMA_M((t) + 2, sl_prev); } \
    if (GB && !ABL_NOBIAS_V) { apply_bias(C0, C1, BIASP(t)); } \
    { float a = MX3(C0[0], C0[1], C1[0]), b = MX3(C0[2], C0[3], C1[1]); a = MX3(a, C1[2], C1[3]); \
      _Pragma("unroll") for (int r = 4; r < 16; r += 4) { a = MX3(a, C0[r], C0[r + 1]); b = MX3(b, C0[r + 2], C0[r + 3]); a = MX3(a, C1[r], C1[r + 1]); b = MX3(b, C1[r + 2], C1[r + 3]); } \
      float rm = __builtin_fmaxf(a, b); { auto rr = __builtin_amdgcn_permlane32_swap(__float_as_uint(rm), __float_as_uint(rm), false, false); rm = __builtin_fmaxf(__uint_as_float(rr[0]), __uint_as_float(rr[1])); } \
      resc = false; \
      if (__builtin_expect(__any(rm > (float)THRL), 0)) { const float dl = __builtin_fmaxf(rm, 0.f); mhat += dl; \
        _Pragma("unroll") for (int r = 0; r < 16; ++r) { C0[r] -= dl; C1[r] -= dl; } \
        const float f = __builtin_amdgcn_exp2f(-dl); l_reg *= f; if (hi == 0) wsf[r32] = f; resc = true; } } \
    SBAR(); \
    GAPB(o[0] = __builtin_amdgcn_mfma_f32_32x32x16_bf16(PAF(0), VFR(0), o[0], 0, 0, 0), C0, 0); \
    GAPB(o[1] = __builtin_amdgcn_mfma_f32_32x32x16_bf16(PAF(0), VFR(4), o[1], 0, 0, 0), C0, 4); \
    KRD(GL, 0); GAPB(o[0] = __builtin_amdgcn_mfma_f32_32x32x16_bf16(PAF(1), VFR(1), o[0], 0, 0, 0), C0, 8); \
    KRD(GL, 1); GAPB(o[1] = __builtin_amdgcn_mfma_f32_32x32x16_bf16(PAF(1), VFR(5), o[1], 0, 0, 0), C0, 12); \
    KRD(GL, 2); GAPB(o[0] = __builtin_amdgcn_mfma_f32_32x32x16_bf16(PAF(2), VFR(2), o[0], 0, 0, 0), C1, 0); \
    KRD(GL, 3); GAPB(o[1] = __builtin_amdgcn_mfma_f32_32x32x16_bf16(PAF(2), VFR(6), o[1], 0, 0, 0), C1, 4); \
    GAPB(o[0] = __builtin_amdgcn_mfma_f32_32x32x16_bf16(PAF(3), VFR(3), o[0], 0, 0, 0), C1, 8); \
    GAPB(o[1] = __builtin_amdgcn_mfma_f32_32x32x16_bf16(PAF(3), VFR(7), o[1], 0, 0, 0), C1, 12); \
    } while (0)
    int t = 1;
    for (; t + 7 < NT; t += 2) {
        STEP(pB0, pB1, pA0, pA1, t, true, true, true, true, false);     WAIT_BAR(3); RESC(); ROT();
        STEP(pA0, pA1, pB0, pB1, t + 1, true, true, true, true, false); WAIT_BAR(3); RESC(); ROT();
    }
#define ENDW(tt) do { if ((tt) + 3 < NT) { WAIT_BAR(3); } else if ((tt) + 2 < NT) { WAIT_BAR(2); } else { WAIT_BAR(0); } } while (0)
    for (; t + 1 < NT; t += 2) {
        STEP(pB0, pB1, pA0, pA1, t, (t + 3 < NT), (t + 1 < NT), (t + 2 < NT), (t + 1 < NT), (t + 7 >= NT));         ENDW(t);     RESC(); ROT();
        STEP(pA0, pA1, pB0, pB1, t + 1, (t + 4 < NT), (t + 2 < NT), (t + 3 < NT), (t + 2 < NT), (t + 8 >= NT));     ENDW(t + 1); RESC(); ROT();
    }
    STEP(pB0, pB1, pA0, pA1, NT - 1, false, false, false, false, true); RESC();
    { float sacc = pB0[0] + pB0[1]; _Pragma("unroll") for (int r = 2; r < 16; ++r) sacc += pB0[r]; _Pragma("unroll") for (int r = 0; r < 16; ++r) sacc += pB1[r]; l_reg += sacc;
      pw0 = (u32x4){PKW(pB0, 0), PKW(pB0, 2), PKW(pB0, 4), PKW(pB0, 6)}; pw1 = (u32x4){PKW(pB0, 8), PKW(pB0, 10), PKW(pB0, 12), PKW(pB0, 14)}; pw2 = (u32x4){PKW(pB1, 0), PKW(pB1, 2), PKW(pB1, 4), PKW(pB1, 6)}; pw3 = (u32x4){PKW(pB1, 8), PKW(pB1, 10), PKW(pB1, 12), PKW(pB1, 14)};
      SBAR(); pv(o, vb0 + sl_cur, PAF(0), PAF(1), PAF(2), PAF(3)); }
#undef PKW
#undef PAF
#undef VFR
#undef PIN
#undef MX3
#undef GAPA
#undef GAPB
#undef EX
#undef VRD
#undef KRD
#undef STEP
#undef ENDW
    { auto rr = __builtin_amdgcn_permlane32_swap(__float_as_uint(l_reg), __float_as_uint(l_reg), false, false); l_reg = __uint_as_float(rr[0]) + __uint_as_float(rr[1]); }
    if (hi == 0) wsf[32 + r32] = l_reg; asm volatile("s_waitcnt lgkmcnt(0)" ::: "memory");
    float rli[16];
#pragma unroll
    for (int r = 0; r < 16; ++r) rli[r] = __builtin_amdgcn_rcpf(wsf[32 + crow(r, hi)]);
    bf16_t* Ow = O + (rowbase + q0 + wid * QBLK) * OP + h * D;
    { bf16_t* stg = (bf16_t*)(shm + LDS_OST) + wid * 2048;
#pragma unroll
      for (int r = 0; r < 16; ++r) { const int orow = crow(r, hi);
#pragma unroll
          for (int d0 = 0; d0 < 2; ++d0) stg[orow * 64 + d0 * 32 + r32] = (bf16_t)f2bf(o[d0][r] * rli[r]
#ifdef ABL_NOATTN
              * 0.f
#endif
              ); }
      asm volatile("s_waitcnt lgkmcnt(0)" ::: "memory");
#pragma unroll
      for (int i = 0; i < 4; ++i) { const int row = i * 8 + (lane >> 3), ch = lane & 7; const u32x4 v = *(const u32x4*)(stg + row * 64 + ch * 8); *(u32x4*)(Ow + (long)row * OP + ch * 8) = v; } }
    asm volatile("s_waitcnt lgkmcnt(0)\n\ts_barrier" ::: "memory");
#undef DMA_K
#undef DMA_V
#undef DMA_M
#undef START
#undef RESC
#undef ROT
#undef BIASP
}
#undef SBAR
#undef WAIT_BAR
}
constexpr size_t MiB = 1u << 20;
constexpr size_t WS_CTL = 0, CTL_ZERO_BYTES = 1 * MiB;
constexpr size_t WS_MOD = 1 * MiB;
constexpr size_t WS_ROT = 2 * MiB;
constexpr size_t WS_TOPE = 4 * MiB;
constexpr size_t WS_GATE = WS_TOPE + 512 * 1024;
constexpr size_t WS_RANK = 5 * MiB;
constexpr size_t WS_POS = WS_RANK + 512 * 1024;
constexpr size_t WS_ROWTOK = 6 * MiB;
constexpr size_t WS_ROWGATE = 7 * MiB;
constexpr size_t WS_BLKEXP = 8 * MiB;
constexpr size_t WS_ROWSCALE = 9 * MiB;
constexpr size_t WS_WIN = 10 * MiB;
constexpr size_t WS_WOUT = 17 * MiB;
constexpr size_t WS_WGU = 20 * MiB;
constexpr size_t WS_SWGU = 100 * MiB;
constexpr size_t WS_WD = 148 * MiB;
constexpr size_t WS_SWD = 101 * MiB;
constexpr size_t WS_WINQ = 102 * MiB;
constexpr size_t WS_SWIN = 106 * MiB;
constexpr size_t WS_SH = 107 * MiB;
constexpr size_t WS_HQ = 108 * MiB;
constexpr size_t WS_X1 = 212 * MiB;
constexpr size_t WS_H2 = 340 * MiB;
constexpr size_t WS_STOK = 380 * MiB;
constexpr size_t WS_ACT = 404 * MiB;
constexpr size_t WS_Y = 676 * MiB;
constexpr size_t WS_END = 948 * MiB;
constexpr size_t WS_H = 404 * MiB;
constexpr size_t WS_QA = 468 * MiB, WS_KA = 500 * MiB, WS_VA = 508 * MiB, WS_QI = 516 * MiB, WS_KIW = 532 * MiB;
constexpr size_t WS_QR = 540 * MiB, WS_KR = 572 * MiB, WS_VR = 604 * MiB, WS_GR = 636 * MiB;
constexpr size_t WS_MIX = 468 * MiB;
constexpr size_t WS_MASK = 668 * MiB;
constexpr size_t WS_U = 684 * MiB;
constexpr size_t WS_S = 748 * MiB;
static_assert(WS_S + 32 * MiB <= WS_END, "ws map");
constexpr int CW_BAR = 4096;
constexpr int CW_QUEUE = 2048;
constexpr int CW_CNT = 1024;
constexpr int CW_AMAXIN = 240000;
constexpr int CW_AMAXD = 196608;
constexpr int CW_AMAX = 131072;

constexpr int NWAVES = 8;
constexpr int LDS_BYTES = 160 * 1024;

#define XB_TMO      128
#define XB_XCNT(j)  (256  + 64 * (j))
#define XB_XSUB(j)  (1280 + 64 * (j))
#define XB_XGEN(j)  (2304 + 64 * (j))
#define XB_TOP      3328
#define XB_TOPGEN   3392
#define XCD_BAR_WORDS 3456
#define XB_SPIN_CAP (1u << 22)
__device__ __forceinline__ unsigned xb_ld(unsigned* p)              { return __hip_atomic_load(p, __ATOMIC_RELAXED, __HIP_MEMORY_SCOPE_AGENT); }
__device__ __forceinline__ unsigned xb_add(unsigned* p, unsigned v) { return __hip_atomic_fetch_add(p, v, __ATOMIC_RELAXED, __HIP_MEMORY_SCOPE_AGENT); }
__device__ __forceinline__ unsigned xb_xcc_id() { return (unsigned)__builtin_amdgcn_s_getreg((3 << 11) | 20) & 0xFu; }
#define XB_SPIN(cond, bar) do { unsigned _sp = 0; while (cond) { __builtin_amdgcn_s_sleep(1); \
    if ((++_sp & 255u) == 0u) { if (xb_ld(&(bar)[XB_TMO])) break; if (_sp > XB_SPIN_CAP) { atomicAdd(&(bar)[XB_TMO], 1u); break; } } } } while (0)
struct XcdBarrier { unsigned* bar; unsigned x; volatile LAS unsigned* st; };
__device__ __forceinline__ XcdBarrier xcd_barrier_post(unsigned* bar, volatile LAS unsigned* st) {
    XcdBarrier b; b.bar = bar; b.x = xb_xcc_id(); b.st = st;
    if (threadIdx.x == 0) (void)xb_add(&bar[XB_XCNT(b.x)], 1u);
    return b;
}
__device__ __forceinline__ void xcd_barrier_complete(unsigned* bar, unsigned x, unsigned& nloc, unsigned& nx) {
    const unsigned G = gridDim.x * gridDim.y * gridDim.z;
    unsigned sum, cnt, mine, sp = 0u;
    for (;;) {
        sum = 0u; cnt = 0u; mine = 0u;
#pragma unroll
        for (unsigned j = 0; j < 16; ++j) { const unsigned c = xb_ld(&bar[XB_XCNT(j)]); sum += c; cnt += (c > 0u) ? 1u : 0u; mine = (j == x) ? c : mine; }
        if (sum == G) break;
        __builtin_amdgcn_s_sleep(1);
        if ((++sp & 255u) == 0u) { if (xb_ld(&bar[XB_TMO])) break; if (sp > XB_SPIN_CAP) { atomicAdd(&bar[XB_TMO], 1u); break; } }
    }
    nloc = mine > 0u ? mine : 1u; nx = cnt > 0u ? cnt : 1u;
}
__device__ __forceinline__ void xcd_barrier(const XcdBarrier& b) {
    asm volatile("s_waitcnt vmcnt(0)" ::: "memory");
    __syncthreads();
    if (threadIdx.x == 0) {
        unsigned* bar = b.bar;
        __builtin_amdgcn_s_waitcnt(0);
        unsigned nloc = b.st[0], nx = b.st[1];
        if (nloc == 0u) { xcd_barrier_complete(bar, b.x, nloc, nx); b.st[0] = nloc; b.st[1] = nx; }
        const unsigned old = xb_add(&bar[XB_XSUB(b.x)], 1u);
        const unsigned gen = old / nloc;
        if (old + 1u == (gen + 1u) * nloc) {
            __builtin_amdgcn_fence(__ATOMIC_RELEASE, "agent");
            asm volatile("s_waitcnt vmcnt(0)" ::: "memory");
            const unsigned og = xb_add(&bar[XB_TOP], 1u);
            const unsigned tg = og / nx;
            if (og + 1u == (tg + 1u) * nx) xb_add(&bar[XB_TOPGEN], 1u);
            else XB_SPIN(xb_ld(&bar[XB_TOPGEN]) == tg, bar);
            __builtin_amdgcn_fence(__ATOMIC_ACQUIRE, "agent");
            xb_add(&bar[XB_XGEN(b.x)], 1u);
            asm volatile("s_waitcnt vmcnt(0)" ::: "memory");
        } else {
            XB_SPIN(xb_ld(&bar[XB_XGEN(b.x)]) == gen, bar);
            __builtin_amdgcn_fence(__ATOMIC_ACQUIRE, "agent");
            asm volatile("s_waitcnt vmcnt(0)" ::: "memory");
        }
    }
    __syncthreads();
}

struct Frame {
    unsigned char* ws; int tid, lane, wave, vcu, G;
    const float *x, *c, *rel_bias, *w_ada, *b_ada, *w_in, *ret_g, *w_out, *ln1_g, *ln1_b, *w_router, *b_router, *w_gu, *b_gu, *w_d, *b_d, *ln2_g, *ln2_b;
    float* out;
};
__device__ __forceinline__ float wave_sum(float v) {
#pragma unroll
    for (int o = 1; o < 64; o <<= 1) v += __shfl_xor(v, o);
    return v;
}
__device__ __forceinline__ float wave_max(float v) {
#pragma unroll
    for (int o = 1; o < 64; o <<= 1) v = fmaxf(v, __shfl_xor(v, o));
    return v;
}
#define LDS_WAIT() asm volatile("s_waitcnt lgkmcnt(0)" ::: "memory")
__device__ __forceinline__ void p0_transpose_item(const float* W, int K, int N, int src_col0, bf16_t* WT, int dest_row0, int k0, LAS float* scr, int lane) {
#pragma unroll 8
    for (int i = 0; i < 32; ++i) { const int kk = 2 * i + (lane >> 5); scr[kk * 33 + (lane & 31)] = W[(size_t)(k0 + kk) * N + src_col0 + (lane & 31)]; }
    LDS_WAIT(); asm volatile("" ::: "memory");
    const int c = lane & 7;
#pragma unroll
    for (int j = 0; j < 4; ++j) { const int n = (lane >> 3) + 8 * j; const LAS float* s = scr + (8 * c) * 33 + n;
        u32x4 o; o.x = pk2(s[0 * 33], s[1 * 33]); o.y = pk2(s[2 * 33], s[3 * 33]); o.z = pk2(s[4 * 33], s[5 * 33]); o.w = pk2(s[6 * 33], s[7 * 33]);
        *(u32x4*)(WT + (size_t)(dest_row0 + n) * K + k0 + 8 * c) = o; }
    LDS_WAIT(); asm volatile("" ::: "memory");
}
__device__ __forceinline__ void p0_absmax_item(const float* W  , int N, int n0, int k0, unsigned* amax  , int lane) {
    const float* wp = W + (size_t)(k0 + (lane >> 5)) * N + n0 + (lane & 31);
    float m = 0.f;
#pragma unroll
    for (int i = 0; i < 32; ++i) m = fmaxf(m, fabsf(wp[(size_t)i * 2 * N]));
    { const unsigned u = __float_as_uint(m); auto r = __builtin_amdgcn_permlane32_swap(u, u, false, false); m = fmaxf(__uint_as_float(r[0]), __uint_as_float(r[1])); }
    if (lane < 32) atomicMax(amax + lane, __float_as_uint(m));
}
__device__ __forceinline__ void p1_quant_item(const float* W, int N, float widen, int n0, int k0, signed char* WQ  , const unsigned* amax, float* SW, LAS float* scr, int lane) {
    const float mx = widen * __uint_as_float(amax[lane & 31]); const float inv = mx > 0.f ? 127.0f / mx : 0.f;
    if (k0 == 0 && lane < 32) SW[lane] = mx > 0.f ? mx * (1.0f / 127.0f) : 1.0f;
    const float* wp = W + (size_t)(k0 + (lane >> 5)) * N + n0 + (lane & 31);
#pragma unroll
    for (int i = 0; i < 32; ++i) { const int kk = 2 * i + (lane >> 5); scr[kk * 33 + (lane & 31)] = wp[(size_t)i * 2 * N] * inv; }
    LDS_WAIT(); asm volatile("" ::: "memory");
    const int c = lane & 7;
#pragma unroll
    for (int j = 0; j < 4; ++j) { const int n = (lane >> 3) + 8 * j; const LAS float* sp = scr + (8 * c) * 33 + n;
        int q[8];
#pragma unroll
        for (int t = 0; t < 8; ++t) q[t] = (int)rintf(fminf(fmaxf(sp[t * 33], -127.0f), 127.0f)) & 0xff;
        u32x2 o; o.x = (unsigned)(q[0] | (q[1] << 8) | (q[2] << 16) | (q[3] << 24)); o.y = (unsigned)(q[4] | (q[5] << 8) | (q[6] << 16) | (q[7] << 24));
        *(u32x2*)(WQ + (size_t)n * 1024 + k0 + 8 * c) = o; }
    LDS_WAIT(); asm volatile("" ::: "memory");
}
__device__ __forceinline__ void p1_fp8_item(const float* W  , int n0, int k0, unsigned char* WQ  , const unsigned* amax, float* SW, LAS float* scr, int lane) {
    const float mx = 1.25f * __uint_as_float(amax[lane & 31]); const float inv = mx > 0.f ? 224.0f / mx : 0.f;
    if (k0 == 0 && lane < 32) SW[lane] = (mx > 0.f ? mx * (1.0f / 224.0f) : 1.0f) * 0.125f;
    const float* wp = W + (size_t)(k0 + (lane >> 5)) * 1024 + n0 + (lane & 31);
#pragma unroll
    for (int i = 0; i < 32; ++i) { const int kk = 2 * i + (lane >> 5); scr[kk * 33 + (lane & 31)] = __builtin_amdgcn_fmed3f(wp[(size_t)i * 2048] * inv, -448.0f, 448.0f); }
    LDS_WAIT(); asm volatile("" ::: "memory");
    const int c = lane & 7;
#pragma unroll
    for (int j = 0; j < 4; ++j) { const int n = (lane >> 3) + 8 * j; const LAS float* sp = scr + (8 * c) * 33 + n;
        int w0 = __builtin_amdgcn_cvt_pk_fp8_f32(sp[0 * 33], sp[1 * 33], 0, false); w0 = __builtin_amdgcn_cvt_pk_fp8_f32(sp[2 * 33], sp[3 * 33], w0, true);
        int w1 = __builtin_amdgcn_cvt_pk_fp8_f32(sp[4 * 33], sp[5 * 33], 0, false); w1 = __builtin_amdgcn_cvt_pk_fp8_f32(sp[6 * 33], sp[7 * 33], w1, true);
        u32x2 o; o.x = (unsigned)w0; o.y = (unsigned)w1;
        *(u32x2*)(WQ + (size_t)n * 1024 + k0 + 8 * c) = o; }
    LDS_WAIT(); asm volatile("" ::: "memory");
}
struct WqItem { const float* src; const unsigned* am; unsigned char* dst; float* sw; int N, kb; unsigned am4[4], am0; };
__device__ __forceinline__ void wq_issue(Frame& F, WqItem& it, LAS float* wq) {
    int ln_ = F.lane; asm volatile("" : "+v"(ln_));
    const float* wsrc = it.src + (size_t)(ln_ >> 3) * it.N;
#pragma unroll
    for (int j = 0; j < 8; ++j) __builtin_amdgcn_global_load_lds((const unsigned*)(wsrc + (size_t)(8 * j) * it.N + 4 * ((ln_ & 7) ^ j)), (LAS unsigned*)((LAS unsigned char*)wq + j * 1024), 16, 0, 0);
#pragma unroll
    for (int j = 0; j < 4; ++j) it.am4[j] = it.am[(ln_ >> 3) + 8 * j];
    it.am0 = it.am[ln_ & 31];
}
__device__ __forceinline__ void wq_issue_gu(Frame& F, WqItem& it, LAS float* wq, const int r) {
    const int e = r >> 10, nb = (r & 1023) >> 4; it.kb = r & 15; const int n0 = 32 * nb, k0 = 64 * it.kb;
    const int drow = ((n0 & 1023) >> 7) * 256 + (n0 >> 10) * 128 + (n0 & 127);
    it.N = 2048; it.src = F.w_gu + (size_t)e * DM * 2048 + (size_t)k0 * 2048 + n0; it.am = (const unsigned*)(F.ws + WS_CTL) + CW_AMAX + e * 2048 + drow;
    it.dst = (unsigned char*)(F.ws + WS_WGU) + ((size_t)e * 2048 + drow) * 1024 + k0; it.sw = (float*)(F.ws + WS_SWGU) + e * 2048 + drow;
    wq_issue(F, it, wq);
}
__device__ __forceinline__ void wq_issue_d(Frame& F, WqItem& it, LAS float* wq, const int r) {
    const int e = r >> 9, nb = (r & 511) >> 4; it.kb = r & 15; const int n0 = 32 * nb, k0 = 64 * it.kb;
    it.N = 1024; it.src = F.w_d + (size_t)e * DFF * DM + (size_t)k0 * 1024 + n0; it.am = (const unsigned*)(F.ws + WS_CTL) + CW_AMAXD + e * 1024 + n0;
    it.dst = (unsigned char*)(F.ws + WS_WD) + ((size_t)e * 1024 + n0) * 1024 + k0; it.sw = (float*)(F.ws + WS_SWD) + e * 1024 + n0;
    wq_issue(F, it, wq);
}
template <bool FP8>
__device__ __forceinline__ void wq_convert(Frame& F, const WqItem& it, const LAS float* wq) {
    int ln_ = F.lane; asm volatile("" : "+v"(ln_));
    constexpr float QMAX = FP8 ? 224.0f : 127.0f;
    if (it.kb == 0 && ln_ < 32) { const float mx = 1.25f * __uint_as_float(it.am0); it.sw[ln_] = (mx > 0.f ? mx * (1.0f / QMAX) : 1.0f) * (FP8 ? 0.125f : 1.0f); }
    const int c = ln_ & 7;
#pragma unroll
    for (int j = 0; j < 4; ++j) { const int n = (ln_ >> 3) + 8 * j; const float mx = 1.25f * __uint_as_float(it.am4[j]); const float inv = mx > 0.f ? QMAX / mx : 0.f;
        const LAS float* sp = wq + (8 * c) * 32 + (((n >> 2) ^ c) << 2) + (n & 3);
        u32x2 o;
        if (FP8) { float v[8];
#pragma unroll
            for (int t = 0; t < 8; ++t) v[t] = __builtin_amdgcn_fmed3f(sp[t * 32] * inv, -448.0f, 448.0f);
            int w0 = __builtin_amdgcn_cvt_pk_fp8_f32(v[0], v[1], 0, false); w0 = __builtin_amdgcn_cvt_pk_fp8_f32(v[2], v[3], w0, true);
            int w1 = __builtin_amdgcn_cvt_pk_fp8_f32(v[4], v[5], 0, false); w1 = __builtin_amdgcn_cvt_pk_fp8_f32(v[6], v[7], w1, true);
            o.x = (unsigned)w0; o.y = (unsigned)w1;
        } else { int q[8];
#pragma unroll
            for (int t = 0; t < 8; ++t) q[t] = (int)rintf(fminf(fmaxf(sp[t * 32] * inv, -127.0f), 127.0f)) & 0xff;
            o.x = (unsigned)(q[0] | (q[1] << 8) | (q[2] << 16) | (q[3] << 24)); o.y = (unsigned)(q[4] | (q[5] << 8) | (q[6] << 16) | (q[7] << 24)); }
        *(u32x2*)(it.dst + (size_t)n * 1024 + 8 * c) = o; }
}
constexpr int P0_GU_MOVED = 2048;
constexpr int MOD2 = 8 * 6144;
__device__ __forceinline__ void p0_prologue(Frame& F, LAS unsigned char* lds) {
    LAS float* scr = (LAS float*)(lds + F.wave * 16384);
    const int gw = F.vcu * NWAVES + F.wave, NGW = F.G * NWAVES;
    bf16_t* WinT = (bf16_t*)(F.ws + WS_WIN); bf16_t* WoutT = (bf16_t*)(F.ws + WS_WOUT); unsigned* amaxgu = (unsigned*)(F.ws + WS_CTL) + CW_AMAX; unsigned* amaxd = (unsigned*)(F.ws + WS_CTL) + CW_AMAXD; unsigned* amaxin = (unsigned*)(F.ws + WS_CTL) + CW_AMAXIN;
    if (F.vcu < 192) {
        LAS float* red = (LAS float*)(lds + 32768);
        LAS float* sil = (LAS float*)(lds);
        for (int i = F.tid; i < 8 * DM; i += 512) { const float cv = F.c[i]; sil[i] = cv / (1.f + __expf(-cv)); }
        __syncthreads();
        for (int it = F.vcu; it < 192; it += F.G) {
            const int cg = it % 96, kh = it / 96; const int n = cg * 64 + F.lane, kw = kh * 512 + F.wave * 64; float a[8];
#pragma unroll
            for (int b = 0; b < 8; ++b) a[b] = 0.f;
            const float* wp = F.w_ada + (size_t)kw * 6144 + n;
#pragma unroll 1
            for (int k0 = 0; k0 < 64; k0 += 16) { float wv[16];
#pragma unroll
              for (int kk = 0; kk < 16; ++kk) wv[kk] = wp[(size_t)(k0 + kk) * 6144];
#pragma unroll
              for (int kq = 0; kq < 16; ++kq) { const int kk = k0 + kq;
                const float w = wv[kq];
#pragma unroll
                for (int b = 0; b < 8; ++b) a[b] = fmaf(sil[b * DM + kw + kk], w, a[b]);
            } }
#pragma unroll
            for (int b = 0; b < 8; ++b) red[(F.wave * 8 + b) * 64 + F.lane] = a[b];
            __syncthreads();
            { const int b = F.wave; float s = kh == 0 ? F.b_ada[n] : 0.f;
#pragma unroll
              for (int w = 0; w < 8; ++w) s += red[(w * 8 + b) * 64 + F.lane];
              ((float*)(F.ws + WS_MOD))[kh * MOD2 + b * 6144 + n] = s; }
            __syncthreads();
        }
    }
    {
        float* rc = (float*)(F.ws + WS_ROT); float* rs = rc + SEQ * 64;
        for (int i = (F.vcu * 512 + F.tid); i < SEQ * 64; i += F.G * 512) { const int t = i >> 6, j = i & 63;
            const float inv = 1.0f / powf(10000.0f, (float)(2 * j) / 128.0f); const float ang = (float)t * inv;
            const double rev = (double)ang * 0.15915494309189535; const float fr = (float)(rev - floor(rev));
            rc[i] = __builtin_amdgcn_cosf(fr); rs[i] = __builtin_amdgcn_sinf(fr); }
    }
    constexpr int I_IN_A = 10 * 16, I_IN_B = 0, I_OUT = 32 * 16, I_GU = 32 * 64 * 4, I_D = 32 * 32 * 4, I_PAD = 192;
    constexpr int I_INQ = (24 + 64) * 16;
    const int ngu0 = (F.G == 256) ? I_GU - P0_GU_MOVED : I_GU, nd0 = (F.G == 256) ? 0 : I_D;
    const int NITEMS = I_IN_A + I_IN_B + I_OUT + ngu0 + nd0 + I_PAD + I_INQ;
    for (int it = gw; it < NITEMS; it += NGW) {
        int r = it;
        if (r < ngu0) { const int e = r >> 8, q = r & 255, nb = q >> 2, kb = (q & 3) * 4; const int n0 = 32 * nb;
            const int half = n0 >> 10, nn = n0 & 1023; const int drow = (nn >> 7) * 256 + half * 128 + (nn & 127);
            p0_absmax_item(F.w_gu + (size_t)e * DM * 2048, 2048, n0, 64 * kb, amaxgu + e * 2048 + drow, F.lane); continue; } r -= ngu0;
        if (r < I_IN_A) { const int nb = 24 + (r >> 4), kb = r & 15; p0_transpose_item(F.w_in, DM, DIN_SRC, 32 * nb, WinT, 32 * nb, 64 * kb, scr, F.lane); continue; } r -= I_IN_A;
        if (r < I_OUT) { const int nb = r >> 4, kb = r & 15; p0_transpose_item(F.w_out, DM, DM, 32 * nb, WoutT, 32 * nb, 64 * kb, scr, F.lane); continue; } r -= I_OUT;
        if (r < nd0) { const int e = r >> 7, q = r & 127, nb = q >> 2, kb = (q & 3) * 4;
            p0_absmax_item(F.w_d + (size_t)e * DFF * DM, DM, 32 * nb, 64 * kb, amaxd + e * 1024 + 32 * nb, F.lane); continue; } r -= nd0;
        if (r >= I_PAD) { r -= I_PAD; const int nb = r >> 4, kb = r & 15; const int src = nb < 24 ? 32 * nb : 1092 + 32 * (nb - 24), dst = nb < 24 ? 32 * nb : 1280 + 32 * (nb - 24);
            p0_absmax_item(F.w_in, DIN_SRC, src, 64 * kb, amaxin + dst, F.lane); continue; }
        { const int row = 1088 + r;
          for (int k = F.lane; k < DM; k += 64) WinT[(size_t)row * DM + k] = (row < 1092) ? (bf16_t)f2bf(F.w_in[(size_t)k * DIN_SRC + row]) : (bf16_t)0; }
    }
}
__device__ __forceinline__ void p2_tail_calibration(Frame& F) {
    unsigned* amaxgu = (unsigned*)(F.ws + WS_CTL) + CW_AMAX; unsigned* amaxd = (unsigned*)(F.ws + WS_CTL) + CW_AMAXD;
    const int gw2 = ((int)blockIdx.x - 128) * NWAVES + F.wave;
    for (int r = gw2; r < 32 * 32 * 4; r += 1024) { const int e = r >> 7, q = r & 127, nb = q >> 2, kb = (q & 3) * 4;
        p0_absmax_item(F.w_d + (size_t)e * DFF * DM, DM, 32 * nb, 64 * kb, amaxd + e * 1024 + 32 * nb, F.lane); }
    for (int r = 32 * 64 * 4 - P0_GU_MOVED + gw2; r < 32 * 64 * 4; r += 1024) { const int e = r >> 8, q = r & 255, nb = q >> 2, kb = (q & 3) * 4; const int n0 = 32 * nb;
        const int half = n0 >> 10, nn = n0 & 1023; const int drow = (nn >> 7) * 256 + half * 128 + (nn & 127);
        p0_absmax_item(F.w_gu + (size_t)e * DM * 2048, 2048, n0, 64 * kb, amaxgu + e * 2048 + drow, F.lane); }
}
__device__ __forceinline__ void p1_modulate(Frame& F, LAS unsigned char* lds) {
    const int gw = F.vcu * NWAVES + F.wave, NGW = F.G * NWAVES;
    { LAS float* scr = (LAS float*)(lds + F.wave * 16384); signed char* WguQ = (signed char*)(F.ws + WS_WGU); float* SWgu = (float*)(F.ws + WS_SWGU); const unsigned* amaxgu = (const unsigned*)(F.ws + WS_CTL) + CW_AMAX;
      for (int r = 16 * BATCH * 256 + gw; r < 32 * 64 * 16; r += NGW) { const int e = r >> 10, q = r & 1023, nb = q >> 4, kb = q & 15; const int n0 = 32 * nb;
          const int half = n0 >> 10, nn = n0 & 1023; const int drow = (nn >> 7) * 256 + half * 128 + (nn & 127);
          p1_quant_item(F.w_gu + (size_t)e * DM * 2048, 2048, 1.25f, n0, 64 * kb, WguQ + ((size_t)e * 2048 + drow) * 1024, amaxgu + e * 2048 + drow, SWgu + e * 2048 + drow, scr, F.lane); }
      { signed char* WinQ = (signed char*)(F.ws + WS_WINQ); float* SWin = (float*)(F.ws + WS_SWIN); const unsigned* amaxin = (const unsigned*)(F.ws + WS_CTL) + CW_AMAXIN;
        for (int r = gw; r < (24 + 64) * 16; r += NGW) { const int nb = r >> 4, kb = r & 15; const int src = nb < 24 ? 32 * nb : 1092 + 32 * (nb - 24), dst = nb < 24 ? 32 * nb : 1280 + 32 * (nb - 24);
            p1_quant_item(F.w_in, DIN_SRC, 1.0f, src, 64 * kb, WinQ + (size_t)dst * 1024, amaxin + dst, SWin + dst, scr, F.lane); } }
      unsigned char* WdQ = (unsigned char*)(F.ws + WS_WD); float* SWd = (float*)(F.ws + WS_SWD); const unsigned* amaxd = (const unsigned*)(F.ws + WS_CTL) + CW_AMAXD;
      for (int r = 16 * 1024 + gw; r < 32 * 32 * 16; r += NGW) { const int e = r >> 9, q = r & 511, nb = q >> 4, kb = q & 15;
          p1_fp8_item(F.w_d + (size_t)e * DFF * DM, 32 * nb, 64 * kb, WdQ + ((size_t)e * 1024 + 32 * nb) * 1024, amaxd + e * 1024 + 32 * nb, SWd + e * 1024 + 32 * nb, scr, F.lane); } }
    const float* mod = (const float*)(F.ws + WS_MOD); bf16_t* H = (bf16_t*)(F.ws + WS_H);
    unsigned* HQ = (unsigned*)(F.ws + WS_HQ); float* SH = (float*)(F.ws + WS_SH);
    LAS f32x4* mv = (LAS f32x4*)lds;
    __syncthreads();
    for (int i = F.tid; i < 8 * 256; i += 512) { const int b = i >> 8, c = i & 255;
        mv[(b * 2) * 256 + c] = ((const f32x4*)(mod + (size_t)b * 6144 + DM))[c] + ((const f32x4*)(mod + MOD2 + (size_t)b * 6144 + DM))[c] + 1.0f;
        mv[(b * 2 + 1) * 256 + c] = ((const f32x4*)(mod + (size_t)b * 6144))[c] + ((const f32x4*)(mod + MOD2 + (size_t)b * 6144))[c]; }
    __syncthreads();
    f32x4 nx[4];
    if (gw < NTOK) {
#pragma unroll
        for (int j = 0; j < 4; ++j) nx[j] = ((const f32x4*)(F.x + (size_t)gw * DM) + F.lane)[64 * j]; }
    for (int m = gw; m < NTOK; m += NGW) {
        const int b = m / SEQ;
        unsigned long long* o8 = (unsigned long long*)(H + (size_t)m * DM) + F.lane;
        f32x4 v[4]; float amx = 0.f;
#pragma unroll
        for (int j = 0; j < 4; ++j) v[j] = nx[j];
        if (m + NGW < NTOK) {
#pragma unroll
            for (int j = 0; j < 4; ++j) nx[j] = ((const f32x4*)(F.x + (size_t)(m + NGW) * DM) + F.lane)[64 * j]; }
#pragma unroll
        for (int j = 0; j < 4; ++j) { v[j] = v[j] * mv[(b * 2) * 256 + F.lane + 64 * j] + mv[(b * 2 + 1) * 256 + F.lane + 64 * j];
            o8[64 * j] = (unsigned long long)pk2(v[j].x, v[j].y) | ((unsigned long long)pk2(v[j].z, v[j].w) << 32);
            amx = fmaxf(fmaxf(amx, fmaxf(fabsf(v[j].x), fabsf(v[j].y))), fmaxf(fabsf(v[j].z), fabsf(v[j].w))); }
        amx = wave_max(amx);
        const float inv = amx > 0.f ? 127.0f / amx : 0.f; unsigned* q8 = HQ + (size_t)m * (DM / 4) + F.lane;
#pragma unroll
        for (int j = 0; j < 4; ++j) q8[64 * j] = (unsigned)(((int)rintf(v[j].x * inv) & 0xff) | (((int)rintf(v[j].y * inv) & 0xff) << 8) | (((int)rintf(v[j].z * inv) & 0xff) << 16) | (((int)rintf(v[j].w * inv) & 0xff) << 24));
        if (F.lane == 0) SH[m] = amx > 0.f ? amx * (1.0f / 127.0f) : 1.0f;
    }
}
__device__ __forceinline__ unsigned sortable(float s) { s = s + 0.0f; const unsigned u = __float_as_uint(s); return (u & 0x80000000u) ? ~u : (u | 0x80000000u); }

__device__ __forceinline__ unsigned wave_max_u32(unsigned v, int lane) {
    v = max(v, (unsigned)__builtin_amdgcn_update_dpp(0, (int)v, 0xB1, 0xF, 0xF, false)); v = max(v, (unsigned)__builtin_amdgcn_update_dpp(0, (int)v, 0x4E, 0xF, 0xF, false));
    v = max(v, (unsigned)__builtin_amdgcn_update_dpp(0, (int)v, 0x141, 0xF, 0xF, false)); v = max(v, (unsigned)__builtin_amdgcn_update_dpp(0, (int)v, 0x140, 0xF, 0xF, false));
    { auto r = __builtin_amdgcn_permlane16_swap(v, v, false, false); v = max(r[0], r[1]); } { auto r = __builtin_amdgcn_permlane32_swap(v, v, false, false); v = max(r[0], r[1]); }
    return v; }
__device__ __forceinline__ unsigned wave_sum_u32(unsigned v, int lane) {
    v += (unsigned)__builtin_amdgcn_update_dpp(0, (int)v, 0xB1, 0xF, 0xF, false); v += (unsigned)__builtin_amdgcn_update_dpp(0, (int)v, 0x4E, 0xF, 0xF, false);
    v += (unsigned)__builtin_amdgcn_update_dpp(0, (int)v, 0x141, 0xF, 0xF, false); v += (unsigned)__builtin_amdgcn_update_dpp(0, (int)v, 0x140, 0xF, 0xF, false);
    { auto r = __builtin_amdgcn_permlane16_swap(v, v, false, false); v = r[0] + r[1]; } { auto r = __builtin_amdgcn_permlane32_swap(v, v, false, false); v = r[0] + r[1]; }
    return v; }
#define CNT_OP(OP, c, a, b) asm volatile("v_cmp_" OP "_u32 vcc, %1, %2\n\tv_addc_co_u32 %0, vcc, 0, %0, vcc" : "+v"(c) : "v"(a), "v"(b) : "vcc")
__device__ __forceinline__ void sel_search(const unsigned (&kk)[64], const int tqw, const int qw, const int nblk, const int lane, LAS unsigned* lmask, const int flags) {
        unsigned lo = 1u, hi = 0xfffffff0u; int clo = tqw + 1, chi = 0;
        if (!(flags & 64))
        { unsigned m = 0, mn = 0xffffffffu;
#pragma unroll
          for (int j = 0; j < 64; ++j) { m = max(m, kk[j]); mn = min(mn, kk[j] - 1u); }
          m = wave_max_u32(m, lane); mn = ~wave_max_u32(~mn, lane);
          hi = __builtin_amdgcn_readfirstlane(m) + 1u; lo = __builtin_amdgcn_readfirstlane(mn) + 1u; }
        int diag_it = 0;
        bool done = (clo <= 256);
        float wlo = 1.0f, whi = 1.0f; int side = 0;
        for (int it = 0; it < ((flags & 8) ? 0 : (flags & 128) ? 4 : (flags & 256) ? 12 : (flags & 512) ? 24 : 128) && (!done || (flags & 128)); ++it) {
            const unsigned width = hi - lo;
            unsigned cand;
            if (it == 0) cand = 0x80001000u;
            else if (it == 1 && hi <= 0x80001000u && lo < 0x80000000u) cand = 0x80000000u;
            else { const float flo = (__logf((float)clo + 0.5f) - 5.545177444f) * wlo, fhi = (__logf((float)chi + 0.5f) - 5.545177444f) * whi; const float fr = flo * __builtin_amdgcn_rcpf(flo - fhi);
                if (width <= 8192u) cand = lo + (unsigned)(fr * (float)width);
                else { const unsigned ul = (lo & 0x80000000u) ? (lo ^ 0x80000000u) : ~lo, uh = (hi & 0x80000000u) ? (hi ^ 0x80000000u) : ~hi;
                    const float fl = __uint_as_float(ul), fh = __uint_as_float(uh); const float fc = fl + fr * (fh - fl);
                    cand = sortable(fc); } }
            cand = max(lo + 1u, min(cand, hi - 1u));
            const unsigned cs = __builtin_amdgcn_readfirstlane(cand);
            unsigned c0_ = 0, c1_ = 0, c2_ = 0, c3_ = 0; int scnt = 0;
#pragma unroll
            for (int j = 0; j < 64; j += 8) { if (j < nblk) {
                unsigned long long m0, m1, m2, m3, m4, m5, m6, m7;
                if ((j & 8) == 0) {
                asm volatile("v_cmp_le_u32_e64 %[m0], %[cs], %[k0]\n\tv_cmp_le_u32_e64 %[m1], %[cs], %[k1]\n\tv_cmp_le_u32_e64 %[m2], %[cs], %[k2]\n\tv_cmp_le_u32_e64 %[m3], %[cs], %[k3]\n\t"
                             "v_cmp_le_u32_e64 %[m4], %[cs], %[k4]\n\tv_cmp_le_u32_e64 %[m5], %[cs], %[k5]\n\tv_cmp_le_u32_e64 %[m6], %[cs], %[k6]\n\tv_cmp_le_u32_e64 %[m7], %[cs], %[k7]\n\t"
                             "v_addc_co_u32_e64 %[c0], %[m0], 0, %[c0], %[m0]\n\tv_addc_co_u32_e64 %[c1], %[m1], 0, %[c1], %[m1]\n\tv_addc_co_u32_e64 %[c2], %[m2], 0, %[c2], %[m2]\n\tv_addc_co_u32_e64 %[c3], %[m3], 0, %[c3], %[m3]\n\t"
                             "v_addc_co_u32_e64 %[c0], %[m4], 0, %[c0], %[m4]\n\tv_addc_co_u32_e64 %[c1], %[m5], 0, %[c1], %[m5]\n\tv_addc_co_u32_e64 %[c2], %[m6], 0, %[c2], %[m6]\n\tv_addc_co_u32_e64 %[c3], %[m7], 0, %[c3], %[m7]"
                             : [c0] "+v"(c0_), [c1] "+v"(c1_), [c2] "+v"(c2_), [c3] "+v"(c3_), [m0] "=&s"(m0), [m1] "=&s"(m1), [m2] "=&s"(m2), [m3] "=&s"(m3), [m4] "=&s"(m4), [m5] "=&s"(m5), [m6] "=&s"(m6), [m7] "=&s"(m7)
                             : [cs] "s"(cs), [k0] "v"(kk[j]), [k1] "v"(kk[j + 1]), [k2] "v"(kk[j + 2]), [k3] "v"(kk[j + 3]), [k4] "v"(kk[j + 4]), [k5] "v"(kk[j + 5]), [k6] "v"(kk[j + 6]), [k7] "v"(kk[j + 7]));
                } else {
                int t0_, t1_, t2_, t3_, t4_, t5_, t6_, t7_;
                asm volatile("v_cmp_le_u32_e64 %[m0], %[cs], %[k0]\n\tv_cmp_le_u32_e64 %[m1], %[cs], %[k1]\n\tv_cmp_le_u32_e64 %[m2], %[cs], %[k2]\n\tv_cmp_le_u32_e64 %[m3], %[cs], %[k3]\n\t"
                             "v_cmp_le_u32_e64 %[m4], %[cs], %[k4]\n\tv_cmp_le_u32_e64 %[m5], %[cs], %[k5]\n\tv_cmp_le_u32_e64 %[m6], %[cs], %[k6]\n\tv_cmp_le_u32_e64 %[m7], %[cs], %[k7]\n\t"
                             "s_bcnt1_i32_b64 %[t0], %[m0]\n\ts_bcnt1_i32_b64 %[t1], %[m1]\n\ts_bcnt1_i32_b64 %[t2], %[m2]\n\ts_bcnt1_i32_b64 %[t3], %[m3]\n\t"
                             "s_bcnt1_i32_b64 %[t4], %[m4]\n\ts_bcnt1_i32_b64 %[t5], %[m5]\n\ts_bcnt1_i32_b64 %[t6], %[m6]\n\ts_bcnt1_i32_b64 %[t7], %[m7]\n\t"
                             "s_add_u32 %[t0], %[t0], %[t1]\n\ts_add_u32 %[t2], %[t2], %[t3]\n\ts_add_u32 %[t4], %[t4], %[t5]\n\ts_add_u32 %[t6], %[t6], %[t7]\n\t"
                             "s_add_u32 %[t0], %[t0], %[t2]\n\ts_add_u32 %[t4], %[t4], %[t6]\n\ts_add_u32 %[t0], %[t0], %[t4]\n\ts_add_u32 %[cnt], %[cnt], %[t0]"
                             : [cnt] "+s"(scnt), [m0] "=&s"(m0), [m1] "=&s"(m1), [m2] "=&s"(m2), [m3] "=&s"(m3), [m4] "=&s"(m4), [m5] "=&s"(m5), [m6] "=&s"(m6), [m7] "=&s"(m7),
                               [t0] "=&s"(t0_), [t1] "=&s"(t1_), [t2] "=&s"(t2_), [t3] "=&s"(t3_), [t4] "=&s"(t4_), [t5] "=&s"(t5_), [t6] "=&s"(t6_), [t7] "=&s"(t7_)
                             : [cs] "s"(cs), [k0] "v"(kk[j]), [k1] "v"(kk[j + 1]), [k2] "v"(kk[j + 2]), [k3] "v"(kk[j + 3]), [k4] "v"(kk[j + 4]), [k5] "v"(kk[j + 5]), [k6] "v"(kk[j + 6]), [k7] "v"(kk[j + 7])
                             : "scc"); } } }
            const int cnt = scnt + (int)__builtin_amdgcn_readfirstlane(wave_sum_u32((c0_ + c1_) + (c2_ + c3_), lane));
            if (cnt >= 256) { lo = cs; clo = cnt; wlo = 1.0f; if (side == 1) whi *= 0.5f; side = 1; }
            else { hi = cs; chi = cnt; whi = 1.0f; if (side == 2) wlo *= 0.5f; side = 2; }
            done = (clo == 256) || (hi - lo <= 1u); ++diag_it;
        }
        if (!(flags & 32)) {
#ifdef ABL_SELALL
          const unsigned thr = 1u;
#else
          const unsigned thr = __builtin_amdgcn_readfirstlane(lo);
#endif
          unsigned mlo = 0u, mhi = 0u;
#pragma unroll
          for (int j = 0; j < 64; ++j) { if (j < nblk) asm volatile("v_cmp_le_u32 vcc, %2, %3\n\ts_nop 1\n\tv_writelane_b32 %0, vcc_lo, %4\n\tv_writelane_b32 %1, vcc_hi, %4" : "+v"(mlo), "+v"(mhi) : "s"(thr), "v"(kk[j]), "i"(j) : "vcc"); }
          int ln = lane; asm volatile("" : "+v"(ln));
          u32x2 w; w.x = mlo; w.y = mhi; *(LAS u32x2*)((LAS unsigned char*)lmask + qw * 512 + ln * 8) = w; }
}
__device__ __forceinline__ int select_item(Frame& F, LAS unsigned char* lds, const int k, bool& staged, unsigned* qctr, volatile LAS unsigned* qslot, int flags) {
    const int b = k >> 8, qblk = 255 - (k & 255);
    unsigned kn_v = 0u; if (F.tid == 0) kn_v = __hip_atomic_fetch_add(qctr, 1u, __ATOMIC_RELAXED, __HIP_MEMORY_SCOPE_AGENT);
    const int lane = F.lane, wid = F.wave, qn = lane & 15, kq = lane >> 4;
    const int t0 = qblk * 16, ntile = qblk + 1;
    const bf16_t* QI = (const bf16_t*)(F.ws + WS_QI); const bf16_t* KIW = (const bf16_t*)(F.ws + WS_KIW);
    LAS unsigned char* kst = lds;
    LAS unsigned* lmask = (LAS unsigned*)(lds + 8 * 16400);
    const size_t rowq = (size_t)b * SEQ + t0 + qn;
    LAS unsigned char* qst = lds + 150016;
    if (!staged) { int ln2 = F.lane; asm volatile("" : "+v"(ln2)); const size_t row0 = (size_t)b * SEQ + t0;
        __builtin_amdgcn_global_load_lds((const unsigned*)(QI + (row0 + 2 * wid + (ln2 >> 5)) * 256 + (ln2 & 31) * 8), (LAS unsigned*)(qst + wid * 1024), 16, 0, 0);
        if (wid == 0) __builtin_amdgcn_global_load_lds((const unsigned*)(KIW + (row0 + ((ln2 & 31) >> 1)) * 128 + 64 + (ln2 & 1) * 2), (LAS unsigned*)(qst + 8192), 4, 0, 0); }
    unsigned key[32][4];
    int ibase_i = 16 * wid + 4 * kq; asm volatile("" : "+v"(ibase_i));
    const unsigned ibase = (unsigned)ibase_i;
    const int dq = t0 + qn - ibase_i;
    const int dqmin = __builtin_amdgcn_readfirstlane(t0 - (16 * wid + 12));
    const unsigned nidx = 4095u - ibase;
    int fragoff0 = (16 * wid + qn) * 128 + ((kq ^ (qn & 7)) << 4), fragoff1 = (16 * wid + qn) * 128 + (((4 + kq) ^ (qn & 7)) << 4); asm volatile("" : "+v"(fragoff0), "+v"(fragoff1));
    { int srow = F.tid >> 3; asm volatile("" : "+v"(srow));
      const int spc = (F.tid & 7) ^ (srow & 7);
      const bf16_t* gsrc0 = KIW + ((size_t)b * SEQ + srow) * 128 + spc * 8;
      LAS unsigned char* ldw = kst + wid * 1024;
      const int nsub = (t0 + 16 + 511) >> 9;
      if (!staged) {
          __syncthreads();
#pragma unroll
          for (int j = 0; j < 8; ++j) __builtin_amdgcn_global_load_lds((const unsigned*)(gsrc0 + (size_t)j * 64 * 128), (LAS unsigned*)(ldw + j * 8192), 16, 0, 0);
          asm volatile("s_waitcnt vmcnt(0)" ::: "memory");
          __syncthreads();
      }
      bf16x8 bq[4][2]; float wv[4];
#pragma unroll
      for (int h = 0; h < 4; ++h) {
#pragma unroll
          for (int s_ = 0; s_ < 2; ++s_) bq[h][s_] = *(const LAS bf16x8*)(qst + qn * 512 + (h * 64 + s_ * 32 + kq * 8) * 2);
          wv[h] = 0.5f * bf2f(*(const LAS unsigned short*)(qst + 8192 + qn * 8 + h * 2)); }
#pragma unroll
      for (int sb = 0; sb < 8; ++sb) {
          if (sb < nsub) {
              const bool more = (sb + 1 < nsub);
              if (more) {
#pragma unroll
                  for (int j = 0; j < 8; ++j) __builtin_amdgcn_global_load_lds((const unsigned*)(gsrc0 + (size_t)((sb + 1) * 512 + j * 64) * 128), (LAS unsigned*)(ldw + ((sb + 1) & 1) * 65536 + j * 8192), 16, 0, 0); }
              const LAS unsigned char* kb = kst + (sb & 1) * 65536;
              if (flags & 2048) {
#pragma unroll
                  for (int ii = 0; ii < 4; ++ii)
#pragma unroll
                      for (int r = 0; r < 4; ++r) key[sb * 4 + ii][r] = 0u;
              } else
#pragma unroll
              for (int ii = 0; ii < 4; ++ii) {
                  const int i = sb * 4 + ii;
                  const bf16x8 a0 = *(const LAS bf16x8*)(kb + fragoff0 + 16384 * ii), a1 = *(const LAS bf16x8*)(kb + fragoff1 + 16384 * ii);
                  f32x4 sc = {0.f, 0.f, 0.f, 0.f};
#pragma unroll
                  for (int h = 0; h < 4; ++h) { f32x4 c = {0.f, 0.f, 0.f, 0.f};
                      c = __builtin_amdgcn_mfma_f32_16x16x32_bf16(a0, bq[h][0], c, 0, 0, 0); c = __builtin_amdgcn_mfma_f32_16x16x32_bf16(a1, bq[h][1], c, 0, 0, 0);
#pragma unroll
                      for (int r = 0; r < 4; ++r) sc[r] = fmaf(wv[h], fmaxf(c[r], 0.f), sc[r]); }
#pragma unroll
                  for (int r = 0; r < 4; ++r) { const unsigned u = __float_as_uint(sc[r]);
                      const unsigned sk = u ^ ((unsigned)((int)u >> 31) | 0x80000000u);
                      key[i][r] = (sk & 0xfffff000u) | (nidx - (128u * i + r)); }
                  if (128 * i + 3 > dqmin) {
#pragma unroll
                      for (int r = 0; r < 4; ++r) key[i][r] = (128 * i + r <= dq) ? key[i][r] : 0u; }
              }
              asm volatile("s_waitcnt vmcnt(0)" ::: "memory");
              __syncthreads();
          } else {
#pragma unroll
              for (int ii = 0; ii < 4; ++ii)
#pragma unroll
                  for (int r = 0; r < 4; ++r) key[sb * 4 + ii][r] = 0u;
          }
      } }
    int knext = 0;
    constexpr int QPITCH = 16384 + 16;
    if (!(flags & 4096)) {
        unsigned kkA[64], kkB[64];
        int lo_ = lane; asm volatile("" : "+v"(lo_)); const LAS unsigned char* src = lds + wid * QPITCH + lo_ * 4;
        int qo = qn; asm volatile("" : "+v"(qo)); const int dsto = (qo & 7) * QPITCH + ibase_i * 4;
        if (F.tid == 0) qslot[0] = kn_v;
        __syncthreads();
        if ((qo >> 3) == 0) { LAS unsigned char* dst = lds + dsto;
#pragma unroll
            for (int i = 0; i < 32; ++i) { u32x4 v; v.x = key[i][0]; v.y = key[i][1]; v.z = key[i][2]; v.w = key[i][3]; *(LAS u32x4*)(dst + 512 * i) = v; } }
        __syncthreads();
#pragma unroll
        for (int j = 0; j < 64; ++j) kkA[j] = *(const LAS unsigned*)(src + 256 * j);
        __syncthreads();
        if ((qo >> 3) == 1) { LAS unsigned char* dst = lds + dsto;
#pragma unroll
            for (int i = 0; i < 32; ++i) { u32x4 v; v.x = key[i][0]; v.y = key[i][1]; v.z = key[i][2]; v.w = key[i][3]; *(LAS u32x4*)(dst + 512 * i) = v; } }
        __syncthreads();
#pragma unroll
        for (int j = 0; j < 64; ++j) kkB[j] = *(const LAS unsigned*)(src + 256 * j);
        knext = (int)qslot[0];
        __syncthreads();
        if (knext < BATCH * 256) { int srow = F.tid; asm volatile("" : "+v"(srow)); const int s7 = srow & 7; srow >>= 3;
            const bf16_t* gn = KIW + ((size_t)(knext >> 8) * SEQ + srow) * 128 + (s7 ^ (srow & 7)) * 8;
#pragma unroll
            for (int j = 0; j < 8; ++j) __builtin_amdgcn_global_load_lds((const unsigned*)(gn + (size_t)j * 64 * 128), (LAS unsigned*)(kst + wid * 1024 + j * 8192), 16, 0, 0);
            { int ln2 = F.lane; asm volatile("" : "+v"(ln2)); const size_t row0 = (size_t)(knext >> 8) * SEQ + (255 - (knext & 255)) * 16;
              __builtin_amdgcn_global_load_lds((const unsigned*)(QI + (row0 + 2 * wid + (ln2 >> 5)) * 256 + (ln2 & 31) * 8), (LAS unsigned*)(lds + 150016 + wid * 1024), 16, 0, 0);
              if (wid == 0) __builtin_amdgcn_global_load_lds((const unsigned*)(KIW + (row0 + ((ln2 & 31) >> 1)) * 128 + 64 + (ln2 & 1) * 2), (LAS unsigned*)(lds + 150016 + 8192), 4, 0, 0); } }
        WqItem wa, wb; LAS float* wq = (LAS float*)(lds + 65536 + wid * 8192);
        wq_issue_gu(F, wa, wq, 16 * k + wid);
        sel_search(kkA, t0 + wid, wid, ((t0 + wid) >> 6) + 1, lane, lmask, flags);
        asm volatile("s_waitcnt vmcnt(0)" ::: "memory");
        wq_convert<false>(F, wa, wq);
        asm volatile("s_waitcnt lgkmcnt(0)" ::: "memory");
        wq_issue_gu(F, wb, wq, 16 * k + 8 + wid);
        sel_search(kkB, t0 + 8 + wid, 8 + wid, ((t0 + 8 + wid) >> 6) + 1, lane, lmask, flags);
        asm volatile("s_waitcnt vmcnt(0)" ::: "memory");
        wq_convert<false>(F, wb, wq);
    }
    __syncthreads();
    staged = !(flags & 4096) && knext < BATCH * 256;
    { unsigned* mask = (unsigned*)(F.ws + ((flags & 4) ? WS_END : WS_MASK)); const int ntile64 = 4 * (t0 / 256 + 1);
      int tw = F.tid; asm volatile("" : "+v"(tw)); const int tl0 = tw >> 5, q = (tw >> 1) & 15, w = tw & 1;
      unsigned* mp = mask + (((size_t)b * 64 + tl0) * SEQ + t0 + q) * 2 + w; const LAS unsigned* lp = lmask + q * 128 + tl0 * 2 + w;
#pragma unroll 1
      for (int tl = tl0; tl < ntile64; tl += 16) { *mp = *lp; mp += (size_t)16 * SEQ * 2; lp += 32; } }
    if ((flags & 4096) && F.tid == 0) qslot[0] = kn_v;
    __syncthreads();
    if (flags & 4096) { knext = (int)qslot[0]; __syncthreads(); }
    return knext;
#undef CNT_OP
}
constexpr int RP = 272;
constexpr int RT = 128 * RP;
__device__ __forceinline__ void block_gemm128(f32x16 (&acc)[2], const LAS unsigned char* A, const LAS unsigned char* Bt, int wr, int wc, int r32, int hi) {
#pragma unroll
    for (int ks = 0; ks < 8; ++ks) {
        const bf16x8 a = *(const LAS bf16x8*)(A + (32 * wr + r32) * RP + ks * 32 + hi * 16);
#pragma unroll
        for (int n = 0; n < 2; ++n) { const bf16x8 bf = *(const LAS bf16x8*)(Bt + (64 * wc + 32 * n + r32) * RP + ks * 32 + hi * 16);
            acc[n] = __builtin_amdgcn_mfma_f32_32x32x16_bf16(bf, a, acc[n], 0, 0, 0); }
    }
}
__device__ __forceinline__ float ret_gamma_log2(int h) { return log2f(1.0f - exp2f(-5.0f - (float)h)); }

struct RetRaw { bf16x8 x1[2], x2[2]; };
struct RetRot { f32x4 c0[2], c1[2], s0[2], s1[2]; };
__device__ __forceinline__ void ret_ld(Frame& F, RetRaw& r, const bf16_t* src, int b, int h, int c) {
    const int i = F.tid >> 2, q = F.tid & 3; const bf16_t* row = src + ((size_t)b * SEQ + c * 128 + i) * 512 + h * 128;
#pragma unroll
    for (int m = 0; m < 2; ++m) { const int d0 = 8 * q + 32 * m; r.x1[m] = *(const bf16x8*)(row + d0); r.x2[m] = *(const bf16x8*)(row + d0 + 64); }
}
__device__ __forceinline__ void ret_ld_rot(Frame& F, RetRot& r, int c) {
    const float* rc = (const float*)(F.ws + WS_ROT); const float* rs = rc + SEQ * 64;
    const int i = F.tid >> 2, q = F.tid & 3; const size_t t = (size_t)(c * 128 + i);
#pragma unroll
    for (int m = 0; m < 2; ++m) { const int d0 = 8 * q + 32 * m;
        r.c0[m] = *(const f32x4*)(rc + t * 64 + d0); r.c1[m] = *(const f32x4*)(rc + t * 64 + d0 + 4); r.s0[m] = *(const f32x4*)(rs + t * 64 + d0); r.s1[m] = *(const f32x4*)(rs + t * 64 + d0 + 4); }
}
template <bool ROT, bool TR>
__device__ __forceinline__ void ret_st(Frame& F, LAS unsigned char* dst, const RetRaw& r, const RetRot& rr, float sc, float rowdecay_l2  ) {
    const int i = F.tid >> 2, q = F.tid & 3;
    const float rsc = sc * ((rowdecay_l2 != 0.f) ? exp2f(rowdecay_l2 * (float)(127 - i)) : 1.0f);
#pragma unroll
    for (int m = 0; m < 2; ++m) {
        const int d0 = 8 * q + 32 * m;
        float o1[8], o2[8];
        if (ROT) {
#pragma unroll
            for (int j = 0; j < 8; ++j) { const float a = bf2f((unsigned short)r.x1[m][j]), bb = bf2f((unsigned short)r.x2[m][j]); const float cs = j < 4 ? rr.c0[m][j] : rr.c1[m][j - 4], sn = j < 4 ? rr.s0[m][j] : rr.s1[m][j - 4];
                o1[j] = (a * cs - bb * sn) * rsc; o2[j] = (a * sn + bb * cs) * rsc; }
        } else {
#pragma unroll
            for (int j = 0; j < 8; ++j) { o1[j] = bf2f((unsigned short)r.x1[m][j]) * rsc; o2[j] = bf2f((unsigned short)r.x2[m][j]) * rsc; }
        }
        if (!TR) {
            u32x4 w1, w2; w1.x = pk2(o1[0], o1[1]); w1.y = pk2(o1[2], o1[3]); w1.z = pk2(o1[4], o1[5]); w1.w = pk2(o1[6], o1[7]);
            w2.x = pk2(o2[0], o2[1]); w2.y = pk2(o2[2], o2[3]); w2.z = pk2(o2[4], o2[5]); w2.w = pk2(o2[6], o2[7]);
            *(LAS u32x4*)(dst + i * RP + d0 * 2) = w1; *(LAS u32x4*)(dst + i * RP + (d0 + 64) * 2) = w2;
        } else {
#pragma unroll
            for (int j = 0; j < 8; ++j) { *(LAS bf16_t*)(dst + (d0 + j) * RP + i * 2) = (bf16_t)f2bf(o1[j]); *(LAS bf16_t*)(dst + (d0 + 64 + j) * RP + i * 2) = (bf16_t)f2bf(o2[j]); }
        }
    }
}
__device__ __forceinline__ void ret_state_item(Frame& F, LAS unsigned char* lds, int unit) {
    const int b = unit >> 7, h = (unit >> 5) & 3, c = unit & 31;
    const int lane = F.lane, wid = F.wave, wr = wid >> 1, wc = wid & 1, r32 = lane & 31, hi = lane >> 5;
    LAS unsigned char* Vt = lds; LAS unsigned char* Kt = lds + RT;
    const float lg = ret_gamma_log2(h);
    WqItem wa, wb; LAS float* wq = (LAS float*)(lds + 81920 + wid * 8192);
    { RetRaw rv, rk; RetRot rr; ret_ld(F, rv, (const bf16_t*)(F.ws + WS_VR), b, h, c); ret_ld(F, rk, (const bf16_t*)(F.ws + WS_KR), b, h, c); ret_ld_rot(F, rr, c);
      wq_issue_d(F, wa, wq, 16 * unit + wid);
      ret_st<false, true>(F, Vt, rv, rr, 1.0f, 0.f); ret_st<true, true>(F, Kt, rk, rr, 0.08838834764831845f, lg); }
    asm volatile("s_waitcnt vmcnt(0)" ::: "memory");
    wq_convert<true>(F, wa, wq);
    asm volatile("s_waitcnt lgkmcnt(0)" ::: "memory");
    wq_issue_d(F, wb, wq, 16 * unit + 8 + wid);
    __syncthreads();
    f32x16 acc[2]; acc[0] = f32x16{}; acc[1] = f32x16{};
    block_gemm128(acc, Vt, Kt, wr, wc, r32, hi);
    bf16_t* U = (bf16_t*)(F.ws + WS_U) + (size_t)unit * 16384;
#pragma unroll
    for (int n = 0; n < 2; ++n)
#pragma unroll
        for (int gq = 0; gq < 4; ++gq) { u32x2 w; w.x = pk2(acc[n][4 * gq], acc[n][4 * gq + 1]); w.y = pk2(acc[n][4 * gq + 2], acc[n][4 * gq + 3]);
            *(u32x2*)(U + (size_t)(32 * wr + r32) * 128 + 64 * wc + 32 * n + 8 * gq + 4 * hi) = w; }
    asm volatile("s_waitcnt vmcnt(0)" ::: "memory");
    wq_convert<true>(F, wb, wq);
    __syncthreads();
}
__device__ __forceinline__ void ret_scan(Frame& F) {
    const bf16_t* U = (const bf16_t*)(F.ws + WS_U); bf16_t* S = (bf16_t*)(F.ws + WS_S);
    const int nthr = F.G * 512;
    for (int idx = F.vcu * 512 + F.tid; idx < 32 * 4096; idx += nthr) {
        const int bh = idx >> 12, e4 = (idx & 4095) * 4, h = bh & 3;
        const float cd = exp2f(128.0f * ret_gamma_log2(h));
        f32x4 s = {0.f, 0.f, 0.f, 0.f};
        u32x2 uwv[31];
#pragma unroll
        for (int c = 0; c < 31; ++c) uwv[c] = *(const u32x2*)(U + ((size_t)(bh * 32 + c)) * 16384 + e4);
#pragma unroll
        for (int c = 0; c < 31; ++c) {
            const u32x2 uw = uwv[c];
            f32x4 u; u.x = __uint_as_float(uw.x << 16); u.y = __uint_as_float(uw.x & 0xffff0000u); u.z = __uint_as_float(uw.y << 16); u.w = __uint_as_float(uw.y & 0xffff0000u);
            s = s * cd + u;
            u32x2 w; w.x = pk2(s.x, s.y); w.y = pk2(s.z, s.w);
            *(u32x2*)(S + ((size_t)(bh * 32 + c + 1)) * 16384 + e4) = w;
        }
    }
}
__device__ __forceinline__ void ret_out_item(Frame& F, LAS unsigned char* lds, int unit) {
    const int b = unit >> 7, h = (unit >> 5) & 3, c = unit & 31;
    const int lane = F.lane, wid = F.wave, wr = wid >> 1, wc = wid & 1, r32 = lane & 31, hi = lane >> 5;
    LAS unsigned char* Qs = lds; LAS unsigned char* Ks = lds + RT; LAS unsigned char* Vt = lds + 2 * RT; LAS unsigned char* St = lds + 3 * RT;
    LAS float* red = (LAS float*)(lds + 4 * RT);
    const float lg = ret_gamma_log2(h);
    u32x2 gwv[2][4];
    { const size_t tok_ = (size_t)b * SEQ + c * 128 + 32 * wr + r32; const bf16_t* GR_ = (const bf16_t*)(F.ws + WS_GR) + tok_ * 512 + h * 128;
#pragma unroll
      for (int n = 0; n < 2; ++n)
#pragma unroll
          for (int gq = 0; gq < 4; ++gq) gwv[n][gq] = *(const u32x2*)(GR_ + 64 * wc + 32 * n + 8 * gq + 4 * hi); }
    { RetRaw rq, rk, rv; RetRot rr; u32x4 sv[4];
      ret_ld(F, rq, (const bf16_t*)(F.ws + WS_QR), b, h, c); ret_ld(F, rk, (const bf16_t*)(F.ws + WS_KR), b, h, c); ret_ld_rot(F, rr, c); ret_ld(F, rv, (const bf16_t*)(F.ws + WS_VR), b, h, c);
      const bf16_t* S = (const bf16_t*)(F.ws + WS_S) + (size_t)unit * 16384;
      if (c > 0) {
#pragma unroll
          for (int k = 0; k < 4; ++k) { const int i = F.tid + 512 * k; sv[k] = *(const u32x4*)(S + (i >> 4) * 128 + (i & 15) * 8); } }
      ret_st<true, false>(F, Qs, rq, rr, 1.0f, 0.f); ret_st<true, false>(F, Ks, rk, rr, 0.08838834764831845f, 0.f); ret_st<false, true>(F, Vt, rv, rr, 1.0f, 0.f);
      if (c > 0) {
#pragma unroll
          for (int k = 0; k < 4; ++k) { const int i = F.tid + 512 * k; *(LAS u32x4*)(St + (i >> 4) * RP + (i & 15) * 16) = sv[k]; } } }
    __syncthreads();
    f32x16 p[2]; p[0] = f32x16{}; p[1] = f32x16{};
    block_gemm128(p, Ks, Qs, wr, wc, r32, hi);
    __syncthreads();
    LAS unsigned char* Ps = Ks;
    { const int j = 32 * wr + r32;
#pragma unroll
      for (int n = 0; n < 2; ++n)
#pragma unroll
          for (int rg = 0; rg < 16; ++rg) { const int i = 64 * wc + 32 * n + (rg & 3) + 8 * (rg >> 2) + 4 * hi;
              const float v = (i >= j) ? p[n][rg] * exp2f(lg * (float)(i - j)) : 0.f;
              *(LAS bf16_t*)(Ps + i * RP + j * 2) = (bf16_t)f2bf(v); } }
    __syncthreads();
    f32x16 acc[2], cr[2]; acc[0] = f32x16{}; acc[1] = f32x16{}; cr[0] = f32x16{}; cr[1] = f32x16{};
    block_gemm128(acc, Ps, Vt, wr, wc, r32, hi);
    if (c > 0) block_gemm128(cr, Qs, St, wr, wc, r32, hi);
    const int i = 32 * wr + r32; const float qd = exp2f(lg * (float)(i + 1));
    float s1 = 0.f, s2 = 0.f;
#pragma unroll
    for (int n = 0; n < 2; ++n)
#pragma unroll
        for (int rg = 0; rg < 16; ++rg) { const float v = acc[n][rg] + qd * cr[n][rg]; acc[n][rg] = v; s1 += v; s2 += v * v; }
    s1 += __shfl_xor(s1, 32); s2 += __shfl_xor(s2, 32);
    if (hi == 0) { red[(wc * 128 + i) * 2] = s1; red[(wc * 128 + i) * 2 + 1] = s2; }
    __syncthreads();
    const float t1 = red[i * 2] + red[(128 + i) * 2], t2 = red[i * 2 + 1] + red[(128 + i) * 2 + 1];
    const float mean = t1 * (1.0f / 128.0f); const float var = fmaxf(t2 * (1.0f / 128.0f) - mean * mean, 0.f); const float rstd = 1.0f / sqrtf(var + LN_EPS);
    const size_t tok = (size_t)b * SEQ + c * 128 + i;
    bf16_t* CC = (bf16_t*)(F.ws + WS_H) + tok * 1024 + 512 + h * 128;
#pragma unroll
    for (int n = 0; n < 2; ++n)
#pragma unroll
        for (int gq = 0; gq < 4; ++gq) { const int col = 64 * wc + 32 * n + 8 * gq + 4 * hi;
            const u32x2 gw = gwv[n][gq]; const f32x4 ng = *(const f32x4*)(F.ret_g + h * 128 + col);
            float o[4];
#pragma unroll
            for (int k = 0; k < 4; ++k) { const unsigned short gb = (unsigned short)((k < 2 ? gw.x : gw.y) >> (16 * (k & 1))); const float gg = bf2f(gb);
                const float sl = gg / (1.0f + __expf(-gg)); o[k] = (acc[n][4 * gq + k] - mean) * rstd * ng[k] * sl
#ifdef ABL_NORET
                    * 0.f
#endif
                    ; }
            u32x2 w; w.x = pk2(o[0], o[1]); w.y = pk2(o[2], o[3]);
            *(u32x2*)(CC + col) = w; }
    __syncthreads();
}
constexpr int WRP = 1028;
__device__ __forceinline__ float dpp_f(float v, int ctrl_sel) {
    const int u = __float_as_int(v);
    switch (ctrl_sel) {
        case 0: return __int_as_float(__builtin_amdgcn_update_dpp(0, u, 0xB1, 0xF, 0xF, false));
        case 1: return __int_as_float(__builtin_amdgcn_update_dpp(0, u, 0x4E, 0xF, 0xF, false));
        case 2: return __int_as_float(__builtin_amdgcn_update_dpp(0, u, 0x141, 0xF, 0xF, false));
        default: return __int_as_float(__builtin_amdgcn_update_dpp(0, u, 0x140, 0xF, 0xF, false));
    }
}
__device__ __forceinline__ float part16(float v, int lane) { const unsigned u = __float_as_uint(v); auto r = __builtin_amdgcn_permlane16_swap(u, u, false, false); return __uint_as_float((lane & 16) ? r[0] : r[1]); }
__device__ __forceinline__ float part32(float v, int lane) { const unsigned u = __float_as_uint(v); auto r = __builtin_amdgcn_permlane32_swap(u, u, false, false); return __uint_as_float((lane & 32) ? r[0] : r[1]); }
__device__ __forceinline__ float wsum(float v, int lane) { v += dpp_f(v, 0); v += dpp_f(v, 1); v += dpp_f(v, 2); v += dpp_f(v, 3); v += part16(v, lane); v += part32(v, lane); return v; }
__device__ __forceinline__ float wmax(float v, int lane) { v = fmaxf(v, dpp_f(v, 0)); v = fmaxf(v, dpp_f(v, 1)); v = fmaxf(v, dpp_f(v, 2)); v = fmaxf(v, dpp_f(v, 3)); v = fmaxf(v, part16(v, lane)); v = fmaxf(v, part32(v, lane)); return v; }
__device__ __forceinline__ float rs32(float (&a)[32], int lane) {
#pragma unroll
    for (int e = 0; e < 16; ++e) { const bool up = (lane & 32) != 0; const float send = up ? a[e] : a[e + 16], keep = up ? a[e + 16] : a[e]; a[e] = keep + part32(send, lane); }
#pragma unroll
    for (int e = 0; e < 8; ++e) { const bool up = (lane & 16) != 0; const float send = up ? a[e] : a[e + 8], keep = up ? a[e + 8] : a[e]; a[e] = keep + part16(send, lane); }
#pragma unroll
    for (int e = 0; e < 4; ++e) { const bool up = (lane & 8) != 0; const float send = up ? a[e] : a[e + 4], keep = up ? a[e + 4] : a[e]; a[e] = keep + dpp_f(send, 3); }
#pragma unroll
    for (int e = 0; e < 2; ++e) { const bool up = (lane & 4) != 0; const float send = up ? a[e] : a[e + 2], keep = up ? a[e + 2] : a[e]; a[e] = keep + dpp_f(send, 2); }
    { const bool up = (lane & 2) != 0; const float send = up ? a[0] : a[1], keep = up ? a[1] : a[0]; a[0] = keep + dpp_f(send, 1); }
    return a[0] + dpp_f(a[0], 0);
}
__device__ __forceinline__ f32x4 ld_v1(const float* x, const bf16_t* mix, int tok, int lane, int j) {
    const f32x4 xv = ((const f32x4*)(x + (size_t)tok * DM) + lane)[64 * j]; const u32x2 w = ((const u32x2*)(mix + (size_t)tok * DM) + lane)[64 * j];
    f32x4 m; m.x = __uint_as_float(w.x << 16); m.y = __uint_as_float(w.x & 0xffff0000u); m.z = __uint_as_float(w.y << 16); m.w = __uint_as_float(w.y & 0xffff0000u);
    return xv * DN_ALPHA + m; }
__device__ __forceinline__ void p6_rows(Frame& F, LAS unsigned char* lds) {
    LAS float* wrt = (LAS float*)lds;
    LAS unsigned* lcnt = (LAS unsigned*)(lds + 32 * WRP * 4);
    LAS unsigned* lbase = lcnt + 32;
    for (int i = F.tid; i < DM * NEXP; i += 512) { const int k = i >> 5, e = i & 31; wrt[e * WRP + k] = F.w_router[i]; }
    const float* mod = (const float*)(F.ws + WS_MOD);
    bf16_t* X1 = (bf16_t*)(F.ws + WS_X1); unsigned* H2Q = (unsigned*)(F.ws + WS_H2); float* STOK = (float*)(F.ws + WS_STOK); const bf16_t* MIXp = (const bf16_t*)(F.ws + WS_MIX);
    int* tope = (int*)(F.ws + WS_TOPE); float* gate = (float*)(F.ws + WS_GATE); int* rank = (int*)(F.ws + WS_RANK);
    unsigned* gcnt = (unsigned*)(F.ws + WS_CTL) + CW_CNT;
    const int lane = F.lane;
    const float br = F.b_router[(lane >> 1) & 31];
    for (int chunk = F.vcu; chunk < NTOK / 128; chunk += F.G) {
        const int b = (chunk * 128) / SEQ;
        LAS f32x4* prm = (LAS f32x4*)(lds + 132096);
        if (F.tid < 32) lcnt[F.tid] = 0u;
        if (F.tid < 256) { prm[F.tid] = ((const f32x4*)(mod + (size_t)b * 6144 + 4 * DM))[F.tid] + ((const f32x4*)(mod + MOD2 + (size_t)b * 6144 + 4 * DM))[F.tid] + 1.0f;
            prm[256 + F.tid] = ((const f32x4*)(mod + (size_t)b * 6144 + 3 * DM))[F.tid] + ((const f32x4*)(mod + MOD2 + (size_t)b * 6144 + 3 * DM))[F.tid];
            prm[512 + F.tid] = ((const f32x4*)F.ln1_g)[F.tid]; prm[768 + F.tid] = ((const f32x4*)F.ln1_b)[F.tid]; }
        __syncthreads();
        const int tok0 = chunk * 128 + F.wave * 16;
        f32x4 nxa[4], nxb[4]; u32x2 nma[4], nmb[4];
#pragma unroll
        for (int j = 0; j < 4; ++j) { nxa[j] = ((const f32x4*)(F.x + (size_t)tok0 * DM) + lane)[64 * j]; nma[j] = ((const u32x2*)(MIXp + (size_t)tok0 * DM) + lane)[64 * j];
            nxb[j] = ((const f32x4*)(F.x + (size_t)(tok0 + 1) * DM) + lane)[64 * j]; nmb[j] = ((const u32x2*)(MIXp + (size_t)(tok0 + 1) * DM) + lane)[64 * j]; }
        for (int pp = 0; pp < 8; ++pp) {
            const int tok = tok0 + 2 * pp;
            f32x4 va[4], vb[4];
#pragma unroll
            for (int j = 0; j < 4; ++j) { f32x4 m;
                m.x = __uint_as_float(nma[j].x << 16); m.y = __uint_as_float(nma[j].x & 0xffff0000u); m.z = __uint_as_float(nma[j].y << 16); m.w = __uint_as_float(nma[j].y & 0xffff0000u); va[j] = nxa[j] * DN_ALPHA + m;
                m.x = __uint_as_float(nmb[j].x << 16); m.y = __uint_as_float(nmb[j].x & 0xffff0000u); m.z = __uint_as_float(nmb[j].y << 16); m.w = __uint_as_float(nmb[j].y & 0xffff0000u); vb[j] = nxb[j] * DN_ALPHA + m; }
            if (pp < 7) {
#pragma unroll
                for (int j = 0; j < 4; ++j) { nxa[j] = ((const f32x4*)(F.x + (size_t)(tok + 2) * DM) + lane)[64 * j]; nma[j] = ((const u32x2*)(MIXp + (size_t)(tok + 2) * DM) + lane)[64 * j];
                    nxb[j] = ((const f32x4*)(F.x + (size_t)(tok + 3) * DM) + lane)[64 * j]; nmb[j] = ((const u32x2*)(MIXp + (size_t)(tok + 3) * DM) + lane)[64 * j]; } }
            float sa = 0.f, sb = 0.f;
#pragma unroll
            for (int j = 0; j < 4; ++j) { sa += (va[j].x + va[j].y) + (va[j].z + va[j].w); sb += (vb[j].x + vb[j].y) + (vb[j].z + vb[j].w); }
            const float ma = wsum(sa, lane) * (1.f / DM), mb = wsum(sb, lane) * (1.f / DM); float qa = 0.f, qb = 0.f;
#pragma unroll
            for (int j = 0; j < 4; ++j) { va[j] = va[j] - ma; vb[j] = vb[j] - mb; qa += (va[j].x * va[j].x + va[j].y * va[j].y) + (va[j].z * va[j].z + va[j].w * va[j].w); qb += (vb[j].x * vb[j].x + vb[j].y * vb[j].y) + (vb[j].z * vb[j].z + vb[j].w * vb[j].w); }
            const float ra = 1.f / sqrtf(wsum(qa, lane) * (1.f / DM) + LN_EPS), rb = 1.f / sqrtf(wsum(qb, lane) * (1.f / DM) + LN_EPS);
            unsigned long long* xa = (unsigned long long*)(X1 + (size_t)tok * DM) + lane; unsigned long long* xb = (unsigned long long*)(X1 + (size_t)(tok + 1) * DM) + lane;
            unsigned* oa = H2Q + (size_t)tok * (DM / 4) + lane; unsigned* ob = H2Q + (size_t)(tok + 1) * (DM / 4) + lane;
            float amxa = 0.f, amxb = 0.f;
#pragma unroll
            for (int j = 0; j < 4; ++j) { const f32x4 sc1 = prm[lane + 64 * j], sh1 = prm[256 + lane + 64 * j]; const f32x4 g1j = prm[512 + lane + 64 * j], b1j = prm[768 + lane + 64 * j];
                const f32x4 x1a = va[j] * ra * g1j + b1j, x1b = vb[j] * rb * g1j + b1j;
                xa[64 * j] = (unsigned long long)pk2(x1a.x, x1a.y) | ((unsigned long long)pk2(x1a.z, x1a.w) << 32); xb[64 * j] = (unsigned long long)pk2(x1b.x, x1b.y) | ((unsigned long long)pk2(x1b.z, x1b.w) << 32);
                va[j] = x1a * sc1 + sh1; vb[j] = x1b * sc1 + sh1;
                amxa = fmaxf(fmaxf(amxa, fmaxf(fabsf(va[j].x), fabsf(va[j].y))), fmaxf(fabsf(va[j].z), fabsf(va[j].w)));
                amxb = fmaxf(fmaxf(amxb, fmaxf(fabsf(vb[j].x), fabsf(vb[j].y))), fmaxf(fabsf(vb[j].z), fabsf(vb[j].w))); }
            amxa = wmax(amxa, lane); amxb = wmax(amxb, lane);
            { const float ia = amxa > 0.f ? 127.0f / amxa : 0.f, ib = amxb > 0.f ? 127.0f / amxb : 0.f;
#pragma unroll
              for (int j = 0; j < 4; ++j) {
                  oa[64 * j] = (unsigned)(((int)rintf(va[j].x * ia) & 0xff) | (((int)rintf(va[j].y * ia) & 0xff) << 8) | (((int)rintf(va[j].z * ia) & 0xff) << 16) | (((int)rintf(va[j].w * ia) & 0xff) << 24));
                  ob[64 * j] = (unsigned)(((int)rintf(vb[j].x * ib) & 0xff) | (((int)rintf(vb[j].y * ib) & 0xff) << 8) | (((int)rintf(vb[j].z * ib) & 0xff) << 16) | (((int)rintf(vb[j].w * ib) & 0xff) << 24)); }
              if (lane == 0) { STOK[tok] = amxa > 0.f ? amxa * (1.0f / 127.0f) : 1.0f; STOK[tok + 1] = amxb > 0.f ? amxb * (1.0f / 127.0f) : 1.0f; } }
            float a[32], c[32];
            f32x2 vp[4][4];
#pragma unroll
            for (int j = 0; j < 4; ++j) { vp[j][0] = (f32x2){va[j].x, vb[j].x}; vp[j][1] = (f32x2){va[j].y, vb[j].y}; vp[j][2] = (f32x2){va[j].z, vb[j].z}; vp[j][3] = (f32x2){va[j].w, vb[j].w}; }
#pragma unroll
            for (int e = 0; e < 32; ++e) { f32x2 acc2 = {0.f, 0.f};
#pragma unroll
                for (int j = 0; j < 4; ++j) { const f32x4 w = *(const LAS f32x4*)(wrt + e * WRP + 4 * lane + 256 * j);
                    acc2 = vp[j][0] * w.x + acc2; acc2 = vp[j][1] * w.y + acc2; acc2 = vp[j][2] * w.z + acc2; acc2 = vp[j][3] * w.w + acc2; }
                a[e] = acc2.x; c[e] = acc2.y; }
            float lga = rs32(a, lane) + br, lgb = rs32(c, lane) + br;
            int ea[4], eb[4]; float xa4[4], xb4[4];
#pragma unroll
            for (int k = 0; k < 4; ++k) {
                const float m1 = wmax(lga, lane), m2 = wmax(lgb, lane);
                const unsigned long long b1_ = __ballot(lga == m1), b2_ = __ballot(lgb == m2);
                ea[k] = (__ffsll((long long)b1_) - 1) >> 1; eb[k] = (__ffsll((long long)b2_) - 1) >> 1; xa4[k] = m1; xb4[k] = m2;
                if ((lane >> 1) == ea[k]) lga = -INFINITY; if ((lane >> 1) == eb[k]) lgb = -INFINITY; }
            { const float e1 = __expf(xa4[1] - xa4[0]), e2 = __expf(xa4[2] - xa4[0]), e3 = __expf(xa4[3] - xa4[0]); const float inv = 1.f / (1.f + e1 + e2 + e3);
              const float f1 = __expf(xb4[1] - xb4[0]), f2 = __expf(xb4[2] - xb4[0]), f3 = __expf(xb4[3] - xb4[0]); const float jnv = 1.f / (1.f + f1 + f2 + f3);
              if (lane < 8) { const int k = lane & 3; const bool second = lane >= 4;
                  const int e = second ? (k == 0 ? eb[0] : k == 1 ? eb[1] : k == 2 ? eb[2] : eb[3]) : (k == 0 ? ea[0] : k == 1 ? ea[1] : k == 2 ? ea[2] : ea[3]);
                  const float gv = second ? (k == 0 ? 1.f : k == 1 ? f1 : k == 2 ? f2 : f3) * jnv : (k == 0 ? 1.f : k == 1 ? e1 : k == 2 ? e2 : e3) * inv;
                  const unsigned r = atomicAdd((unsigned*)&lcnt[e], 1u); const int tk = tok + (second ? 1 : 0);
                  tope[tk * 4 + k] = e; gate[tk * 4 + k] = gv; rank[tk * 4 + k] = (int)r; } }
        }
        __syncthreads();
        if (F.tid < 32) lbase[F.tid] = __hip_atomic_fetch_add(gcnt + F.tid, lcnt[F.tid], __ATOMIC_RELAXED, __HIP_MEMORY_SCOPE_AGENT);
        __syncthreads();
        { const int i = F.tid; const int tok = chunk * 128 + (i >> 2); rank[tok * 4 + (i & 3)] += (int)lbase[tope[tok * 4 + (i & 3)]]; }
        __syncthreads();
    }
}
__device__ __forceinline__ void p6b_scatter(Frame& F, LAS unsigned char* lds) {
    LAS int* pst = (LAS int*)lds; LAS int* cnts = pst + 32;
    unsigned* gcnt = (unsigned*)(F.ws + WS_CTL) + CW_CNT;
    if (F.tid == 0) { int acc = 0; for (int e = 0; e < 32; ++e) { const int c = (int)__hip_atomic_load(gcnt + e, __ATOMIC_RELAXED, __HIP_MEMORY_SCOPE_AGENT); cnts[e] = c; pst[e] = acc; acc += (c + 255) / 256 * 256; }
        pst[64] = acc; }
    __syncthreads();
    const int* tope = (const int*)(F.ws + WS_TOPE); const float* gate = (const float*)(F.ws + WS_GATE); const int* rank = (const int*)(F.ws + WS_RANK);
    int* pos = (int*)(F.ws + WS_POS); int* rowtok = (int*)(F.ws + WS_ROWTOK); float* rowgate = (float*)(F.ws + WS_ROWGATE); int* blkexp = (int*)(F.ws + WS_BLKEXP);
    const float* stok = (const float*)(F.ws + WS_STOK); float* rowscale = (float*)(F.ws + WS_ROWSCALE);
    for (int i = F.vcu * 512 + F.tid; i < NTOK * 4; i += F.G * 512) { const int e = tope[i]; const int d = pst[e] + rank[i]; pos[i] = d; rowtok[d] = i >> 2; rowgate[d] = gate[i] * 64.0f; rowscale[d] = stok[i >> 2]; }
    for (int i = F.vcu * 512 + F.tid; i < 32 * 256; i += F.G * 512) { const int e = i >> 8, r = cnts[e] + (i & 255); if (r < (cnts[e] + 255) / 256 * 256) { rowtok[pst[e] + r] = 0; rowgate[pst[e] + r] = 0.f; rowscale[pst[e] + r] = 0.f; } }
    if (F.vcu == 0) { const int nblk = pst[64] / 256;
        for (int rb = F.tid; rb < nblk; rb += 512) { int e = 0; for (int q = 1; q < 32; ++q) if (pst[q] <= rb * 256) e = q; blkexp[rb] = e; }
        if (F.tid == 0) blkexp[MAXBLK] = nblk;
        if (F.tid < 33) blkexp[600 + F.tid] = (F.tid < 32 ? pst[F.tid] : pst[64]) / 256; }
}
__device__ __forceinline__ void p9_final(Frame& F, LAS unsigned char* lds) {
    const int gw = F.vcu * NWAVES + F.wave, NGW = F.G * NWAVES, lane = F.lane;
    const float* mod = (const float*)(F.ws + WS_MOD); const bf16_t* X1 = (const bf16_t*)(F.ws + WS_X1); const unsigned char* Y = (const unsigned char*)(F.ws + WS_Y); const int* pos = (const int*)(F.ws + WS_POS);
    f32x4 g2[4], b2[4];
#pragma unroll
    for (int j = 0; j < 4; ++j) { g2[j] = ((const f32x4*)F.ln2_g)[lane + 64 * j]; b2[j] = ((const f32x4*)F.ln2_b)[lane + 64 * j]; }
    LAS f32x4* gfl = (LAS f32x4*)lds;
    for (int i = F.tid; i < 8 * 256; i += 512) gfl[i] = ((const f32x4*)(mod + (size_t)(i >> 8) * 6144 + 5 * DM))[i & 255] + ((const f32x4*)(mod + MOD2 + (size_t)(i >> 8) * 6144 + 5 * DM))[i & 255] + 1.0f;
    __syncthreads();
    int p1[4]; unsigned yn[4][4]; u32x2 xn[4];
    if (gw < NTOK) { int p0[4];
#pragma unroll
        for (int k = 0; k < 4; ++k) { p0[k] = pos[gw * 4 + k]; p1[k] = (gw + NGW < NTOK) ? pos[(gw + NGW) * 4 + k] : 0; }
#pragma unroll
        for (int j = 0; j < 4; ++j) {
#pragma unroll
            for (int k = 0; k < 4; ++k) yn[j][k] = *((const unsigned*)(Y + (size_t)p0[k] * DM) + lane + 64 * j);
            xn[j] = ((const u32x2*)(X1 + (size_t)gw * DM) + lane)[64 * j]; } }
    for (int tok = gw; tok < NTOK; tok += NGW) {
        const int b = tok / SEQ;
        unsigned yc[4][4]; u32x2 xc[4];
#pragma unroll
        for (int j = 0; j < 4; ++j) { xc[j] = xn[j];
#pragma unroll
            for (int k = 0; k < 4; ++k) yc[j][k] = yn[j][k]; }
        if (tok + NGW < NTOK) {
#pragma unroll
            for (int j = 0; j < 4; ++j) {
#pragma unroll
                for (int k = 0; k < 4; ++k) yn[j][k] = *((const unsigned*)(Y + (size_t)p1[k] * DM) + lane + 64 * j);
                xn[j] = ((const u32x2*)(X1 + (size_t)(tok + NGW) * DM) + lane)[64 * j]; }
            if (tok + 2 * NGW < NTOK) {
#pragma unroll
                for (int k = 0; k < 4; ++k) p1[k] = pos[(tok + 2 * NGW) * 4 + k]; } }
        f32x4 v[4]; float s = 0.f;
#pragma unroll
        for (int j = 0; j < 4; ++j) { f32x4 ff = {0.f, 0.f, 0.f, 0.f};
#pragma unroll
            for (int k = 0; k < 4; ++k) { const int w = (int)yc[j][k];
                const f32x2 lo = __builtin_amdgcn_cvt_pk_f32_fp8(w, false), hi = __builtin_amdgcn_cvt_pk_f32_fp8(w, true);
                ff.x += lo.x; ff.y += lo.y; ff.z += hi.x; ff.w += hi.y; }
            ff = ff * (1.0f / 64.0f);
            { const u32x2 xw = xc[j]; f32x4 x1v; x1v.x = __uint_as_float(xw.x << 16); x1v.y = __uint_as_float(xw.x & 0xffff0000u); x1v.z = __uint_as_float(xw.y << 16); x1v.w = __uint_as_float(xw.y & 0xffff0000u);
              v[j] = x1v * DN_ALPHA + gfl[b * 256 + lane + 64 * j] * ff; } s += (v[j].x + v[j].y) + (v[j].z + v[j].w); }
        const float mean = wave_sum(s) * (1.f / DM); float s2 = 0.f;
#pragma unroll
        for (int j = 0; j < 4; ++j) { v[j] = v[j] - mean; s2 += (v[j].x * v[j].x + v[j].y * v[j].y) + (v[j].z * v[j].z + v[j].w * v[j].w); }
        const float rstd = 1.f / sqrtf(wave_sum(s2) * (1.f / DM) + LN_EPS);
        f32x4* orow = (f32x4*)(F.out + (size_t)tok * DM) + lane;
#pragma unroll
        for (int j = 0; j < 4; ++j) __builtin_nontemporal_store(v[j] * rstd * g2[j] + b2[j], &orow[64 * j]);
    }
}
#ifndef MK_N_LAUNCHES
#define MK_N_LAUNCHES 1
#endif
constexpr int PER_PHASE = 12;
constexpr int N_LAUNCHES = MK_N_LAUNCHES;
struct Args { const float* in[18]; float* out; unsigned char* ws; int ph_lo, ph_hi, sub, pad; };
static_assert(sizeof(Args) == 18 * 8 + 8 + 8 + 16, "Args has no padding");

__global__ void __launch_bounds__(NWAVES * 64, 2) dsa_fwd(Args args) {
    extern __shared__ __attribute__((aligned(16))) unsigned char lds[];
    LAS unsigned char* L = (LAS unsigned char*)lds;
    Frame F;
    F.ws = args.ws; F.tid = threadIdx.x; F.lane = F.tid & 63; F.wave = __builtin_amdgcn_readfirstlane(F.tid >> 6);
    F.G = gridDim.x; { const int bx = blockIdx.x; F.vcu = (F.G % 8 == 0) ? (bx % 8) * (F.G / 8) + bx / 8 : bx; }
    F.x = args.in[0]; F.c = args.in[1]; F.rel_bias = args.in[2]; F.w_ada = args.in[3]; F.b_ada = args.in[4]; F.w_in = args.in[5]; F.ret_g = args.in[6]; F.w_out = args.in[7];
    F.ln1_g = args.in[8]; F.ln1_b = args.in[9]; F.w_router = args.in[10]; F.b_router = args.in[11]; F.w_gu = args.in[12]; F.b_gu = args.in[13]; F.w_d = args.in[14]; F.b_d = args.in[15];
    F.ln2_g = args.in[16]; F.ln2_b = args.in[17]; F.out = args.out;
    unsigned* ctl = (unsigned*)(F.ws + WS_CTL);
    volatile LAS unsigned* MISC = (volatile LAS unsigned*)(L + LDS_BYTES - 64);
    if (F.tid < 16) MISC[F.tid] = 0u;
    __syncthreads();
    XcdBarrier bar; bar.bar = ctl + CW_BAR; bar.x = 0; bar.st = nullptr;
    if (N_LAUNCHES == 1) bar = xcd_barrier_post(ctl + CW_BAR, MISC + 8);
    const int lo = args.ph_lo, hi = args.ph_hi;
#ifndef PHASE_MASK
#define PHASE_MASK 0xfff
#endif
#define IN(k) (((PHASE_MASK >> (k)) & 1) && lo <= (k) && (k) < hi)
#define REFRESH() do { int t_ = threadIdx.x; asm volatile("" : "+v"(t_)); F.tid = t_; F.lane = t_ & 63; } while (0)
#define SEAM(k) do { if (IN(k) && IN((k) + 1)) xcd_barrier(bar); } while (0)

    if (IN(0)) { REFRESH(); p0_prologue(F, L); } SEAM(0);
    if (IN(1)) { REFRESH(); p1_modulate(F, L); } SEAM(1);
    if (IN(2)) { REFRESH();
        {
            pg8::Gemm g{(const bf16_t*)(F.ws + WS_H), (const bf16_t*)(F.ws + WS_WIN), DM, nullptr}; pg8::RemapOrder S; S.base.init(NTOK, 512, F.G, (int)blockIdx.x); S.from = 0; S.off = 3;
            pg8::EpiInProj E{(bf16_t*)(F.ws + WS_QA), (bf16_t*)(F.ws + WS_KA), (bf16_t*)(F.ws + WS_VA), (bf16_t*)(F.ws + WS_QI), (bf16_t*)(F.ws + WS_KIW),
                             (bf16_t*)(F.ws + WS_QR), (bf16_t*)(F.ws + WS_KR), (bf16_t*)(F.ws + WS_VR), (bf16_t*)(F.ws + WS_GR)};
            pg8::gemm_phase<pg8::EpiInProj, pg8::RemapOrder, false>(L, g, S, E); }
        {
            pg8::Gemm g{(const bf16_t*)(F.ws + WS_HQ), (const bf16_t*)(F.ws + WS_WINQ), DM / 2, nullptr}; pg8::RemapOrder S; S.base.init(NTOK, 11 * 256, F.G, (int)blockIdx.x); S.from = 3; S.off = 2;
            pg8::EpiInProjI8 E{(bf16_t*)(F.ws + WS_QA), (bf16_t*)(F.ws + WS_KA), (bf16_t*)(F.ws + WS_VA), (bf16_t*)(F.ws + WS_QR), (bf16_t*)(F.ws + WS_KR), (bf16_t*)(F.ws + WS_VR), (bf16_t*)(F.ws + WS_GR),
                               (const float*)(F.ws + WS_SH), (const float*)(F.ws + WS_SWIN)};
            pg8::gemm_phase<pg8::EpiInProjI8, pg8::RemapOrder, false, true>(L, g, S, E); }
        if (F.G == 256 && (int)blockIdx.x >= 128) { REFRESH(); p2_tail_calibration(F); }
    } SEAM(2);
    if (IN(3)) { REFRESH();
        unsigned* qctr = ctl + CW_QUEUE; volatile LAS unsigned* qslot = MISC;
        int k; bool staged = false;
        if (F.tid == 0) qslot[0] = __hip_atomic_fetch_add(qctr, 1u, __ATOMIC_RELAXED, __HIP_MEMORY_SCOPE_AGENT);
        __syncthreads(); k = (int)qslot[0]; __syncthreads();
        for (;;) {
            if (k >= BATCH * 256 + 1024) break;
            if (k < BATCH * 256 && (args.sub & 1)) { k = select_item(F, L, k, staged, qctr, qslot, args.sub); continue; }
            if (k >= BATCH * 256 && (args.sub & 2)) ret_state_item(F, L, k - BATCH * 256);
            if (F.tid == 0) qslot[0] = __hip_atomic_fetch_add(qctr, 1u, __ATOMIC_RELAXED, __HIP_MEMORY_SCOPE_AGENT);
            __syncthreads(); k = (int)qslot[0]; __syncthreads();
        }
    } SEAM(3);
    if (IN(4)) { REFRESH(); ret_scan(F); } SEAM(4);
    if (IN(5)) { REFRESH();
        if (args.sub & 1)
        for (int i = 0;; ++i) { const int Lx = i * F.G + F.vcu; if (Lx >= 1024) break;
            int bh, qb;
            if (F.G == 256) { const int s = F.vcu & 3; bh = F.vcu >> 2; qb = (i == 0) ? 15 - s : (i == 1) ? 8 + s : (i == 2) ? 7 - s : s; }
            else { bh = Lx >> 4; qb = Lx & 15; }
            attn_body::attn_unit(bh >> 3, bh & 7, qb, (const bf16_t*)(F.ws + WS_QA), (const bf16_t*)(F.ws + WS_KA), (const bf16_t*)(F.ws + WS_VA), (bf16_t*)(F.ws + WS_H),
                                 (const unsigned*)(F.ws + WS_MASK), F.rel_bias, (char*)lds, !(F.G == 256 && i > 0)); }
        __syncthreads();
        if (args.sub & 2)
        for (int u = F.vcu; u < 1024; u += F.G) ret_out_item(F, L, u);
    } SEAM(5);
    if (IN(6)) { REFRESH();
        pg8::Gemm g{(const bf16_t*)(F.ws + WS_H), (const bf16_t*)(F.ws + WS_WOUT), DM, nullptr}; pg8::StaticOrder S; S.init(NTOK, DM, F.G, (int)blockIdx.x);
        pg8::EpiOutProj E{(const float*)(F.ws + WS_MOD), (bf16_t*)(F.ws + WS_MIX)};
        pg8::gemm_phase<pg8::EpiOutProj, pg8::StaticOrder, false>(L, g, S, E);
    } SEAM(6);
    if (IN(7)) { REFRESH(); p6_rows(F, L); } SEAM(7);
    if (IN(8)) { REFRESH(); p6b_scatter(F, L); } SEAM(8);
    if (IN(9)) { REFRESH();
        const int* blkexp = (const int*)(F.ws + WS_BLKEXP); const int nblk = __hip_atomic_load(blkexp + MAXBLK, __ATOMIC_RELAXED, __HIP_MEMORY_SCOPE_AGENT);
        LAS int* lexp = (LAS int*)(L + 157696); for (int i = F.tid; i < 640; i += 512) lexp[i] = blkexp[i]; __syncthreads();
        pg8::Gemm g{(const bf16_t*)(F.ws + WS_H2), (const bf16_t*)(F.ws + WS_WGU), DM / 2, (const int*)(F.ws + WS_ROWTOK)}; pg8::MoeOrder S{lexp, nblk, 8, F.G, F.vcu};
        pg8::EpiGateUp E{(unsigned char*)(F.ws + WS_ACT), F.b_gu, (const float*)(F.ws + WS_SWGU), (const float*)(F.ws + WS_ROWSCALE)};
        pg8::gemm_phase<pg8::EpiGateUp, pg8::MoeOrder, true, true>(L, g, S, E);
    } SEAM(9);
    if (IN(10)) { REFRESH();
        const int* blkexp = (const int*)(F.ws + WS_BLKEXP); const int nblk = __hip_atomic_load(blkexp + MAXBLK, __ATOMIC_RELAXED, __HIP_MEMORY_SCOPE_AGENT);
        LAS int* lexp = (LAS int*)(L + 157696); for (int i = F.tid; i < 640; i += 512) lexp[i] = blkexp[i]; __syncthreads();
        pg8::Gemm g{(const bf16_t*)(F.ws + WS_ACT), (const bf16_t*)(F.ws + WS_WD), DFF / 2, nullptr}; pg8::MoeOrder S{lexp, nblk, 4, F.G, F.vcu};
        pg8::EpiDown E{(unsigned char*)(F.ws + WS_Y), F.b_d, (const float*)(F.ws + WS_ROWGATE), (const float*)(F.ws + WS_SWD)};
        pg8::gemm_phase<pg8::EpiDown, pg8::MoeOrder, false, false, true>(L, g, S, E);
    } SEAM(10);
    if (IN(11)) { REFRESH(); p9_final(F, L); }
#undef IN
#undef SEAM
}

extern "C" void kernel_launch(void* const* d_in, const int* in_sizes, int n_in, void* d_out, int out_size, void* d_ws, size_t ws_size, hipStream_t stream) {
    static int grid = 0;
    if (grid == 0) {
        if (n_in != 18 || out_size != NTOK * DM || ws_size < WS_END) { fprintf(stderr, "kernel_launch: unexpected shapes (n_in %d out %d ws %zu)\n", n_in, out_size, ws_size); grid = -1; return; }
        int dev = 0, cus = 0, per_cu = 0;
        if (hipGetDevice(&dev) != hipSuccess || hipDeviceGetAttribute(&cus, hipDeviceAttributeMultiprocessorCount, dev) != hipSuccess) { grid = -1; return; }
        if (hipFuncSetAttribute((const void*)dsa_fwd, hipFuncAttributeMaxDynamicSharedMemorySize, LDS_BYTES) != hipSuccess) { fprintf(stderr, "kernel_launch: hipFuncSetAttribute failed\n"); grid = -1; return; }
        if (hipOccupancyMaxActiveBlocksPerMultiprocessor(&per_cu, (const void*)dsa_fwd, NWAVES * 64, LDS_BYTES) != hipSuccess || per_cu < 1) { fprintf(stderr, "kernel_launch: occupancy query says %d blocks per CU\n", per_cu); (void)hipGetLastError(); per_cu = 1; }
        grid = cus;
    }
    if (grid < 0) return;
    (void)hipMemsetAsync((char*)d_ws + WS_CTL, 0, CTL_ZERO_BYTES, stream);
    Args a{};
    for (int i = 0; i < 18; ++i) a.in[i] = (const float*)d_in[i];
    a.out = (float*)d_out; a.ws = (unsigned char*)d_ws; a.sub = 3;
    if (N_LAUNCHES == 1) {
        a.ph_lo = 0; a.ph_hi = PER_PHASE;
        void* kargs[] = {&a};
        hipError_t e = hipLaunchCooperativeKernel((const void*)dsa_fwd, dim3(grid), dim3(NWAVES * 64), kargs, LDS_BYTES, stream);
        if (e != hipSuccess) { fprintf(stderr, "kernel_launch: cooperative launch failed: %s (grid %d)\n", hipGetErrorString(e), grid); }
#ifdef PROBE_PHASE
        a.ph_lo = PROBE_PHASE; a.ph_hi = PROBE_PHASE + 1;
#ifdef PROBE_SUB
        a.sub = PROBE_SUB;
#endif
        (void)hipMemsetAsync((char*)d_ws + WS_CTL + 4 * CW_QUEUE, 0, 64, stream);
        hipLaunchKernelGGL(dsa_fwd, dim3(grid), dim3(NWAVES * 64), LDS_BYTES, stream, a);
#endif
    } else {
        for (int li = 0; li < PER_PHASE; ++li) { a.ph_lo = li; a.ph_hi = li + 1; hipLaunchKernelGGL(dsa_fwd, dim3(grid), dim3(NWAVES * 64), LDS_BYTES, stream, a); }
    }
}
```
